# Optimizing an MI355X kernel written in HIP

```python
import math
import jax
import jax.numpy as jnp
from jax import lax
import numpy as np


D_MODEL = 1024
BATCH = 8
SEQ = 2048
DEPTH = 2

GRID_W = 64
CTX_LEN = 256
EPS = 1e-6
N_MOD = 6

RET_HEADS = 4
RET_DK = 128
RET_DV = 128
RET_CHUNK = 128
ROPE_BASE = 10000.0
FNET_GROUPS = 4
FNET_CH = 128
DN_HEADS = 4
DN_DK = 128
DN_DV = 128
DN_CHUNK = 64
DN_CONV = 3
SGU_GROUPS = 4
SGU_CH = 128
SGU_CHUNK = 128
MOE_GROUPS = 4
MOE_EXP_PER_GROUP = 8
MOE_EXPERTS = MOE_GROUPS * MOE_EXP_PER_GROUP
MOE_TOP_K = 2
MOE_HIDDEN = 512
MOE_BLOCK = 128

RET_QK = RET_HEADS * RET_DK
RET_V = RET_HEADS * RET_DV
FNET_W = FNET_GROUPS * FNET_CH
E_K = RET_QK
E_V = 2 * RET_QK
E_G = 2 * RET_QK + RET_V
E_F = 2 * RET_QK + 2 * RET_V
EVEN_IN = E_F + FNET_W
EVEN_MIX = RET_V + FNET_W
DN_QK = DN_HEADS * DN_DK
DN_V = DN_HEADS * DN_DV
SGU_W = SGU_GROUPS * SGU_CH
O_K = DN_QK
O_V = 2 * DN_QK
O_Z = 2 * DN_QK + DN_V
O_A = O_Z + DN_V
O_U = O_A + 4 * DN_HEADS
O_S = O_U + SGU_W
ODD_IN = O_S + SGU_W
ODD_MIX = DN_V + SGU_W

kernel_name = 'hybrid_prefix_diffusion_block'
F32 = jnp.float32


def rms_norm(x, w):
    xf = x.astype(F32)
    y = xf * lax.rsqrt(jnp.mean(xf * xf, -1, keepdims=True) + EPS)
    return (y * w.astype(F32)).astype(x.dtype)


def l2norm(x):
    return x * lax.rsqrt(jnp.sum(x * x, -1, keepdims=True) + EPS)


def to_heads(x, n_heads):
    b, t, _ = x.shape
    return x.reshape(b, t, n_heads, -1).transpose(0, 2, 1, 3).astype(F32)


def from_heads(x):
    b, h, t, d = x.shape
    return x.transpose(0, 2, 1, 3).reshape(b, t, h * d)


def to_chunks(x, c):
    return x.reshape(x.shape[:2] + (x.shape[2] // c, c) + x.shape[3:])


def from_chunks(x):
    return x.reshape(x.shape[:2] + (x.shape[2] * x.shape[3],) + x.shape[4:])


def _noflip(x):
    return x


def _flip(x):
    return x[:, :, ::-1]


def axial_rope(x):
    t, d = x.shape[2], x.shape[3]
    rows = t // GRID_W
    row = jnp.repeat(jnp.arange(rows), GRID_W).astype(F32)
    col = jnp.tile(jnp.arange(GRID_W), rows).astype(F32)
    n_freq = d // 4
    inv = jnp.power(ROPE_BASE, -jnp.arange(n_freq, dtype=F32) / n_freq)
    ang = jnp.concatenate([row[:, None] * inv, col[:, None] * inv], -1)
    cos, sin = jnp.cos(ang), jnp.sin(ang)
    x1, x2 = jnp.split(x, 2, -1)
    return jnp.concatenate([x1 * cos - x2 * sin, x1 * sin + x2 * cos], -1)


def _ret_states(k, v, log_gamma, s0):
    c = k.shape[3]
    pos = jnp.arange(c, dtype=F32)
    w_tail = jnp.exp(log_gamma[:, None] * (c - 1 - pos))
    kv = jnp.einsum('bhncd,bhnce->bhnde', k * w_tail[None, :, None, :, None], v)
    g_chunk = jnp.exp(log_gamma * c)[None, :, None, None]

    def step(s, kv_n):
        return g_chunk * s + kv_n, s

    s_fin, s_prev = lax.scan(step, s0, jnp.moveaxis(kv, 2, 0))
    return jnp.moveaxis(s_prev, 0, 2), s_fin


def _ret_out(q, k, v, log_gamma, s_prev):
    c = q.shape[3]
    pos = jnp.arange(c, dtype=F32)
    diff = pos[:, None] - pos[None, :]
    dmat = jnp.where(diff >= 0, jnp.exp(log_gamma[:, None, None] * jnp.maximum(diff, 0.0)), 0.0)
    scores = jnp.einsum('bhnid,bhnjd->bhnij', q, k) * dmat[None, :, None]
    inner = jnp.einsum('bhnij,bhnje->bhnie', scores, v)
    q_dec = q * jnp.exp(log_gamma[:, None] * (pos + 1.0))[None, :, None, :, None]
    return inner + jnp.einsum('bhnid,bhnde->bhnie', q_dec, s_prev)


def retention_dir(k, v, log_gamma, s0, q=None):
    kc, vc = to_chunks(k, RET_CHUNK), to_chunks(v, RET_CHUNK)
    s_prev, s_fin = _ret_states(kc, vc, log_gamma, s0)
    out = None if q is None else from_chunks(_ret_out(to_chunks(q, RET_CHUNK), kc, vc, log_gamma, s_prev))
    return out, s_fin


def group_norm_gate(o, gate, w):
    mu = jnp.mean(o, -1, keepdims=True)
    var = jnp.mean(jnp.square(o - mu), -1, keepdims=True)
    y = from_heads((o - mu) * lax.rsqrt(var + EPS)) * w.astype(F32)
    return (y * jax.nn.silu(gate.astype(F32))).astype(gate.dtype)


def fourier_mix(f):
    b, t, _ = f.shape
    z = jnp.fft.fft2(f.reshape(b, t, FNET_GROUPS, FNET_CH).astype(F32), axes=(1, 3), norm='ortho')
    return jnp.real(z).reshape(b, t, FNET_W).astype(f.dtype)


def short_conv(x, w):
    k = w.shape[0]
    y = lax.conv_general_dilated(x, w[:, None, :].astype(x.dtype), window_strides=(1,),
                                 padding=[((k - 1) // 2, k // 2)],
                                 dimension_numbers=('NWC', 'WIO', 'NWC'),
                                 feature_group_count=x.shape[-1])
    return jax.nn.silu(y)


def dn_gates(ab, d, a_log, dt_bias):
    b, t, _ = ab.shape
    a = ab[..., :2 * DN_HEADS].reshape(b, t, 2, DN_HEADS)[:, :, d].astype(F32)
    bt = ab[..., 2 * DN_HEADS:].reshape(b, t, 2, DN_HEADS)[:, :, d].astype(F32)
    beta = jax.nn.sigmoid(bt)
    glog = -jnp.exp(a_log[d].astype(F32)) * jax.nn.softplus(a + dt_bias[d].astype(F32))
    return beta.transpose(0, 2, 1), glog.transpose(0, 2, 1)


def _delta_prep(k, v, beta, glog):
    c = k.shape[3]
    g = jnp.cumsum(glog, -1)
    idx = jnp.arange(c)
    lower = idx[:, None] >= idx[None, :]
    strict = idx[:, None] > idx[None, :]
    diff = g[..., :, None] - g[..., None, :]
    decay = jnp.where(lower, jnp.exp(jnp.where(lower, diff, 0.0)), 0.0)
    kk = jnp.einsum('bhnid,bhnjd->bhnij', k, k)
    a_mat = jnp.where(strict, beta[..., :, None] * kk * decay, 0.0) + jnp.eye(c, dtype=F32)
    rhs = jnp.concatenate([v * beta[..., None], k * (beta * jnp.exp(g))[..., None]], -1)
    sol = lax.linalg.triangular_solve(a_mat, rhs, left_side=True, lower=True)
    dv = v.shape[-1]
    u, w = sol[..., :dv], sol[..., dv:]
    k_tail = k * jnp.exp(g[..., -1:] - g)[..., None]
    return u, w, k_tail, g, decay


def _delta_states(u, w, k_tail, g, s0):
    g_last = jnp.exp(g[..., -1])

    def step(s, xs):
        u_n, w_n, kt_n, gl_n = xs
        v_new = u_n - jnp.einsum('bhck,bhkv->bhcv', w_n, s)
        return s * gl_n[..., None, None] + jnp.einsum('bhck,bhcv->bhkv', kt_n, v_new), s

    xs = (jnp.moveaxis(u, 2, 0), jnp.moveaxis(w, 2, 0), jnp.moveaxis(k_tail, 2, 0), jnp.moveaxis(g_last, 2, 0))
    s_fin, s_prev = lax.scan(step, s0, xs)
    return jnp.moveaxis(s_prev, 0, 2), s_fin


def _delta_out(q, k, u, w, g, decay, s_prev):
    v_new = u - jnp.einsum('bhnck,bhnkv->bhncv', w, s_prev)
    attn = jnp.einsum('bhnik,bhnjk->bhnij', q, k) * decay
    inter = jnp.einsum('bhnik,bhnkv->bhniv', q * jnp.exp(g)[..., None], s_prev)
    return inter + jnp.einsum('bhnij,bhnjv->bhniv', attn, v_new)


def delta_dir(k, v, beta, glog, s0, q=None):
    kc = to_chunks(k, DN_CHUNK)
    u, w, k_tail, g, decay = _delta_prep(kc, to_chunks(v, DN_CHUNK), to_chunks(beta, DN_CHUNK), to_chunks(glog, DN_CHUNK))
    s_prev, s_fin = _delta_states(u, w, k_tail, g, s0)
    out = None if q is None else from_chunks(_delta_out(to_chunks(q, DN_CHUNK), kc, u, w, g, decay, s_prev))
    return out, s_fin


def gated_head_norm(o, z, w):
    y = o * lax.rsqrt(jnp.mean(o * o, -1, keepdims=True) + EPS) * w.astype(F32)
    return (from_heads(y) * jax.nn.silu(z.astype(F32))).astype(z.dtype)


def spatial_gating(u, v, w_s, b_s):
    b, t, _ = u.shape
    u = jax.nn.gelu(u, approximate=False)
    v = jax.nn.gelu(v.astype(F32), approximate=False).reshape(b, t // SGU_CHUNK, SGU_CHUNK, SGU_GROUPS, SGU_CH)
    mu = jnp.mean(v, -1, keepdims=True)
    var = jnp.mean(jnp.square(v - mu), -1, keepdims=True)
    v = (v - mu) * lax.rsqrt(var + EPS)
    v = jnp.einsum('gpq,bnqgc->bnpgc', w_s.astype(F32), v) + b_s.astype(F32).T[None, None, :, :, None]
    return (u.astype(F32) * v.reshape(b, t, SGU_W)).astype(u.dtype)


def even_mixer(h_ctx, h_lat, w_in, decay_logit, gn_w, w_out, need_ctx):
    log_gamma = jax.nn.log_sigmoid(decay_logit.astype(F32))
    scale = RET_DK ** -0.5
    lat = h_lat @ w_in
    q_l = axial_rope(to_heads(lat[..., :E_K], RET_HEADS)) * scale
    k_l = axial_rope(to_heads(lat[..., E_K:E_V], RET_HEADS))
    v_l = to_heads(lat[..., E_V:E_G], RET_HEADS)
    if need_ctx:
        ctx = h_ctx @ w_in
        q_c = to_heads(ctx[..., :E_K], RET_HEADS) * scale
        kv_c = ctx[..., E_K:E_G]
    else:
        kv_c = h_ctx @ w_in[:, E_K:E_G]
    k_c = to_heads(kv_c[..., :RET_QK], RET_HEADS)
    v_c = to_heads(kv_c[..., RET_QK:], RET_HEADS)
    s_zero = jnp.zeros((h_lat.shape[0], RET_HEADS, RET_DK, RET_DV), F32)
    o_l, o_c = 0.0, 0.0
    for d, fl in enumerate((_noflip, _flip)):
        oc, s_c = retention_dir(fl(k_c), fl(v_c), log_gamma[d], s_zero, fl(q_c) if need_ctx else None)
        ol, _ = retention_dir(fl(k_l), fl(v_l), log_gamma[d], s_c, fl(q_l))
        o_l = o_l + fl(ol)
        if need_ctx:
            o_c = o_c + fl(oc)
    y_l = jnp.concatenate([group_norm_gate(o_l, lat[..., E_G:E_F], gn_w), fourier_mix(lat[..., E_F:])], -1) @ w_out
    y_c = None
    if need_ctx:
        y_c = jnp.concatenate([group_norm_gate(o_c, ctx[..., E_G:E_F], gn_w), fourier_mix(ctx[..., E_F:])], -1) @ w_out
    return y_c, y_l


def odd_mixer(h_ctx, h_lat, w_in, conv_w, a_log, dt_bias, norm_w, sp_w, sp_b, w_out, need_ctx):
    scale = DN_DK ** -0.5
    lat = h_lat @ w_in
    qkv_l = short_conv(lat[..., :O_Z], conv_w)
    q_l = l2norm(to_heads(qkv_l[..., :O_K], DN_HEADS)) * scale
    k_l = l2norm(to_heads(qkv_l[..., O_K:O_V], DN_HEADS))
    v_l = to_heads(qkv_l[..., O_V:], DN_HEADS)
    ab_l = lat[..., O_A:O_U]
    if need_ctx:
        ctx = h_ctx @ w_in
        qkv_c = short_conv(ctx[..., :O_Z], conv_w)
        q_c = l2norm(to_heads(qkv_c[..., :O_K], DN_HEADS)) * scale
        kv_c = qkv_c[..., O_K:]
        ab_c = ctx[..., O_A:O_U]
    else:
        kv_c = short_conv(h_ctx @ w_in[:, O_K:O_Z], conv_w[:, O_K:O_Z])
        ab_c = h_ctx @ w_in[:, O_A:O_U]
    k_c = l2norm(to_heads(kv_c[..., :DN_QK], DN_HEADS))
    v_c = to_heads(kv_c[..., DN_QK:], DN_HEADS)
    s_zero = jnp.zeros((h_lat.shape[0], DN_HEADS, DN_DK, DN_DV), F32)
    o_l, o_c = 0.0, 0.0
    for d, fl in enumerate((_noflip, _flip)):
        beta_c, glog_c = dn_gates(ab_c, d, a_log, dt_bias)
        beta_l, glog_l = dn_gates(ab_l, d, a_log, dt_bias)
        oc, s_c = delta_dir(fl(k_c), fl(v_c), fl(beta_c), fl(glog_c), s_zero, fl(q_c) if need_ctx else None)
        ol, _ = delta_dir(fl(k_l), fl(v_l), fl(beta_l), fl(glog_l), s_c, fl(q_l))
        o_l = o_l + fl(ol)
        if need_ctx:
            o_c = o_c + fl(oc)
    y_l = jnp.concatenate([gated_head_norm(o_l, lat[..., O_Z:O_A], norm_w),
                           spatial_gating(lat[..., O_U:O_S], lat[..., O_S:], sp_w, sp_b)], -1) @ w_out
    y_c = None
    if need_ctx:
        y_c = jnp.concatenate([gated_head_norm(o_c, ctx[..., O_Z:O_A], norm_w),
                               spatial_gating(ctx[..., O_U:O_S], ctx[..., O_S:], sp_w, sp_b)], -1) @ w_out
    return y_c, y_l


def hier_moe(h, wg, bg, we, be, w_gate, w_up, w_down):
    t, d = h.shape
    logit_g = (h @ wg).astype(F32) + bg.astype(F32)
    grp = jnp.argmax(logit_g, -1)
    p_grp = jnp.take_along_axis(jax.nn.softmax(logit_g, -1), grp[:, None], -1)[:, 0]
    logit_e = ((h @ we).astype(F32) + be.astype(F32)).reshape(t, MOE_GROUPS, MOE_EXP_PER_GROUP)
    logit_in = jnp.take_along_axis(logit_e, grp[:, None, None], 1)[:, 0]
    top_l, top_i = lax.top_k(logit_in, MOE_TOP_K)
    gate = p_grp[:, None] * jax.nn.softmax(top_l, -1)
    expert = grp[:, None] * MOE_EXP_PER_GROUP + top_i
    n_assign = t * MOE_TOP_K
    e_flat = expert.reshape(-1)
    g_flat = gate.reshape(-1)
    tok = jnp.repeat(jnp.arange(t), MOE_TOP_K)
    order = jnp.argsort(e_flat)
    e_s, tok_s, g_s = e_flat[order], tok[order], g_flat[order]
    counts = jnp.bincount(e_flat, length=MOE_EXPERTS)
    starts = jnp.cumsum(counts) - counts
    padded = (counts + MOE_BLOCK - 1) // MOE_BLOCK * MOE_BLOCK
    p_ends = jnp.cumsum(padded)
    dest = p_ends[e_s] - padded[e_s] + jnp.arange(n_assign) - starts[e_s]
    n_blocks = -(-(n_assign + MOE_EXPERTS * (MOE_BLOCK - 1)) // MOE_BLOCK)
    rows = jnp.zeros((n_blocks * MOE_BLOCK, d), h.dtype).at[dest].set(h[tok_s])
    blk_exp = jnp.minimum(jnp.searchsorted(p_ends, jnp.arange(n_blocks) * MOE_BLOCK, side='right'), MOE_EXPERTS - 1)

    def run_block(args):
        xb, e = args
        return (jax.nn.silu(xb @ w_gate[e]) * (xb @ w_up[e])) @ w_down[e]

    y = lax.map(run_block, (rows.reshape(n_blocks, MOE_BLOCK, d), blk_exp)).reshape(-1, d)
    contrib = y[dest].astype(F32) * g_s[:, None]
    return jnp.zeros((t, d), F32).at[tok_s].add(contrib).astype(h.dtype)


def setup_inputs(seed: int = 0) -> dict:
    key = jax.random.key(seed)
    ks = iter(jax.random.split(key, 40))
    n_even = (DEPTH + 1) // 2
    n_odd = DEPTH // 2

    def nrm(shape, scale=1.0):
        return jax.random.normal(next(ks), shape, F32) * scale

    def gain(shape):
        return 1.0 + nrm(shape, 0.02)

    x = nrm((BATCH, SEQ, D_MODEL))
    c = nrm((BATCH, D_MODEL))
    ctx = nrm((BATCH, CTX_LEN, D_MODEL))
    c_ctx = nrm((D_MODEL,))
    norm1_w = gain((DEPTH, D_MODEL))
    norm2_w = gain((DEPTH, D_MODEL))
    ada_w = nrm((DEPTH, D_MODEL, N_MOD * D_MODEL), 0.5 * D_MODEL ** -0.5)
    ada_b = nrm((DEPTH, N_MOD * D_MODEL), 0.01)
    even_w_in = nrm((n_even, D_MODEL, EVEN_IN), D_MODEL ** -0.5)
    ret_base = jnp.log(jnp.power(2.0, 5.0 + jnp.arange(RET_HEADS, dtype=F32)) - 1.0)
    ret_decay_logit = ret_base + nrm((n_even, 2, RET_HEADS), 0.1)
    ret_gn_w = gain((n_even, RET_V))
    even_w_out = nrm((n_even, EVEN_MIX, D_MODEL), EVEN_MIX ** -0.5)
    odd_w_in = nrm((n_odd, D_MODEL, ODD_IN), D_MODEL ** -0.5)
    dn_conv_w = nrm((n_odd, DN_CONV, O_Z), DN_CONV ** -0.5)
    dn_a_log = jnp.log(jax.random.uniform(next(ks), (n_odd, 2, DN_HEADS), F32, 1.0, 16.0))
    dt = jnp.exp(jax.random.uniform(next(ks), (n_odd, 2, DN_HEADS), F32, math.log(1e-3), math.log(1e-1)))
    dn_dt_bias = dt + jnp.log(-jnp.expm1(-dt))
    dn_norm_w = gain((n_odd, DN_DV))
    sgu_w = nrm((n_odd, SGU_GROUPS, SGU_CHUNK, SGU_CHUNK), SGU_CHUNK ** -0.5)
    sgu_b = gain((n_odd, SGU_GROUPS, SGU_CHUNK))
    odd_w_out = nrm((n_odd, ODD_MIX, D_MODEL), ODD_MIX ** -0.5)
    router_g_w = nrm((DEPTH, D_MODEL, MOE_GROUPS), D_MODEL ** -0.5)
    router_g_b = nrm((DEPTH, MOE_GROUPS), 0.01)
    router_e_w = nrm((DEPTH, D_MODEL, MOE_EXPERTS), D_MODEL ** -0.5)
    router_e_b = nrm((DEPTH, MOE_EXPERTS), 0.01)
    moe_w_gate = nrm((DEPTH, MOE_EXPERTS, D_MODEL, MOE_HIDDEN), D_MODEL ** -0.5)
    moe_w_up = nrm((DEPTH, MOE_EXPERTS, D_MODEL, MOE_HIDDEN), D_MODEL ** -0.5)
    moe_w_down = nrm((DEPTH, MOE_EXPERTS, MOE_HIDDEN, D_MODEL), MOE_HIDDEN ** -0.5)
    final_norm_w = gain((D_MODEL,))
    return {'x': x, 'c': c, 'ctx': ctx, 'c_ctx': c_ctx, 'norm1_w': norm1_w, 'norm2_w': norm2_w,
            'ada_w': ada_w, 'ada_b': ada_b, 'even_w_in': even_w_in, 'ret_decay_logit': ret_decay_logit,
            'ret_gn_w': ret_gn_w, 'even_w_out': even_w_out, 'odd_w_in': odd_w_in, 'dn_conv_w': dn_conv_w,
            'dn_a_log': dn_a_log, 'dn_dt_bias': dn_dt_bias, 'dn_norm_w': dn_norm_w, 'sgu_w': sgu_w,
            'sgu_b': sgu_b, 'odd_w_out': odd_w_out, 'router_g_w': router_g_w, 'router_g_b': router_g_b,
            'router_e_w': router_e_w, 'router_e_b': router_e_b, 'moe_w_gate': moe_w_gate,
            'moe_w_up': moe_w_up, 'moe_w_down': moe_w_down, 'final_norm_w': final_norm_w}


def reference(x, c, ctx, c_ctx, norm1_w, norm2_w, ada_w, ada_b, even_w_in, ret_decay_logit, ret_gn_w,
              even_w_out, odd_w_in, dn_conv_w, dn_a_log, dn_dt_bias, dn_norm_w, sgu_w, sgu_b, odd_w_out,
              router_g_w, router_g_b, router_e_w, router_e_b, moe_w_gate, moe_w_up, moe_w_down, final_norm_w):
    b, s, d = x.shape
    x_lat, x_ctx = x, ctx
    for layer in range(DEPTH):
        last = layer == DEPTH - 1
        mod_l = (jax.nn.silu(c) @ ada_w[layer] + ada_b[layer])[:, None, :]
        mod_c = jax.nn.silu(c_ctx) @ ada_w[layer] + ada_b[layer]
        sh1_l, sc1_l, g1_l, sh2_l, sc2_l, g2_l = jnp.split(mod_l, N_MOD, -1)
        sh1_c, sc1_c, g1_c, sh2_c, sc2_c, g2_c = jnp.split(mod_c, N_MOD, -1)
        h_l = rms_norm(x_lat, norm1_w[layer]) * (1.0 + sc1_l) + sh1_l
        h_c = rms_norm(x_ctx, norm1_w[layer]) * (1.0 + sc1_c) + sh1_c
        if layer % 2 == 0:
            i = layer // 2
            y_c, y_l = even_mixer(h_c, h_l, even_w_in[i], ret_decay_logit[i], ret_gn_w[i], even_w_out[i], not last)
        else:
            i = layer // 2
            y_c, y_l = odd_mixer(h_c, h_l, odd_w_in[i], dn_conv_w[i], dn_a_log[i], dn_dt_bias[i], dn_norm_w[i],
                                 sgu_w[i], sgu_b[i], odd_w_out[i], not last)
        x_lat = x_lat + g1_l * y_l
        h2_l = rms_norm(x_lat, norm2_w[layer]) * (1.0 + sc2_l) + sh2_l
        moe_args = (router_g_w[layer], router_g_b[layer], router_e_w[layer], router_e_b[layer],
                    moe_w_gate[layer], moe_w_up[layer], moe_w_down[layer])
        if last:
            x_lat = x_lat + g2_l * hier_moe(h2_l.reshape(-1, d), *moe_args).reshape(b, s, d)
        else:
            x_ctx = x_ctx + g1_c * y_c
            h2_c = rms_norm(x_ctx, norm2_w[layer]) * (1.0 + sc2_c) + sh2_c
            n_c = h2_c.shape[0] * h2_c.shape[1]
            out = hier_moe(jnp.concatenate([h2_c.reshape(-1, d), h2_l.reshape(-1, d)], 0), *moe_args)
            x_ctx = x_ctx + g2_c * out[:n_c].reshape(x_ctx.shape)
            x_lat = x_lat + g2_l * out[n_c:].reshape(b, s, d)
    return rms_norm(x_lat, final_norm_w)
```

```cpp
#include <hip/hip_runtime.h>
#include <cstdio>
#include <cstdint>
#include <cmath>

namespace {
constexpr int DM = 1024, NB = 8, SEQ = 2048, CT = 256;
constexpr int NCTX = NB * CT, NLAT = NB * SEQ, NTOK = NCTX + NLAT;
constexpr int EIN = 2560, OIN = 3088;
constexpr int NEXP = 32, HID = 512;
constexpr float EPS = 1e-6f;
constexpr float PI2 = 6.283185307179586f;

__device__ __forceinline__ float siluf(float v) { return v / (1.f + expf(-v)); }
__device__ __forceinline__ float geluf(float v) { return 0.5f * v * (1.f + erff(v * 0.70710678118654752f)); }
__device__ __forceinline__ int row_batch(int r) { return r < NCTX ? r / CT : (r - NCTX) / SEQ; }
__device__ __forceinline__ int row_mod(int r) { return r < NCTX ? 8 : (r - NCTX) / SEQ; }

__device__ __forceinline__ float block_sum256(float v, float* red) {
#pragma unroll
    for (int o = 32; o > 0; o >>= 1) v += __shfl_xor(v, o);
    __syncthreads();
    if ((threadIdx.x & 63) == 0) red[threadIdx.x >> 6] = v;
    __syncthreads();
    return red[0] + red[1] + red[2] + red[3];
}

__global__ void __launch_bounds__(256) k_mods(const float* __restrict__ c, const float* __restrict__ c_ctx, const float* __restrict__ ada_w, const float* __restrict__ ada_b, float* __restrict__ mods) {
    __shared__ float s[9 * 1024];
    const int layer = blockIdx.y, j = blockIdx.x * 256 + threadIdx.x;
    for (int i = threadIdx.x; i < 9 * 1024; i += 256) { const int r = i >> 10, k = i & 1023; const float v = r < 8 ? c[r * 1024 + k] : c_ctx[k]; s[i] = siluf(v); }
    __syncthreads();
    float acc[9];
#pragma unroll
    for (int r = 0; r < 9; ++r) acc[r] = 0.f;
    for (int k = 0; k < 1024; ++k) {
        const float w = ada_w[((size_t)layer * 1024 + k) * 6144 + j];
#pragma unroll
        for (int r = 0; r < 9; ++r) acc[r] += s[r * 1024 + k] * w;
    }
#pragma unroll
    for (int r = 0; r < 9; ++r) mods[((size_t)layer * 9 + r) * 6144 + j] = acc[r] + ada_b[layer * 6144 + j];
}

__global__ void k_trig(float* __restrict__ tab, int T) {
    const int i = blockIdx.x * blockDim.x + threadIdx.x;
    if (i >= T * T) return;
    const int a = i / T, b = i % T; const int m = (int)(((long)a * b) % T);
    const float ang = PI2 * (float)m / (float)T; const float sc = 1.f / sqrtf((float)T);
    tab[i] = cosf(ang) * sc; tab[(size_t)T * T + i] = sinf(ang) * sc;
}

struct GemmP {
    const float* A; int lda; const int* gather;
    const float* B; int ldb;
    float* C; int ldc;
    int M, N, K;
    int nb0; long sA0, sA1, sB0, sB1, sC0, sC1;
    const int* cnt; const int* off;
    int a_rowoff;
    float alpha; int accum;
};
__global__ void __launch_bounds__(256) k_gemm(GemmP p) {
    __shared__ float As[16][68];
    __shared__ float Bs[16][68];
    const int z = blockIdx.z, z0 = z % p.nb0, z1 = z / p.nb0;
    int M = p.M, roff = 0;
    if (p.cnt) { M = p.cnt[z]; roff = p.off[z]; }
    const int m0 = blockIdx.y * 64, n0 = blockIdx.x * 64;
    if (m0 >= M) return;
    const float* A = p.A + z0 * p.sA0 + z1 * p.sA1;
    const float* B = p.B + z0 * p.sB0 + z1 * p.sB1;
    float* C = p.C + z0 * p.sC0 + z1 * p.sC1;
    const int tid = threadIdx.x, ty = tid >> 4, tx = tid & 15;
    const int ar = tid >> 2, ak = (tid & 3) * 4;
    const float* arow = nullptr;
    if (m0 + ar < M) { int ri = m0 + ar; if (p.gather) ri = p.gather[roff + ri]; else if (p.a_rowoff) ri += roff; arow = A + (size_t)ri * p.lda; }
    const int bk = tid >> 4, bn = (tid & 15) * 4;
    float acc[4][4];
#pragma unroll
    for (int i = 0; i < 4; ++i)
#pragma unroll
        for (int j = 0; j < 4; ++j) acc[i][j] = 0.f;
    for (int k0 = 0; k0 < p.K; k0 += 16) {
        float4 av = make_float4(0.f, 0.f, 0.f, 0.f);
        if (arow) av = *(const float4*)(arow + k0 + ak);
        float4 bv = make_float4(0.f, 0.f, 0.f, 0.f);
        if (n0 + bn < p.N) bv = *(const float4*)(B + (size_t)(k0 + bk) * p.ldb + n0 + bn);
        __syncthreads();
        As[ak + 0][ar] = av.x; As[ak + 1][ar] = av.y; As[ak + 2][ar] = av.z; As[ak + 3][ar] = av.w;
        *(float4*)&Bs[bk][bn] = bv;
        __syncthreads();
#pragma unroll
        for (int k = 0; k < 16; ++k) {
            const float4 a4 = *(const float4*)&As[k][ty * 4];
            const float4 b4 = *(const float4*)&Bs[k][tx * 4];
            const float a[4] = {a4.x, a4.y, a4.z, a4.w}, b[4] = {b4.x, b4.y, b4.z, b4.w};
#pragma unroll
            for (int i = 0; i < 4; ++i)
#pragma unroll
                for (int j = 0; j < 4; ++j) acc[i][j] += a[i] * b[j];
        }
    }
#pragma unroll
    for (int i = 0; i < 4; ++i) {
        const int r = m0 + ty * 4 + i;
        if (r >= M) continue;
        float* crow = C + (size_t)(roff + r) * p.ldc + n0 + tx * 4;
        if (n0 + tx * 4 >= p.N) continue;
        float4 o = make_float4(acc[i][0] * p.alpha, acc[i][1] * p.alpha, acc[i][2] * p.alpha, acc[i][3] * p.alpha);
        if (p.accum) { const float4 old = *(const float4*)crow; o.x += old.x; o.y += old.y; o.z += old.z; o.w += old.w; }
        *(float4*)crow = o;
    }
}

struct RowB {
    const float* xin_lat; const float* xin_ctx;
    float* xl; float* xc;
    const float* Y; const int* tok_slot; const float* tok_gate;
    const float* mods_prev;
    const float* mods_next;
    const float* normw;
    float* h; float* out;
    int row0; int mode;
};
__global__ void __launch_bounds__(256) k_rowB(RowB p) {
    __shared__ float red[4];
    const int r = p.row0 + blockIdx.x, tid = threadIdx.x;
    const int mr = row_mod(r);
    float* xs = r < NCTX ? p.xc + (size_t)r * DM : p.xl + (size_t)(r - NCTX) * DM;
    float4 x;
    if (p.mode == 0) { const float* src = r < NCTX ? p.xin_ctx + (size_t)r * DM : p.xin_lat + (size_t)(r - NCTX) * DM; x = *(const float4*)(src + tid * 4); }
    else {
        x = *(const float4*)(xs + tid * 4);
        const int s0 = p.tok_slot[r * 2], s1 = p.tok_slot[r * 2 + 1]; const float g0 = p.tok_gate[r * 2], g1 = p.tok_gate[r * 2 + 1];
        const float4 y0 = *(const float4*)(p.Y + (size_t)s0 * DM + tid * 4), y1 = *(const float4*)(p.Y + (size_t)s1 * DM + tid * 4);
        const float4 g2 = *(const float4*)(p.mods_prev + (size_t)mr * 6144 + 5 * DM + tid * 4);
        x.x += g2.x * (g0 * y0.x + g1 * y1.x); x.y += g2.y * (g0 * y0.y + g1 * y1.y); x.z += g2.z * (g0 * y0.z + g1 * y1.z); x.w += g2.w * (g0 * y0.w + g1 * y1.w);
    }
    const float ss = block_sum256(x.x * x.x + x.y * x.y + x.z * x.z + x.w * x.w, red);
    const float rs = rsqrtf(ss * (1.f / DM) + EPS);
    const float4 w = *(const float4*)(p.normw + tid * 4);
    float4 n = make_float4(x.x * rs * w.x, x.y * rs * w.y, x.z * rs * w.z, x.w * rs * w.w);
    if (p.mode == 2) { *(float4*)(p.out + (size_t)(r - NCTX) * DM + tid * 4) = n; return; }
    *(float4*)(xs + tid * 4) = x;
    const float4 sh = *(const float4*)(p.mods_next + (size_t)mr * 6144 + 0 * DM + tid * 4), sc = *(const float4*)(p.mods_next + (size_t)mr * 6144 + 1 * DM + tid * 4);
    n.x = n.x * (1.f + sc.x) + sh.x; n.y = n.y * (1.f + sc.y) + sh.y; n.z = n.z * (1.f + sc.z) + sh.z; n.w = n.w * (1.f + sc.w) + sh.w;
    *(float4*)(p.h + (size_t)r * DM + tid * 4) = n;
}

struct RowA {
    float* xl; float* xc; const float* y; const float* mods; const float* normw;
    const float* wg; const float* bg; const float* we; const float* be;
    float* h2; int* cnt; int* tok_e; int* tok_rank; float* tok_gate; int row0;
};
__global__ void __launch_bounds__(256) k_rowA(RowA p) {
    __shared__ float red[4];
    __shared__ float part[36][257];
    __shared__ float logit[36];
    const int r = p.row0 + blockIdx.x, tid = threadIdx.x, mr = row_mod(r);
    float* xs = r < NCTX ? p.xc + (size_t)r * DM : p.xl + (size_t)(r - NCTX) * DM;
    float4 x = *(const float4*)(xs + tid * 4);
    const float4 y = *(const float4*)(p.y + (size_t)r * DM + tid * 4);
    const float* md = p.mods + (size_t)mr * 6144;
    const float4 g1 = *(const float4*)(md + 2 * DM + tid * 4);
    x.x += g1.x * y.x; x.y += g1.y * y.y; x.z += g1.z * y.z; x.w += g1.w * y.w;
    *(float4*)(xs + tid * 4) = x;
    const float ss = block_sum256(x.x * x.x + x.y * x.y + x.z * x.z + x.w * x.w, red);
    const float rs = rsqrtf(ss * (1.f / DM) + EPS);
    const float4 w = *(const float4*)(p.normw + tid * 4), sh = *(const float4*)(md + 3 * DM + tid * 4), sc = *(const float4*)(md + 4 * DM + tid * 4);
    float hv[4];
    hv[0] = x.x * rs * w.x * (1.f + sc.x) + sh.x; hv[1] = x.y * rs * w.y * (1.f + sc.y) + sh.y; hv[2] = x.z * rs * w.z * (1.f + sc.z) + sh.z; hv[3] = x.w * rs * w.w * (1.f + sc.w) + sh.w;
    *(float4*)(p.h2 + (size_t)r * DM + tid * 4) = make_float4(hv[0], hv[1], hv[2], hv[3]);
    float a[36];
#pragma unroll
    for (int j = 0; j < 36; ++j) a[j] = 0.f;
#pragma unroll
    for (int i = 0; i < 4; ++i) {
        const int k = tid * 4 + i;
        const float4 g = *(const float4*)(p.wg + (size_t)k * 4);
        a[0] += hv[i] * g.x; a[1] += hv[i] * g.y; a[2] += hv[i] * g.z; a[3] += hv[i] * g.w;
#pragma unroll
        for (int j = 0; j < 8; ++j) { const float4 e = *(const float4*)(p.we + (size_t)k * 32 + j * 4); a[4 + j * 4] += hv[i] * e.x; a[5 + j * 4] += hv[i] * e.y; a[6 + j * 4] += hv[i] * e.z; a[7 + j * 4] += hv[i] * e.w; }
    }
#pragma unroll
    for (int j = 0; j < 36; ++j) part[j][tid] = a[j];
    __syncthreads();
    if (tid < 36) { float s = 0.f; for (int i = 0; i < 256; ++i) s += part[tid][i]; logit[tid] = s + (tid < 4 ? p.bg[tid] : p.be[tid - 4]); }
    __syncthreads();
    if (tid == 0) {
        int grp = 0; float mx = logit[0];
        for (int g = 1; g < 4; ++g) if (logit[g] > mx) { mx = logit[g]; grp = g; }
        float den = 0.f; for (int g = 0; g < 4; ++g) den += expf(logit[g] - mx);
        const float pg = 1.f / den;
        const float* le = logit + 4 + grp * 8;
        int i0 = 0; float l0 = le[0];
        for (int i = 1; i < 8; ++i) if (le[i] > l0) { l0 = le[i]; i0 = i; }
        int i1 = -1; float l1 = -INFINITY;
        for (int i = 0; i < 8; ++i) if (i != i0 && le[i] > l1) { l1 = le[i]; i1 = i; }
        const float e1 = expf(l1 - l0), inv = 1.f / (1.f + e1);
        const int ex0 = grp * 8 + i0, ex1 = grp * 8 + i1;
        p.tok_e[r * 2] = ex0; p.tok_e[r * 2 + 1] = ex1;
        p.tok_gate[r * 2] = pg * inv; p.tok_gate[r * 2 + 1] = pg * e1 * inv;
        p.tok_rank[r * 2] = atomicAdd(p.cnt + ex0, 1); p.tok_rank[r * 2 + 1] = atomicAdd(p.cnt + ex1, 1);
    }
}
__global__ void k_offsets(const int* cnt, int* off) { if (threadIdx.x == 0) { int s = 0; for (int e = 0; e < NEXP; ++e) { off[e] = s; s += cnt[e]; } } }
__global__ void k_scatter(const int* tok_e, const int* tok_rank, const int* off, int* slot_tok, int* tok_slot, int row0, int nrows) {
    const int i = blockIdx.x * blockDim.x + threadIdx.x;
    if (i >= nrows * 2) return;
    const int r = row0 + (i >> 1), k = i & 1;
    const int s = off[tok_e[r * 2 + k]] + tok_rank[r * 2 + k];
    slot_tok[s] = r; tok_slot[r * 2 + k] = s;
}
__global__ void k_silu_mul(const float* __restrict__ G, const float* __restrict__ U, float* __restrict__ H, size_t n) {
    const size_t i = (size_t)blockIdx.x * blockDim.x + threadIdx.x;
    if (i < n) H[i] = siluf(G[i]) * U[i];
}

__global__ void k_rope(float* __restrict__ lat) {
    const int r = blockIdx.x;
    const int tid = threadIdx.x;
    const int qk = tid >> 8, h = (tid >> 6) & 3, j = tid & 63;
    float* base = lat + (size_t)r * EIN + qk * 512 + h * 128;
    float x1 = base[j], x2 = base[j + 64];
    const float scale = qk == 0 ? 0.08838834764831845f : 1.f;
    if (r >= NCTX) {
        const int t = (r - NCTX) % SEQ;
        const int f = j & 31; const float pos = (j < 32) ? (float)(t / 64) : (float)(t % 64);
        const float inv = powf(10000.f, -(float)f / 32.f);
        const float ang = pos * inv; const float c = cosf(ang), s = sinf(ang);
        const float o1 = x1 * c - x2 * s, o2 = x1 * s + x2 * c; x1 = o1; x2 = o2;
    }
    base[j] = x1 * scale; base[j + 64] = x2 * scale;
}

__global__ void __launch_bounds__(256) k_ret(const float* __restrict__ lat, const float* __restrict__ decay_logit, float* __restrict__ O) {
    extern __shared__ float sm[];
    float* Qs = sm; float* Ks = Qs + 64 * 128; float* Vs = Ks + 64 * 128; float* Ss = Vs + 64 * 128;
    const int it = blockIdx.x, h = blockIdx.y, b = blockIdx.z, tid = threadIdx.x;
    float lg[2];
#pragma unroll
    for (int d = 0; d < 2; ++d) { const float x = decay_logit[d * 4 + h]; const float ls = -log1pf(expf(-x)); lg[d] = ls * 1.4426950408889634f; }
    auto srow = [&](int s) { return s < CT ? b * CT + s : NCTX + b * SEQ + (s - CT); };
    for (int i = tid; i < 64 * 128; i += 256) { const int q = i >> 7, d = i & 127; Qs[i] = lat[(size_t)srow(it * 64 + q) * EIN + h * 128 + d]; }
    float o[32];
#pragma unroll
    for (int i = 0; i < 32; ++i) o[i] = 0.f;
    const int qi = tid >> 2, sub = tid & 3;
    const int si = it * 64 + qi; const int p1i = si < CT ? CT - 1 - si : 2559 - si;
    const int njt = it < 4 ? 4 : 36;
    for (int jt = 0; jt < njt; ++jt) {
        __syncthreads();
        for (int i = tid; i < 64 * 128; i += 256) { const int q = i >> 7, d = i & 127; const size_t ro = (size_t)srow(jt * 64 + q) * EIN; Ks[i] = lat[ro + 512 + h * 128 + d]; Vs[i] = lat[ro + 1024 + h * 128 + d]; }
        __syncthreads();
        for (int kk = 0; kk < 16; ++kk) {
            const int j = sub * 16 + kk; const int sj = jt * 64 + j;
            float dot = 0.f;
            for (int d = 0; d < 128; ++d) dot += Qs[qi * 128 + d] * Ks[j * 128 + d];
            const int p1j = sj < CT ? CT - 1 - sj : 2559 - sj;
            float w = 0.f;
            if (sj <= si) w += exp2f(lg[0] * (float)(si - sj));
            if (p1j <= p1i) w += exp2f(lg[1] * (float)(p1i - p1j));
            Ss[qi * 65 + j] = dot * w;
        }
        __syncthreads();
        for (int j = 0; j < 64; ++j) {
            const float s = Ss[qi * 65 + j];
#pragma unroll
            for (int dd = 0; dd < 32; ++dd) o[dd] += s * Vs[j * 128 + sub * 32 + dd];
        }
    }
    float* orow = O + (size_t)srow(si) * 512 + h * 128 + sub * 32;
#pragma unroll
    for (int dd = 0; dd < 32; ++dd) orow[dd] = o[dd];
}
__global__ void __launch_bounds__(256) k_gn_gate(const float* __restrict__ O, const float* __restrict__ lat, const float* __restrict__ gnw, float* __restrict__ mix) {
    const int wv = blockIdx.x * 4 + (threadIdx.x >> 6), lane = threadIdx.x & 63;
    const int r = wv >> 2, h = wv & 3;
    const float* o = O + (size_t)r * 512 + h * 128;
    float a = o[lane], b = o[lane + 64];
    float s = a + b;
#pragma unroll
    for (int m = 32; m > 0; m >>= 1) s += __shfl_xor(s, m);
    const float mu = s * (1.f / 128.f);
    a -= mu; b -= mu;
    float q = a * a + b * b;
#pragma unroll
    for (int m = 32; m > 0; m >>= 1) q += __shfl_xor(q, m);
    const float rs = rsqrtf(q * (1.f / 128.f) + EPS);
    const float* g = lat + (size_t)r * EIN + 1536 + h * 128;
    mix[(size_t)r * DM + h * 128 + lane] = a * rs * gnw[h * 128 + lane] * siluf(g[lane]);
    mix[(size_t)r * DM + h * 128 + lane + 64] = b * rs * gnw[h * 128 + lane + 64] * siluf(g[lane + 64]);
}

struct DnPrep { const float* lat; const float* convw; const float* a_log; const float* dt_bias; float* QN; float* KN; float* VV; float* beta; float* glog; };
__global__ void __launch_bounds__(256) k_dn_prep(DnPrep p) {
    __shared__ float buf[1536];
    __shared__ float nrm[8];
    const int r = blockIdx.x, tid = threadIdx.x;
    const bool isctx = r < NCTX; const int T = isctx ? CT : SEQ; const int t = isctx ? r % CT : (r - NCTX) % SEQ;
    const float* x0 = p.lat + (size_t)r * OIN;
    for (int i = 0; i < 6; ++i) {
        const int c = tid + 256 * i;
        float y = p.convw[1536 + c] * x0[c];
        if (t > 0) y += p.convw[c] * x0[c - OIN];
        if (t < T - 1) y += p.convw[2 * 1536 + c] * x0[c + OIN];
        buf[c] = siluf(y);
    }
    __syncthreads();
    const int wv = tid >> 6, lane = tid & 63;
    for (int gi = 0; gi < 2; ++gi) {
        const int g = wv * 2 + gi;
        float a = buf[g * 128 + lane], b = buf[g * 128 + lane + 64];
        float s = a * a + b * b;
#pragma unroll
        for (int m = 32; m > 0; m >>= 1) s += __shfl_xor(s, m);
        if (lane == 0) nrm[g] = rsqrtf(s + EPS);
    }
    __syncthreads();
    for (int i = 0; i < 6; ++i) {
        const int c = tid + 256 * i;
        if (c < 512) p.QN[(size_t)r * 512 + c] = buf[c] * nrm[c >> 7] * 0.08838834764831845f;
        else if (c < 1024) p.KN[(size_t)r * 512 + c - 512] = buf[c] * nrm[c >> 7];
        else p.VV[(size_t)r * 512 + c - 1024] = buf[c];
    }
    if (tid < 8) {
        const int d = tid >> 2, h = tid & 3;
        const float a = x0[2048 + d * 4 + h], bt = x0[2048 + 8 + d * 4 + h];
        const float z = a + p.dt_bias[d * 4 + h];
        const float sp = z > 20.f ? z : log1pf(expf(z));
        p.beta[((size_t)d * NTOK + r) * 4 + h] = 1.f / (1.f + expf(-bt));
        p.glog[((size_t)d * NTOK + r) * 4 + h] = -expf(p.a_log[d * 4 + h]) * sp;
    }
}
__global__ void __launch_bounds__(128) k_dn_scan(const float* __restrict__ QN, const float* __restrict__ KN, const float* __restrict__ VV, const float* __restrict__ beta, const float* __restrict__ glog, float* __restrict__ O0, float* __restrict__ O1) {
    __shared__ float ks[32][128]; __shared__ float qs[32][128]; __shared__ float vs[32][128]; __shared__ float al[32]; __shared__ float be[32];
    const int b = blockIdx.x >> 3, h = (blockIdx.x >> 1) & 3, dir = blockIdx.x & 1, tid = threadIdx.x;
    float S[128];
#pragma unroll
    for (int i = 0; i < 128; ++i) S[i] = 0.f;
    float* Od = dir ? O1 : O0;
    const int nsteps = CT + SEQ;
    for (int s0 = 0; s0 < nsteps; s0 += 32) {
        __syncthreads();
        for (int i = 0; i < 32; ++i) {
            const int s = s0 + i;
            int r;
            if (s < CT) r = b * CT + (dir ? CT - 1 - s : s); else { const int t = s - CT; r = NCTX + b * SEQ + (dir ? SEQ - 1 - t : t); }
            ks[i][tid] = KN[(size_t)r * 512 + h * 128 + tid]; qs[i][tid] = QN[(size_t)r * 512 + h * 128 + tid]; vs[i][tid] = VV[(size_t)r * 512 + h * 128 + tid];
            if (tid == 0) { al[i] = expf(glog[((size_t)dir * NTOK + r) * 4 + h]); be[i] = beta[((size_t)dir * NTOK + r) * 4 + h]; }
        }
        __syncthreads();
        for (int i = 0; i < 32; ++i) {
            const float a = al[i], bt = be[i];
            float kS = 0.f;
#pragma unroll
            for (int d = 0; d < 128; ++d) { S[d] *= a; kS += ks[i][d] * S[d]; }
            const float vn = bt * (vs[i][tid] - kS);
            float o = 0.f;
#pragma unroll
            for (int d = 0; d < 128; ++d) { S[d] += ks[i][d] * vn; o += qs[i][d] * S[d]; }
            const int s = s0 + i;
            if (s >= CT) { const int t = s - CT; const int r = b * SEQ + (dir ? SEQ - 1 - t : t); Od[(size_t)r * 512 + h * 128 + tid] = o; }
        }
    }
}
__global__ void __launch_bounds__(256) k_ghn(const float* __restrict__ O0, const float* __restrict__ O1, const float* __restrict__ lat, const float* __restrict__ nw, float* __restrict__ mix) {
    const int wv = blockIdx.x * 4 + (threadIdx.x >> 6), lane = threadIdx.x & 63;
    const int rl = wv >> 2, h = wv & 3, r = NCTX + rl;
    const size_t oi = (size_t)rl * 512 + h * 128;
    const float a = O0[oi + lane] + O1[oi + lane], b = O0[oi + lane + 64] + O1[oi + lane + 64];
    float q = a * a + b * b;
#pragma unroll
    for (int m = 32; m > 0; m >>= 1) q += __shfl_xor(q, m);
    const float rs = rsqrtf(q * (1.f / 128.f) + EPS);
    const float* z = lat + (size_t)r * OIN + 1536 + h * 128;
    mix[(size_t)r * DM + h * 128 + lane] = a * rs * nw[lane] * siluf(z[lane]);
    mix[(size_t)r * DM + h * 128 + lane + 64] = b * rs * nw[lane + 64] * siluf(z[lane + 64]);
}
__global__ void __launch_bounds__(256) k_sgu_pre(const float* __restrict__ lat, float* __restrict__ mix) {
    const int wv = blockIdx.x * 4 + (threadIdx.x >> 6), lane = threadIdx.x & 63;
    const int rl = wv >> 2, g = wv & 3, r = NCTX + rl;
    const float* sp = lat + (size_t)r * OIN + 2576 + g * 128;
    float a = geluf(sp[lane]), b = geluf(sp[lane + 64]);
    float s = a + b;
#pragma unroll
    for (int m = 32; m > 0; m >>= 1) s += __shfl_xor(s, m);
    const float mu = s * (1.f / 128.f); a -= mu; b -= mu;
    float q = a * a + b * b;
#pragma unroll
    for (int m = 32; m > 0; m >>= 1) q += __shfl_xor(q, m);
    const float rs = rsqrtf(q * (1.f / 128.f) + EPS);
    mix[(size_t)r * DM + 512 + g * 128 + lane] = a * rs; mix[(size_t)r * DM + 512 + g * 128 + lane + 64] = b * rs;
}
__global__ void __launch_bounds__(256) k_sgu_post(const float* __restrict__ lat, const float* __restrict__ SG, const float* __restrict__ sgub, float* __restrict__ mix) {
    const int i = blockIdx.x * 256 + threadIdx.x;
    const int rl = i >> 9, j = i & 511, g = j >> 7, r = NCTX + rl, pp = (rl % SEQ) & 127;
    const float u = geluf(lat[(size_t)r * OIN + 2064 + j]);
    mix[(size_t)r * DM + 512 + j] = u * (SG[(size_t)rl * 512 + j] + sgub[g * 128 + pp]);
}

void gemm(hipStream_t st, const float* A, int lda, const float* B, int ldb, float* C, int ldc, int M, int N, int K, float alpha = 1.f, int accum = 0,
          int nb0 = 1, int nb1 = 1, long sA0 = 0, long sA1 = 0, long sB0 = 0, long sB1 = 0, long sC0 = 0, long sC1 = 0) {
    GemmP p{}; p.A = A; p.lda = lda; p.gather = nullptr; p.B = B; p.ldb = ldb; p.C = C; p.ldc = ldc; p.M = M; p.N = N; p.K = K; p.nb0 = nb0;
    p.sA0 = sA0; p.sA1 = sA1; p.sB0 = sB0; p.sB1 = sB1; p.sC0 = sC0; p.sC1 = sC1; p.cnt = nullptr; p.off = nullptr; p.a_rowoff = 0; p.alpha = alpha; p.accum = accum;
    dim3 grid((N + 63) / 64, (M + 63) / 64, nb0 * nb1);
    hipLaunchKernelGGL(k_gemm, grid, dim3(256), 0, st, p);
}
void gemm_moe(hipStream_t st, const float* A, int lda, const int* gather, int a_rowoff, const float* B, int ldb, long sB, float* C, int ldc, int N, int K, const int* cnt, const int* off, int maxM) {
    GemmP p{}; p.A = A; p.lda = lda; p.gather = gather; p.B = B; p.ldb = ldb; p.C = C; p.ldc = ldc; p.M = 0; p.N = N; p.K = K; p.nb0 = NEXP;
    p.sA0 = 0; p.sA1 = 0; p.sB0 = sB; p.sB1 = 0; p.sC0 = 0; p.sC1 = 0; p.cnt = cnt; p.off = off; p.a_rowoff = a_rowoff; p.alpha = 1.f; p.accum = 0;
    dim3 grid((N + 63) / 64, (maxM + 63) / 64, NEXP);
    hipLaunchKernelGGL(k_gemm, grid, dim3(256), 0, st, p);
}
}

extern "C" void kernel_launch(void* const* d_in, const int* in_sizes, int n_in, void* d_out, int out_size, void* d_ws, size_t ws_size, hipStream_t stream) {
    const float* x = (const float*)d_in[0]; const float* c = (const float*)d_in[1]; const float* ctx = (const float*)d_in[2]; const float* c_ctx = (const float*)d_in[3];
    const float* norm1_w = (const float*)d_in[4]; const float* norm2_w = (const float*)d_in[5]; const float* ada_w = (const float*)d_in[6]; const float* ada_b = (const float*)d_in[7];
    const float* even_w_in = (const float*)d_in[8]; const float* ret_decay = (const float*)d_in[9]; const float* ret_gn_w = (const float*)d_in[10]; const float* even_w_out = (const float*)d_in[11];
    const float* odd_w_in = (const float*)d_in[12]; const float* dn_conv_w = (const float*)d_in[13]; const float* dn_a_log = (const float*)d_in[14]; const float* dn_dt_bias = (const float*)d_in[15];
    const float* dn_norm_w = (const float*)d_in[16]; const float* sgu_w = (const float*)d_in[17]; const float* sgu_b = (const float*)d_in[18]; const float* odd_w_out = (const float*)d_in[19];
    const float* router_g_w = (const float*)d_in[20]; const float* router_g_b = (const float*)d_in[21]; const float* router_e_w = (const float*)d_in[22]; const float* router_e_b = (const float*)d_in[23];
    const float* moe_w_gate = (const float*)d_in[24]; const float* moe_w_up = (const float*)d_in[25]; const float* moe_w_down = (const float*)d_in[26]; const float* final_norm_w = (const float*)d_in[27];
    float* out = (float*)d_out;
    char* ws = (char*)d_ws;
    size_t o = 0;
    auto carve = [&](size_t bytes) { char* p = ws + o; o += (bytes + 255) & ~(size_t)255; return p; };
    int* cnt = (int*)carve(2 * NEXP * 4); int* offs = (int*)carve(2 * NEXP * 4);
    float* mods = (float*)carve((size_t)2 * 9 * 6144 * 4);
    int* tok_e = (int*)carve((size_t)NTOK * 2 * 4); int* tok_rank = (int*)carve((size_t)NTOK * 2 * 4); int* tok_slot = (int*)carve((size_t)NTOK * 2 * 4); float* tok_gate = (float*)carve((size_t)NTOK * 2 * 4);
    int* slot_tok = (int*)carve((size_t)NTOK * 2 * 4);
    float* beta = (float*)carve((size_t)2 * NTOK * 4 * 4); float* glog = (float*)carve((size_t)2 * NTOK * 4 * 4);
    float* tabC = (float*)carve((size_t)2 * 128 * 128 * 4); float* tab256 = (float*)carve((size_t)2 * 256 * 256 * 4);
    float* xc = (float*)carve((size_t)NCTX * DM * 4);
    float* BIG = (float*)carve((size_t)NTOK * OIN * 4);
    float* hB = (float*)carve((size_t)NTOK * DM * 4);
    float* HB = (float*)carve((size_t)NTOK * DM * 4);
    float* mixB = (float*)carve((size_t)NTOK * DM * 4);
    float* fourB = (float*)carve((size_t)2 * NLAT * 512 * 4);
    if (o > ws_size) { fprintf(stderr, "workspace too small: need %zu have %zu\n", o, ws_size); return; }
    float* tabT = fourB; float* Gc = fourB + (size_t)2 * 2048 * 2048; float* Gs = Gc + (size_t)2048 * 512;

    hipMemsetAsync(cnt, 0, 2 * NEXP * 4, stream);
    hipLaunchKernelGGL(k_mods, dim3(24, 2), dim3(256), 0, stream, c, c_ctx, ada_w, ada_b, mods);
    hipLaunchKernelGGL(k_trig, dim3((2048 * 2048 + 255) / 256), dim3(256), 0, stream, tabT, 2048);
    hipLaunchKernelGGL(k_trig, dim3((256 * 256 + 255) / 256), dim3(256), 0, stream, tab256, 256);
    hipLaunchKernelGGL(k_trig, dim3((128 * 128 + 255) / 256), dim3(256), 0, stream, tabC, 128);
    const float* mods0 = mods; const float* mods1 = mods + 9 * 6144;
    { RowB p{}; p.xin_lat = x; p.xin_ctx = ctx; p.xl = out; p.xc = xc; p.mods_next = mods0; p.normw = norm1_w; p.h = hB; p.row0 = 0; p.mode = 0;
      hipLaunchKernelGGL(k_rowB, dim3(NTOK), dim3(256), 0, stream, p); }
    float* lat = BIG;
    gemm(stream, hB, DM, even_w_in, EIN, lat, EIN, NTOK, EIN, DM);
    hipLaunchKernelGGL(k_rope, dim3(NTOK), dim3(512), 0, stream, lat);
    float* Oret = HB;
    static bool attr_set = false;
    if (!attr_set) { hipFuncSetAttribute((const void*)k_ret, hipFuncAttributeMaxDynamicSharedMemorySize, (3 * 64 * 128 + 64 * 65) * 4); attr_set = true; }
    hipLaunchKernelGGL(k_ret, dim3(36, 4, NB), dim3(256), (3 * 64 * 128 + 64 * 65) * 4, stream, lat, ret_decay, Oret);
    hipLaunchKernelGGL(k_gn_gate, dim3(NTOK), dim3(256), 0, stream, Oret, lat, ret_gn_w, mixB);
    for (int b = 0; b < NB; ++b) {
        for (int seqt = 0; seqt < 2; ++seqt) {
            const int T = seqt ? SEQ : CT; const int r0 = seqt ? NCTX + b * SEQ : b * CT; const float* tt = seqt ? tabT : tab256;
            const float* f = lat + (size_t)r0 * EIN + 2048;
            gemm(stream, f, EIN, tabC, 128, Gc, 512, T, 128, 128, 1.f, 0, 4, 1, 128, 0, 0, 0, 128, 0);
            gemm(stream, f, EIN, tabC + 128 * 128, 128, Gs, 512, T, 128, 128, 1.f, 0, 4, 1, 128, 0, 0, 0, 128, 0);
            float* Z = mixB + (size_t)r0 * DM + 512;
            gemm(stream, tt, T, Gc, 512, Z, DM, T, 512, T, 1.f, 0);
            gemm(stream, tt + (size_t)T * T, T, Gs, 512, Z, DM, T, 512, T, -1.f, 1);
        }
    }
    float* Yp = hB;
    gemm(stream, mixB, DM, even_w_out, DM, Yp, DM, NTOK, DM, DM);
    float* h2 = mixB;
    { RowA p{}; p.xl = out; p.xc = xc; p.y = Yp; p.mods = mods0; p.normw = norm2_w; p.wg = router_g_w; p.bg = router_g_b; p.we = router_e_w; p.be = router_e_b;
      p.h2 = h2; p.cnt = cnt; p.tok_e = tok_e; p.tok_rank = tok_rank; p.tok_gate = tok_gate; p.row0 = 0;
      hipLaunchKernelGGL(k_rowA, dim3(NTOK), dim3(256), 0, stream, p); }
    hipLaunchKernelGGL(k_offsets, dim3(1), dim3(64), 0, stream, cnt, offs);
    hipLaunchKernelGGL(k_scatter, dim3((NTOK * 2 + 255) / 256), dim3(256), 0, stream, tok_e, tok_rank, offs, slot_tok, tok_slot, 0, NTOK);
    float* Gb = BIG; float* Ub = BIG + (size_t)NTOK * 2 * HID; float* Hh = HB; float* Ym = BIG;
    gemm_moe(stream, h2, DM, slot_tok, 0, moe_w_gate, HID, (long)DM * HID, Gb, HID, HID, DM, cnt, offs, NTOK);
    gemm_moe(stream, h2, DM, slot_tok, 0, moe_w_up, HID, (long)DM * HID, Ub, HID, HID, DM, cnt, offs, NTOK);
    hipLaunchKernelGGL(k_silu_mul, dim3((unsigned)(((size_t)NTOK * 2 * HID + 255) / 256)), dim3(256), 0, stream, Gb, Ub, Hh, (size_t)NTOK * 2 * HID);
    gemm_moe(stream, Hh, HID, nullptr, 1, moe_w_down, DM, (long)HID * DM, Ym, DM, DM, HID, cnt, offs, NTOK);
    { RowB p{}; p.xl = out; p.xc = xc; p.Y = Ym; p.tok_slot = tok_slot; p.tok_gate = tok_gate; p.mods_prev = mods0; p.mods_next = mods1; p.normw = norm1_w + DM; p.h = hB; p.row0 = 0; p.mode = 1;
      hipLaunchKernelGGL(k_rowB, dim3(NTOK), dim3(256), 0, stream, p); }
    gemm(stream, hB, DM, odd_w_in, OIN, lat, OIN, NTOK, OIN, DM);
    float* KN = hB; float* VV = hB + (size_t)NTOK * 512; float* QN = HB; float* O0 = HB + (size_t)NTOK * 512; float* O1 = fourB + (size_t)NLAT * 512; float* SG = fourB;
    { DnPrep p{}; p.lat = lat; p.convw = dn_conv_w; p.a_log = dn_a_log; p.dt_bias = dn_dt_bias; p.QN = QN; p.KN = KN; p.VV = VV; p.beta = beta; p.glog = glog;
      hipLaunchKernelGGL(k_dn_prep, dim3(NTOK), dim3(256), 0, stream, p); }
    hipLaunchKernelGGL(k_sgu_pre, dim3(NLAT), dim3(256), 0, stream, lat, mixB);
    gemm(stream, sgu_w, 128, mixB + (size_t)NCTX * DM + 512, DM, SG, 512, 128, 128, 128, 1.f, 0, 4, 128, 128 * 128, 0, 128, (long)128 * DM, 128, (long)128 * 512);
    hipLaunchKernelGGL(k_sgu_post, dim3(NLAT * 512 / 256), dim3(256), 0, stream, lat, SG, sgu_b, mixB);
    hipLaunchKernelGGL(k_dn_scan, dim3(64), dim3(128), 0, stream, QN, KN, VV, beta, glog, O0, O1);
    hipLaunchKernelGGL(k_ghn, dim3(NLAT), dim3(256), 0, stream, O0, O1, lat, dn_norm_w, mixB);
    gemm(stream, mixB + (size_t)NCTX * DM, DM, odd_w_out, DM, Yp + (size_t)NCTX * DM, DM, NLAT, DM, DM);
    { RowA p{}; p.xl = out; p.xc = xc; p.y = Yp; p.mods = mods1; p.normw = norm2_w + DM; p.wg = router_g_w + DM * 4; p.bg = router_g_b + 4; p.we = router_e_w + DM * 32; p.be = router_e_b + 32;
      p.h2 = h2; p.cnt = cnt + NEXP; p.tok_e = tok_e; p.tok_rank = tok_rank; p.tok_gate = tok_gate; p.row0 = NCTX;
      hipLaunchKernelGGL(k_rowA, dim3(NLAT), dim3(256), 0, stream, p); }
    hipLaunchKernelGGL(k_offsets, dim3(1), dim3(64), 0, stream, cnt + NEXP, offs + NEXP);
    hipLaunchKernelGGL(k_scatter, dim3((NLAT * 2 + 255) / 256), dim3(256), 0, stream, tok_e, tok_rank, offs + NEXP, slot_tok, tok_slot, NCTX, NLAT);
    const size_t MW = (size_t)NEXP * DM * HID;
    gemm_moe(stream, h2, DM, slot_tok, 0, moe_w_gate + MW, HID, (long)DM * HID, Gb, HID, HID, DM, cnt + NEXP, offs + NEXP, NLAT);
    gemm_moe(stream, h2, DM, slot_tok, 0, moe_w_up + MW, HID, (long)DM * HID, Ub, HID, HID, DM, cnt + NEXP, offs + NEXP, NLAT);
    hipLaunchKernelGGL(k_silu_mul, dim3((unsigned)(((size_t)NLAT * 2 * HID + 255) / 256)), dim3(256), 0, stream, Gb, Ub, Hh, (size_t)NLAT * 2 * HID);
    gemm_moe(stream, Hh, HID, nullptr, 1, moe_w_down + MW, DM, (long)HID * DM, Ym, DM, DM, HID, cnt + NEXP, offs + NEXP, NLAT);
    { RowB p{}; p.xl = out; p.xc = xc; p.Y = Ym; p.tok_slot = tok_slot; p.tok_gate = tok_gate; p.mods_prev = mods1; p.normw = final_norm_w; p.out = out; p.row0 = NCTX; p.mode = 2;
      hipLaunchKernelGGL(k_rowB, dim3(NLAT), dim3(256), 0, stream, p); }
}
```

```cpp
#include <hip/hip_runtime.h>
#include <cstdio>
#include <cstdint>
#include <cmath>

#define GAS __attribute__((address_space(1)))
#define LAS __attribute__((address_space(3)))
typedef unsigned short bf16;
typedef unsigned v4u __attribute__((ext_vector_type(4)));
typedef unsigned v2u __attribute__((ext_vector_type(2)));
typedef float f32x4 __attribute__((ext_vector_type(4)));
typedef float f32x2 __attribute__((ext_vector_type(2)));
typedef short bf16x8 __attribute__((ext_vector_type(8)));
#define DI __device__ __forceinline__

#ifndef MK_ONE_LAUNCH
#define MK_ONE_LAUNCH 1
#endif

namespace {
constexpr int DM = 1024, NB = 8, SEQ = 2048, CT = 256;
constexpr int NCTX = NB * CT, NLAT = NB * SEQ, NTOK = NCTX + NLAT;
constexpr int EIN = 2560, OIN = 3088, L1N = 3072;
constexpr int NEXP = 32, HID = 512;
constexpr float EPS = 1e-6f;
constexpr float PI2 = 6.283185307179586f;
constexpr int NTHR = 512, NWAVES = 8;
constexpr int NSLOT = NTOK * 2 + 256;

constexpr size_t al(size_t x) { return (x + 255) & ~(size_t)255; }
constexpr size_t WS_CTL = 0, CTL_BYTES = 1u << 20;
constexpr size_t WS_MODS = WS_CTL + CTL_BYTES;
constexpr size_t WS_TOKE = WS_MODS + al((size_t)2 * 9 * 6144 * 4);
constexpr size_t WS_TOKR = WS_TOKE + al((size_t)NTOK * 2 * 4);
constexpr size_t WS_TOKG = WS_TOKR + al((size_t)NTOK * 2 * 4);
constexpr size_t WS_LIST = WS_TOKG + al((size_t)NTOK * 2 * 4);
constexpr size_t WS_BETA = WS_LIST + al((size_t)NEXP * NTOK * 4);
constexpr size_t WS_GLOG = WS_BETA + al((size_t)2 * NTOK * 4 * 4);
constexpr size_t WS_AB = WS_GLOG + al((size_t)2 * NTOK * 4 * 4);
constexpr size_t WS_ROPE = WS_AB + al((size_t)NTOK * 16 * 4);
constexpr size_t WS_TCH = WS_ROPE + al((size_t)2 * SEQ * 64 * 4);
constexpr size_t WS_T256 = WS_TCH + al((size_t)256 * 128 * 2);
constexpr size_t WS_WIN0 = WS_T256 + al((size_t)256 * 512 * 2);
constexpr size_t WS_WOUT0 = WS_WIN0 + al((size_t)EIN * DM * 2);
constexpr size_t WS_WIN1 = WS_WOUT0 + al((size_t)DM * DM * 2);
constexpr size_t WS_WOUT1 = WS_WIN1 + al((size_t)L1N * DM * 2);
constexpr size_t WS_WM1 = WS_WOUT1 + al((size_t)DM * DM * 2);
constexpr size_t WS_WM2 = WS_WM1 + al((size_t)NEXP * 1024 * DM * 2);
constexpr size_t WS_XC = WS_WM2 + al((size_t)NEXP * DM * HID * 2);
constexpr size_t WS_H = WS_XC + al((size_t)NCTX * DM * 4);
constexpr size_t WS_LAT = WS_H + al((size_t)NTOK * DM * 2);
constexpr size_t WS_MIX = WS_LAT + al((size_t)NTOK * L1N * 2);
constexpr size_t WS_FOUR = WS_MIX + al((size_t)NSLOT * HID * 2);
constexpr size_t FOUR_TRIG = 0, FOUR_GT = (size_t)SEQ * 4096 * 2, FOUR_GTC = FOUR_GT + (size_t)NB * 512 * 4096 * 2;
constexpr size_t WS_QN = WS_FOUR + ((size_t)64 << 20);
constexpr size_t WS_KN = WS_QN + al((size_t)NTOK * 512 * 4);
constexpr size_t WS_VV = WS_KN + al((size_t)NTOK * 512 * 4);
constexpr size_t WS_END = WS_VV + al((size_t)NTOK * 512 * 4);
static_assert(FOUR_GTC + (size_t)NB * 512 * 512 * 2 <= ((size_t)64 << 20), "four region");
static_assert((size_t)NSLOT * DM * 2 <= (size_t)NTOK * L1N * 2, "Y overlay");
constexpr int CW_BAR = 4096, CW_CNT = 16384;

constexpr int RING_BYTES = 131072, LDSCTL_OFF = RING_BYTES, LDS_BYTES = 147456;

DI float bf2f(unsigned short u) { return __uint_as_float((unsigned)u << 16); }
DI unsigned f2bf(float f) { unsigned u = __float_as_uint(f); return (u + 0x7fffu + ((u >> 16) & 1u)) >> 16; }
DI unsigned pk2(float lo, float hi) { return f2bf(lo) | (f2bf(hi) << 16); }
DI float siluf(float v) { return v / (1.f + __expf(-v)); }
DI float geluf(float v) { return 0.5f * v * (1.f + erff(v * 0.70710678118654752f)); }
DI int tid_opq(int wu) {
    int t; asm volatile("v_mbcnt_lo_u32_b32 %0, -1, 0\n\tv_mbcnt_hi_u32_b32 %0, -1, %0\n\tv_lshl_add_u32 %0, %1, 6, %0" : "=&v"(t) : "s"(wu)); return t; }
DI int row_mod(int r) { return r < NCTX ? 8 : (r - NCTX) / SEQ; }
DI float wave_sum(float v) {
#pragma unroll
    for (int o = 1; o < 64; o <<= 1) v += __shfl_xor(v, o);
    return v;
}
#define VM_WAIT() asm volatile("s_waitcnt vmcnt(0)" ::: "memory")
#define LDS_WAIT() asm volatile("s_waitcnt lgkmcnt(0)" ::: "memory")
#define RLX_AGENT __ATOMIC_RELAXED, __HIP_MEMORY_SCOPE_AGENT

#define XB_TMO      128
#define XB_XCNT(j)  (256  + 64 * (j))
#define XB_XSUB(j)  (1280 + 64 * (j))
#define XB_XGEN(j)  (2304 + 64 * (j))
#define XB_TOP      3328
#define XB_TOPGEN   3392
#define XCD_BAR_WORDS 3456
#define XB_SPIN_CAP (1u << 18)
DI unsigned xb_ld(unsigned* p)              { return __hip_atomic_load(p, __ATOMIC_RELAXED, __HIP_MEMORY_SCOPE_AGENT); }
DI unsigned xb_add(unsigned* p, unsigned v) { return __hip_atomic_fetch_add(p, v, __ATOMIC_RELAXED, __HIP_MEMORY_SCOPE_AGENT); }
DI unsigned xb_xcc_id() { return (unsigned)__builtin_amdgcn_s_getreg((3 << 11) | 20) & 0xFu; }
#define XB_SPIN(cond, bar) do { unsigned _sp = 0; while (cond) { __builtin_amdgcn_s_sleep(1); \
    if ((++_sp & 255u) == 0u) { if (xb_ld(&(bar)[XB_TMO])) break; if (_sp > XB_SPIN_CAP) { atomicAdd(&(bar)[XB_TMO], 1u); break; } } } } while (0)
struct XcdBarrier { unsigned* bar; unsigned x; volatile LAS unsigned* st; };
DI XcdBarrier xcd_barrier_post(unsigned* bar, volatile LAS unsigned* st, int tid0) {
    XcdBarrier b; b.bar = bar; b.x = xb_xcc_id(); b.st = st;
    if (tid0 == 0) (void)xb_add(&bar[XB_XCNT(b.x)], 1u);
    return b;
}
DI void xcd_barrier_complete(unsigned* bar, unsigned x, unsigned& nloc, unsigned& nx) {
    const unsigned G = gridDim.x * gridDim.y * gridDim.z;
    unsigned sum, cnt, mine, sp = 0u;
    for (;;) {
        sum = 0u; cnt = 0u; mine = 0u;
#pragma unroll
        for (unsigned j = 0; j < 16; ++j) { const unsigned c = xb_ld(&bar[XB_XCNT(j)]); sum += c; cnt += (c > 0u) ? 1u : 0u; mine = (j == x) ? c : mine; }
        if (sum == G) break;
        __builtin_amdgcn_s_sleep(1);
        if ((++sp & 255u) == 0u) { if (xb_ld(&bar[XB_TMO])) break; if (sp > XB_SPIN_CAP) { atomicAdd(&bar[XB_TMO], 1u); break; } }
    }
    nloc = mine > 0u ? mine : 1u; nx = cnt > 0u ? cnt : 1u;
}
DI void xcd_barrier(const XcdBarrier& b, int tid0) {
    asm volatile("s_waitcnt vmcnt(0)" ::: "memory");
    __syncthreads();
    if (tid0 == 0) {
        unsigned* bar = b.bar;
        __builtin_amdgcn_s_waitcnt(0);
        unsigned nloc = b.st[0], nx = b.st[1];
        if (nloc == 0u) { xcd_barrier_complete(bar, b.x, nloc, nx); b.st[0] = nloc; b.st[1] = nx; }
        const unsigned old = xb_add(&bar[XB_XSUB(b.x)], 1u);
        const unsigned gen = old / nloc;
        if (old + 1u == (gen + 1u) * nloc) {
            __builtin_amdgcn_fence(__ATOMIC_RELEASE, "agent");
            asm volatile("s_waitcnt vmcnt(0)" ::: "memory");
            const unsigned og = xb_add(&bar[XB_TOP], 1u);
            const unsigned tg = og / nx;
            if (og + 1u == (tg + 1u) * nx) xb_add(&bar[XB_TOPGEN], 1u);
            else XB_SPIN(xb_ld(&bar[XB_TOPGEN]) == tg, bar);
            __builtin_amdgcn_fence(__ATOMIC_ACQUIRE, "agent");
            xb_add(&bar[XB_XGEN(b.x)], 1u);
            asm volatile("s_waitcnt vmcnt(0)" ::: "memory");
        } else {
            XB_SPIN(xb_ld(&bar[XB_XGEN(b.x)]) == gen, bar);
            __builtin_amdgcn_fence(__ATOMIC_ACQUIRE, "agent");
            asm volatile("s_waitcnt vmcnt(0)" ::: "memory");
        }
    }
    __syncthreads();
}

namespace pg8 {
constexpr int BM = 256, BK = 64, HALF = 128, HTB = HALF * BK * 2, NXCD = 8, WGM = 8;
DI int lds_byte(int r, int c) { const int st = (r >> 4) * 2 + (c >> 5), rr = r & 15, cc = c & 31, ob = rr * 64 + cc * 2; return st * 1024 + (ob ^ (((ob >> 9) & 1) << 5)); }
DI void stage_rc(int b, int& R, int& C) { const int st = b / 1024, sb = b % 1024, swz = sb ^ (((sb >> 9) & 1) << 5); R = (st >> 1) * 16 + swz / 64; C = (st & 1) * 32 + (swz % 64) / 2; }
DI int perm32(int rho) { const int n = rho >> 4, i = rho & 15; return 8 * (i >> 2) + 4 * n + (i & 3); }

struct UnitG { const char* A; const char* B; const int* gl; int gvalid; int r0, c0, e0, e1; };
DI unsigned cvt_pk_bf16(float lo, float hi) { unsigned r; asm volatile("v_cvt_pk_bf16_f32 %0, %1, %2" : "=v"(r) : "v"(lo), "v"(hi)); return r; }

template <class Epi, class Sched, bool GATHER>
DI void gemm_phase(const int wu, LAS unsigned char* lds, const int K_, const int lda, const int ldb, const Sched& S, const Epi& E) {
    int K = K_; asm volatile("" : "+s"(K));
    int tid_ = tid_opq(wu);
    const int tid = tid_, wid = __builtin_amdgcn_readfirstlane(tid >> 6), lane = tid & 63, wr = wid >> 2, wc = wid & 3, fr = lane & 15, fq = lane >> 4;
    const int nt = K / BK;
    unsigned voffA[2][2], voffAn[2][2], voffB[2];
#pragma unroll
    for (int i = 0; i < 2; ++i) { int R, C; stage_rc(tid * 16 + i * 8192, R, C); const int Rb = Epi::PERM ? ((R & ~31) + perm32(R & 31)) : R;
        voffB[i] = (unsigned)(Rb * ldb + C) * 2u;
        voffA[0][i] = (unsigned)(R * lda + C) * 2u; voffA[1][i] = (unsigned)((R + HALF) * lda + C) * 2u; voffAn[0][i] = voffA[0][i]; voffAn[1][i] = voffA[1][i]; }
    const size_t kstep = (size_t)(BK * 2);
    const size_t hstepB = (size_t)HALF * ldb * 2;
    const unsigned ldsw = (unsigned)wid * 1024u;
    const int aoff = lds_byte(wr * 64 + fr, fq * 8), boff = lds_byte(wc * 32 + fr, fq * 8);
#define PG8_SA(b, h) (((b) * 2 + (h)) * HTB)
#define PG8_SB(b, h) ((4 + (b) * 2 + (h)) * HTB)
#define PG8_STAGEB(bufoff, gbase) do { _Pragma("unroll") for (int _i = 0; _i < 2; ++_i) \
        __builtin_amdgcn_global_load_lds((const unsigned*)((const char*)(gbase) + voffB[_i]), (LAS unsigned*)(lds + (bufoff) + ldsw + _i * 8192), 16, 0, 0); } while (0)
#define PG8_STAGEA(bufoff, gbase, v0, v1) do { \
        __builtin_amdgcn_global_load_lds((const unsigned*)((const char*)(gbase) + (v0)), (LAS unsigned*)(lds + (bufoff) + ldsw), 16, 0, 0); \
        __builtin_amdgcn_global_load_lds((const unsigned*)((const char*)(gbase) + (v1)), (LAS unsigned*)(lds + (bufoff) + ldsw + 8192), 16, 0, 0); } while (0)
#define PG8_LDA(dst, b, h) do { _Pragma("unroll") for (int m = 0; m < 4; ++m) _Pragma("unroll") for (int k = 0; k < 2; ++k) dst[m][k] = *(const LAS bf16x8*)(lds + PG8_SA(b, h) + aoff + m * 2048 + k * 1024); } while (0)
#define PG8_LDB(dst, b, h) do { _Pragma("unroll") for (int n = 0; n < 2; ++n) _Pragma("unroll") for (int k = 0; k < 2; ++k) dst[n][k] = *(const LAS bf16x8*)(lds + PG8_SB(b, h) + boff + n * 2048 + k * 1024); } while (0)
#define PG8_MMA(ai, bj, At, Bt) do { __builtin_amdgcn_s_setprio(1); _Pragma("unroll") for (int m = 0; m < 4; ++m) _Pragma("unroll") for (int n = 0; n < 2; ++n) _Pragma("unroll") for (int k = 0; k < 2; ++k) \
        acc[ai][bj][m][n] = __builtin_amdgcn_mfma_f32_16x16x32_bf16(Bt[n][k], At[m][k], acc[ai][bj][m][n], 0, 0, 0); __builtin_amdgcn_s_setprio(0); } while (0)
#define PG8_WAIT_V(n) asm volatile("s_waitcnt vmcnt(" #n ")" ::: "memory")
#define PG8_WAIT_L(n) asm volatile("s_waitcnt lgkmcnt(" #n ")" ::: "memory")
#define PG8_BAR __builtin_amdgcn_s_barrier()
#define PG8_SCHED __builtin_amdgcn_sched_barrier(0)
    UnitG cur, nxt; int ui = 0;
    if (!S.next(0, cur)) return;
    if constexpr (GATHER) {
#pragma unroll
        for (int h = 0; h < 2; ++h)
#pragma unroll
            for (int i = 0; i < 2; ++i) { int R, C; stage_rc(tid * 16 + i * 8192, R, C); int rr = h * HALF + R; rr = rr < cur.gvalid ? rr : cur.gvalid - 1; voffA[h][i] = (unsigned)(cur.gl[rr] * lda + C) * 2u; }
    }
    f32x4 acc[2][2][4][2];
#pragma unroll
    for (int a = 0; a < 2; ++a)
#pragma unroll
        for (int b = 0; b < 2; ++b)
#pragma unroll
            for (int m = 0; m < 4; ++m)
#pragma unroll
                for (int n = 0; n < 2; ++n) acc[a][b][m][n] = (f32x4){0.f, 0.f, 0.f, 0.f};
    bf16x8 At[4][2], B0[2][2], B1[2][2];
    const char* cA = cur.A; const char* cB = cur.B;
    PG8_STAGEB(PG8_SB(0, 0), cB); PG8_STAGEB(PG8_SB(0, 1), cB + hstepB); PG8_STAGEA(PG8_SA(0, 0), cA, voffA[0][0], voffA[0][1]); PG8_STAGEA(PG8_SA(0, 1), cA, voffA[1][0], voffA[1][1]);
    if (wr == 1) PG8_BAR;
    PG8_WAIT_V(2); PG8_BAR;
    PG8_STAGEB(PG8_SB(1, 0), cB + kstep); PG8_STAGEA(PG8_SA(1, 0), cA + kstep, voffA[0][0], voffA[0][1]); PG8_STAGEB(PG8_SB(1, 1), cB + hstepB + kstep);
    PG8_WAIT_V(6); PG8_BAR;
    for (;;) {
        const bool has_next = S.next(ui + 1, nxt);
        const char* nA = has_next ? nxt.A : cA; const char* nB = has_next ? nxt.B : cB;
        if constexpr (GATHER) {
            if (has_next) {
#pragma unroll
                for (int h = 0; h < 2; ++h)
#pragma unroll
                    for (int i = 0; i < 2; ++i) { int R, C; stage_rc(tid * 16 + i * 8192, R, C); int rr = h * HALF + R; rr = rr < nxt.gvalid ? rr : nxt.gvalid - 1; voffAn[h][i] = (unsigned)(nxt.gl[rr] * lda + C) * 2u; }
            } else {
#pragma unroll
                for (int h = 0; h < 2; ++h)
#pragma unroll
                    for (int i = 0; i < 2; ++i) voffAn[h][i] = voffA[h][i];
            }
        }
        for (int t = 0; t < nt; t += 2) {
            const bool last = (t == nt - 2);
            const char* a1 = cA + (size_t)(t + 1) * kstep;
            const char* a2 = last ? nA : cA + (size_t)(t + 2) * kstep; const char* b2 = last ? nB : cB + (size_t)(t + 2) * kstep;
            const char* a3 = a2 + kstep; const char* b3 = b2 + kstep;
            PG8_LDB(B0, 0, 0); PG8_LDB(B1, 0, 1); PG8_SCHED; PG8_LDA(At, 0, 0); PG8_STAGEA(PG8_SA(1, 1), a1, voffA[1][0], voffA[1][1]);
            PG8_WAIT_V(8); PG8_WAIT_L(0); PG8_BAR; PG8_MMA(0, 0, At, B0); PG8_MMA(0, 1, At, B1); PG8_BAR; PG8_SCHED;
            if constexpr (GATHER) { if (last) { voffA[0][0] = voffAn[0][0]; voffA[0][1] = voffAn[0][1]; voffA[1][0] = voffAn[1][0]; voffA[1][1] = voffAn[1][1]; } }
            PG8_LDA(At, 0, 1); PG8_STAGEB(PG8_SB(0, 0), b2); PG8_STAGEB(PG8_SB(0, 1), b2 + hstepB); PG8_STAGEA(PG8_SA(0, 0), a2, voffA[0][0], voffA[0][1]);
            PG8_WAIT_V(8); PG8_WAIT_L(0); PG8_BAR; PG8_MMA(1, 0, At, B0); PG8_MMA(1, 1, At, B1); PG8_BAR; PG8_SCHED;
            PG8_LDB(B0, 1, 0); PG8_LDB(B1, 1, 1); PG8_SCHED; PG8_LDA(At, 1, 0); PG8_STAGEA(PG8_SA(0, 1), a2, voffA[1][0], voffA[1][1]);
            PG8_WAIT_V(8); PG8_WAIT_L(0); PG8_BAR; PG8_MMA(0, 0, At, B0); PG8_MMA(0, 1, At, B1); PG8_BAR; PG8_SCHED;
            PG8_LDA(At, 1, 1); PG8_STAGEB(PG8_SB(1, 0), b3); PG8_STAGEB(PG8_SB(1, 1), b3 + hstepB); PG8_STAGEA(PG8_SA(1, 0), a3, voffA[0][0], voffA[0][1]);
            PG8_WAIT_V(8); PG8_WAIT_L(0); PG8_BAR; PG8_MMA(1, 0, At, B0); PG8_MMA(1, 1, At, B1); PG8_BAR; PG8_SCHED;
        }
        if (wr == 0) PG8_BAR;
        E(acc, cur, wr, wc, fr, fq);
        if (!has_next) break;
#pragma unroll
        for (int a = 0; a < 2; ++a)
#pragma unroll
            for (int b = 0; b < 2; ++b)
#pragma unroll
                for (int m = 0; m < 4; ++m)
#pragma unroll
                    for (int n = 0; n < 2; ++n) acc[a][b][m][n] = (f32x4){0.f, 0.f, 0.f, 0.f};
        cur = nxt; cA = nA; cB = nB; ++ui;
        if (wr == 1) PG8_BAR;
    }
    PG8_WAIT_V(0);
    PG8_BAR;
#undef PG8_SA
#undef PG8_SB
#undef PG8_STAGEA
#undef PG8_STAGEB
#undef PG8_LDA
#undef PG8_LDB
#undef PG8_MMA
#undef PG8_WAIT_V
#undef PG8_WAIT_L
#undef PG8_BAR
#undef PG8_SCHED
}

DI bool static_order(int nM, int nN, int G, int c, int i, int& pm, int& pn) {
    const int nwg = nM * nN; const long L = (long)i * G + c; if (L >= nwg) return false;
    int wgid = (int)L; { const int q = nwg / NXCD, r = nwg % NXCD, xcd = wgid % NXCD, off = wgid / NXCD; wgid = (xcd < r ? xcd * (q + 1) : r * (q + 1) + (xcd - r) * q) + off; }
    const int nig = WGM * nN, gid = wgid / nig, fm = gid * WGM, gsz = (nM - fm) < WGM ? (nM - fm) : WGM;
    pm = fm + ((wgid % nig) % gsz); pn = (wgid % nig) / gsz; return true;
}
struct SchedDense {
    const char* A; const char* Bt; int lda, ldb; int pm0, nM, pn0, nN; int pm0b, nMb, pn0b, nNb; int G, c;
    DI bool next(int i, UnitG& u) const {
        int pm, pn; const int n1 = nM * nN;
        const long L = (long)i * G + c;
        if (L < n1) { static_order(nM, nN, G, c, i, pm, pn); pm += pm0; pn += pn0; }
        else { const long L2 = L - n1; if (L2 >= (long)nMb * nNb) return false; pm = pm0b + (int)(L2 % nMb); pn = pn0b + (int)(L2 / nMb); }
        u.A = A + (size_t)pm * BM * lda * 2; u.B = Bt + (size_t)pn * BM * ldb * 2; u.gl = nullptr; u.gvalid = BM; u.r0 = pm * BM; u.c0 = pn * BM; u.e0 = BM; u.e1 = 0; return true;
    }
};
struct EpiBf16G {
    static constexpr bool PERM = true;
    bf16* O; int ldc; int coff;
    DI void operator()(const f32x4 (&acc)[2][2][4][2], const UnitG& u, int wr, int wc, int fr, int fq) const {
        const int col0 = u.c0 + coff + wc * 32 + 8 * fq;
#pragma unroll
        for (int ai = 0; ai < 2; ++ai)
#pragma unroll
            for (int m = 0; m < 4; ++m) { const int lr = ai * HALF + wr * 64 + m * 16 + fr;
                if (lr < u.e0) { bf16* rowp = O + (size_t)(u.r0 + lr) * ldc + col0;
#pragma unroll
                    for (int bj = 0; bj < 2; ++bj) { const f32x4 v0 = acc[ai][bj][m][0], v1 = acc[ai][bj][m][1];
                        v4u w; w.x = cvt_pk_bf16(v0[0], v0[1]); w.y = cvt_pk_bf16(v0[2], v0[3]); w.z = cvt_pk_bf16(v1[0], v1[1]); w.w = cvt_pk_bf16(v1[2], v1[3]);
                        *(v4u*)(rowp + bj * HALF) = w; } } }
    }
};
struct EpiSwi {
    static constexpr bool PERM = true;
    bf16* O; int ldc;
    DI void operator()(const f32x4 (&acc)[2][2][4][2], const UnitG& u, int wr, int wc, int fr, int fq) const {
        const int col0 = u.c0 + wc * 32 + 8 * fq;
#pragma unroll
        for (int ai = 0; ai < 2; ++ai)
#pragma unroll
            for (int m = 0; m < 4; ++m) { const int lr = ai * HALF + wr * 64 + m * 16 + fr;
                if (lr < u.e0) { bf16* rowp = O + (size_t)(u.r0 + lr) * ldc + col0;
                    float o[8];
#pragma unroll
                    for (int n = 0; n < 2; ++n)
#pragma unroll
                        for (int j = 0; j < 4; ++j) { const float g = acc[ai][0][m][n][j], up = acc[ai][1][m][n][j]; o[n * 4 + j] = siluf(g) * up; }
                    v4u w; w.x = cvt_pk_bf16(o[0], o[1]); w.y = cvt_pk_bf16(o[2], o[3]); w.z = cvt_pk_bf16(o[4], o[5]); w.w = cvt_pk_bf16(o[6], o[7]);
                    *(v4u*)rowp = w; } }
    }
};
struct EpiResid {
    static constexpr bool PERM = false;
    float* xl; float* xc; const float* mods;
    DI void operator()(const f32x4 (&acc)[2][2][4][2], const UnitG& u, int wr, int wc, int fr, int fq) const {
        const int col0 = u.c0 + wc * 32 + 4 * fq;
#pragma unroll
        for (int ai = 0; ai < 2; ++ai)
#pragma unroll
            for (int m = 0; m < 4; ++m) { const int row = u.r0 + ai * HALF + wr * 64 + m * 16 + fr;
                float* xr = (row < NCTX ? xc + (size_t)row * DM : xl + (size_t)(row - NCTX) * DM) + col0;
                const float* g1 = mods + (size_t)row_mod(row) * 6144 + 2 * DM + col0;
#pragma unroll
                for (int bj = 0; bj < 2; ++bj)
#pragma unroll
                    for (int n = 0; n < 2; ++n) { const int o = bj * HALF + n * 16; const f32x4 g = *(const f32x4*)(g1 + o); f32x4 x = *(const f32x4*)(xr + o); x = x + g * acc[ai][bj][m][n]; *(f32x4*)(xr + o) = x; } }
    }
};
template <int ISCTX> struct EpiChan {
    static constexpr bool PERM = false;
    bf16* GT;
    DI void operator()(const f32x4 (&acc)[2][2][4][2], const UnitG& u, int wr, int wc, int fr, int fq) const {
        constexpr int T = ISCTX ? CT : SEQ, ld = 2 * T;
        const int g = u.e0, j = u.e1;
        bf16* base = ISCTX ? GT + (size_t)j * 512 * ld : GT + (size_t)(j >> 3) * 512 * ld + (j & 7) * 256;
        base += (size_t)(g * 128 + wr * 64 + fr) * ld + wc * 32 + 4 * fq;
#pragma unroll
        for (int ai = 0; ai < 2; ++ai)
#pragma unroll
            for (int m = 0; m < 4; ++m) {
                bf16* rowp = base + (size_t)(m * 16) * ld + ai * T;
#pragma unroll
                for (int bj = 0; bj < 2; ++bj)
#pragma unroll
                    for (int n = 0; n < 2; ++n) { const f32x4 v = acc[ai][bj][m][n]; v2u w; w.x = cvt_pk_bf16(v[0], v[1]); w.y = cvt_pk_bf16(v[2], v[3]); *(v2u*)(rowp + bj * HALF + n * 16) = w; } }
    }
};
}

struct Args { const float* in[28]; float* out; unsigned char* ws; int ph_lo, ph_hi; };
enum { I_X = 0, I_C, I_CTX, I_CCTX, I_N1W, I_N2W, I_ADAW, I_ADAB, I_EWIN, I_RDEC, I_RGNW, I_EWOUT, I_OWIN, I_CONVW, I_ALOG, I_DTB, I_DNNW, I_SGUW, I_SGUB, I_OWOUT,
       I_RGW, I_RGB, I_REW, I_REB, I_MWG, I_MWU, I_MWD, I_FNW };

DI void transpose_super(const float* __restrict__ W, int ldw, int k0, int n0, bf16* __restrict__ WT, int ldt, int mode, int dbase, LAS float* scr, int tid) {
    float4 v[8];
#pragma unroll
    for (int i = 0; i < 8; ++i) { const int idx = tid + 512 * i, kk = idx >> 6, n4 = idx & 63; v[i] = *(const float4*)(W + (size_t)(k0 + kk) * ldw + n0 + n4 * 4); }
#pragma unroll
    for (int i = 0; i < 8; ++i) { const int idx = tid + 512 * i, kk = idx >> 6, n4 = idx & 63; LAS float* d = scr + (n4 >> 4) * (64 * 65) + kk * 65 + (n4 & 15) * 4; d[0] = v[i].x; d[1] = v[i].y; d[2] = v[i].z; d[3] = v[i].w; }
    __syncthreads();
#pragma unroll
    for (int s = 0; s < 4; ++s) {
        const int n = tid >> 3, kc = tid & 7; const LAS float* src = scr + s * (64 * 65) + (kc * 8) * 65 + n;
        v4u o; o.x = pk2(src[0], src[65]); o.y = pk2(src[2 * 65], src[3 * 65]); o.z = pk2(src[4 * 65], src[5 * 65]); o.w = pk2(src[6 * 65], src[7 * 65]);
        const int j = n0 + s * 64 + n;
        const int drow = mode == 0 ? dbase + j : (((j >> 7) << 8) + dbase + (j & 127));
        *(v4u*)(WT + (size_t)drow * ldt + k0 + kc * 8) = o;
    }
    __syncthreads();
}
DI void moe_convert_item(const Args& a, int layer, int item, LAS float* scr, int tid) {
    const int e = item / 96, r = item % 96;
    bf16* WM1 = (bf16*)(a.ws + WS_WM1) + (size_t)e * 1024 * DM; bf16* WM2 = (bf16*)(a.ws + WS_WM2) + (size_t)e * DM * HID;
    if (r < 32) { const float* W = a.in[I_MWG] + ((size_t)layer * NEXP + e) * DM * HID; transpose_super(W, HID, (r >> 1) * 64, (r & 1) * 256, WM1, DM, 1, 0, scr, tid); }
    else if (r < 64) { const int q = r - 32; const float* W = a.in[I_MWU] + ((size_t)layer * NEXP + e) * DM * HID; transpose_super(W, HID, (q >> 1) * 64, (q & 1) * 256, WM1, DM, 1, 128, scr, tid); }
    else { const int q = r - 64; const float* W = a.in[I_MWD] + ((size_t)layer * NEXP + e) * HID * DM; transpose_super(W, DM, (q >> 2) * 64, (q & 3) * 256, WM2, HID, 0, 0, scr, tid); }
}
DI void phase_prep(const int wu, const Args& a, LAS unsigned char* lds) {
    const int tid = tid_opq(wu), bid = blockIdx.x, G = gridDim.x;
    {
        LAS float* s = (LAS float*)lds;
        LAS float* red = s + 9 * 1024;
        bool have = false;
        for (int task = bid; task < 192; task += G) {
            if (!have) { for (int i = tid; i < 9 * 1024; i += NTHR) { const int r = i >> 10, k = i & 1023; const float v = r < 8 ? a.in[I_C][r * 1024 + k] : a.in[I_CCTX][k]; s[i] = v / (1.f + expf(-v)); } have = true; __syncthreads(); }
            const int layer = task / 96, j0 = (task % 96) * 64;
            const int cg = tid & 15, kg = tid >> 4;
            float acc[9][4];
#pragma unroll
            for (int r = 0; r < 9; ++r)
#pragma unroll
                for (int q = 0; q < 4; ++q) acc[r][q] = 0.f;
            const float* W = a.in[I_ADAW] + (size_t)layer * 1024 * 6144 + j0 + cg * 4;
            for (int i = 0; i < 32; ++i) { const int k = kg + 32 * i; const float4 w = *(const float4*)(W + (size_t)k * 6144);
#pragma unroll
                for (int r = 0; r < 9; ++r) { const float sv = s[r * 1024 + k]; acc[r][0] += sv * w.x; acc[r][1] += sv * w.y; acc[r][2] += sv * w.z; acc[r][3] += sv * w.w; } }
#pragma unroll
            for (int r = 0; r < 9; ++r)
#pragma unroll
                for (int q = 0; q < 4; ++q) red[(kg * 9 + r) * 64 + cg * 4 + q] = acc[r][q];
            __syncthreads();
            for (int o = tid; o < 9 * 64; o += NTHR) { const int r = o >> 6, c = o & 63; float t = 0.f; for (int g = 0; g < 32; ++g) t += red[(g * 9 + r) * 64 + c];
                ((float*)(a.ws + WS_MODS))[((size_t)layer * 9 + r) * 6144 + j0 + c] = t + a.in[I_ADAB][layer * 6144 + j0 + c]; }
            __syncthreads();
        }
        __syncthreads();
    }
    {
        LAS float* scr = (LAS float*)lds;
        constexpr int I0 = 16 * 10, I1 = 16 * 4, I2 = 16 * 12, I3 = 16 * 4, IM = NEXP * 96;
        for (int it = bid; it < I0 + I1 + I2 + I3 + IM; it += G) {
            int r = it;
            if (r < I0) { transpose_super(a.in[I_EWIN], EIN, (r / 10) * 64, (r % 10) * 256, (bf16*)(a.ws + WS_WIN0), DM, 0, 0, scr, tid); continue; } r -= I0;
            if (r < I1) { transpose_super(a.in[I_EWOUT], DM, (r / 4) * 64, (r % 4) * 256, (bf16*)(a.ws + WS_WOUT0), DM, 0, 0, scr, tid); continue; } r -= I1;
            if (r < I2) { const int ns = r % 12; const int n0 = ns < 8 ? ns * 256 : 2064 + (ns - 8) * 256;
                transpose_super(a.in[I_OWIN], OIN, (r / 12) * 64, n0, (bf16*)(a.ws + WS_WIN1), DM, 0, ns * 256 - n0, scr, tid); continue; } r -= I2;
            if (r < I3) { transpose_super(a.in[I_OWOUT], DM, (r / 4) * 64, (r % 4) * 256, (bf16*)(a.ws + WS_WOUT1), DM, 0, 0, scr, tid); continue; } r -= I3;
            moe_convert_item(a, 0, r, scr, tid);
        }
    }
    {
        const int gt = bid * NTHR + tid, NT = G * NTHR;
        bf16* TR = (bf16*)(a.ws + WS_FOUR + FOUR_TRIG);
        for (int it = gt; it < SEQ * 4096 / 8; it += NT) { const int tp = it / 512, c8 = (it % 512) * 8; unsigned w[4];
#pragma unroll
            for (int q = 0; q < 4; ++q) { float v[2];
#pragma unroll
                for (int z = 0; z < 2; ++z) { const int col = c8 + q * 2 + z; const int t = col & 2047; const int m = (tp * t) & 2047; const float ang = (float)m * (PI2 / 2048.f);
                    v[z] = (col < 2048 ? __cosf(ang) : -__sinf(ang)) * 0.02209708691207961f; }
                w[q] = pk2(v[0], v[1]); }
            *(v4u*)(TR + (size_t)tp * 4096 + c8) = (v4u){w[0], w[1], w[2], w[3]}; }
        bf16* T256 = (bf16*)(a.ws + WS_T256);
        for (int it = gt; it < 256 * 512; it += NT) { const int tp = it / 512, col = it % 512; const int t = col & 255; const int m = (tp * t) & 255; const float ang = (float)m * (PI2 / 256.f);
            T256[it] = (bf16)f2bf((col < 256 ? __cosf(ang) : -__sinf(ang)) * 0.0625f); }
        bf16* TCH = (bf16*)(a.ws + WS_TCH);
        for (int it = gt; it < 256 * 128; it += NT) { const int rr = it / 128, c = it % 128; const int cp = rr & 127; const int m = (cp * c) & 127; const float ang = (float)m * (PI2 / 128.f);
            TCH[it] = (bf16)f2bf((rr < 128 ? __cosf(ang) : __sinf(ang)) * 0.08838834764831845f); }
        float* RC = (float*)(a.ws + WS_ROPE); float* RS = RC + SEQ * 64;
        for (int it = gt; it < SEQ * 64; it += NT) { const int t = it >> 6, j = it & 63; const int f = j & 31; const float pos = j < 32 ? (float)(t >> 6) : (float)(t & 63);
            const float inv = powf(10000.f, -(float)f / 32.f); float sn, cs; sincosf(pos * inv, &sn, &cs); RC[it] = cs; RS[it] = sn; }
    }
}

DI void moe_offsets_to_lds(const Args& a, int layer, LAS int* moff, int tid) {
    if (tid == 0) { const int* cnt = (const int*)(a.ws + WS_CTL) + CW_CNT + layer * NEXP; int s = 0; for (int e = 0; e < NEXP; ++e) { moff[e] = s; s += cnt[e]; } moff[NEXP] = s; }
    __syncthreads();
}
template <int MODE>
DI void phase_rowB(const int wu, const Args& a, LAS unsigned char* lds) {
    const int tid = tid_opq(wu), lane = tid & 63, wv = tid >> 6;
    LAS int* moff = (LAS int*)(lds + LDSCTL_OFF + 256);
    if (MODE != 0) moe_offsets_to_lds(a, MODE - 1, moff, tid);
    float* xl = a.out; float* xc = (float*)(a.ws + WS_XC);
    const float* modsP = (const float*)(a.ws + WS_MODS) + (MODE == 2 ? 9 * 6144 : 0);
    const float* modsN = (const float*)(a.ws + WS_MODS) + (MODE == 1 ? 9 * 6144 : 0);
    const float* normw = MODE == 2 ? a.in[I_FNW] : a.in[I_N1W] + (MODE == 1 ? DM : 0);
    const int* tok_e = (const int*)(a.ws + WS_TOKE); const int* tok_r = (const int*)(a.ws + WS_TOKR); const float* tok_g = (const float*)(a.ws + WS_TOKG);
    const bf16* Y = (const bf16*)(a.ws + WS_LAT);
    bf16* H = (bf16*)(a.ws + WS_H);
    const int row0 = MODE == 2 ? NCTX : 0;
    for (int r = row0 + blockIdx.x * NWAVES + wv; r < NTOK; r += gridDim.x * NWAVES) {
        const int mr = row_mod(r);
        float* xs = r < NCTX ? xc + (size_t)r * DM : xl + (size_t)(r - NCTX) * DM;
        f32x4 x[4];
        if (MODE == 0) { const float* src = r < NCTX ? a.in[I_CTX] + (size_t)r * DM : a.in[I_X] + (size_t)(r - NCTX) * DM;
#pragma unroll
            for (int j = 0; j < 4; ++j) x[j] = *(const f32x4*)(src + j * 256 + lane * 4); }
        else {
            const int s0 = moff[tok_e[r * 2]] + tok_r[r * 2], s1 = moff[tok_e[r * 2 + 1]] + tok_r[r * 2 + 1]; const float g0 = tok_g[r * 2], g1 = tok_g[r * 2 + 1];
#pragma unroll
            for (int j = 0; j < 4; ++j) { x[j] = *(const f32x4*)(xs + j * 256 + lane * 4);
                const v2u y0 = *(const v2u*)(Y + (size_t)s0 * DM + j * 256 + lane * 4), y1 = *(const v2u*)(Y + (size_t)s1 * DM + j * 256 + lane * 4);
                const f32x4 g2 = *(const f32x4*)(modsP + (size_t)mr * 6144 + 5 * DM + j * 256 + lane * 4);
                f32x4 mo; mo[0] = g0 * __uint_as_float(y0.x << 16) + g1 * __uint_as_float(y1.x << 16); mo[1] = g0 * __uint_as_float(y0.x & 0xffff0000u) + g1 * __uint_as_float(y1.x & 0xffff0000u);
                mo[2] = g0 * __uint_as_float(y0.y << 16) + g1 * __uint_as_float(y1.y << 16); mo[3] = g0 * __uint_as_float(y0.y & 0xffff0000u) + g1 * __uint_as_float(y1.y & 0xffff0000u);
                x[j] = x[j] + g2 * mo; }
        }
        float ss = 0.f;
#pragma unroll
        for (int j = 0; j < 4; ++j) ss += (x[j][0] * x[j][0] + x[j][1] * x[j][1]) + (x[j][2] * x[j][2] + x[j][3] * x[j][3]);
        const float rs = rsqrtf(wave_sum(ss) * (1.f / DM) + EPS);
        if (MODE == 2) {
#pragma unroll
            for (int j = 0; j < 4; ++j) { const f32x4 w = *(const f32x4*)(normw + j * 256 + lane * 4); *(f32x4*)(a.out + (size_t)(r - NCTX) * DM + j * 256 + lane * 4) = x[j] * rs * w; }
            continue;
        }
        f32x4 hv[4];
#pragma unroll
        for (int j = 0; j < 4; ++j) { *(f32x4*)(xs + j * 256 + lane * 4) = x[j];
            const f32x4 w = *(const f32x4*)(normw + j * 256 + lane * 4), sh = *(const f32x4*)(modsN + (size_t)mr * 6144 + j * 256 + lane * 4), sc = *(const f32x4*)(modsN + (size_t)mr * 6144 + DM + j * 256 + lane * 4);
            hv[j] = x[j] * rs * w * (sc + 1.f) + sh;
            v2u o; o.x = pk2(hv[j][0], hv[j][1]); o.y = pk2(hv[j][2], hv[j][3]); *(v2u*)(H + (size_t)r * DM + j * 256 + lane * 4) = o; }
        if (MODE == 1) {
            float ab[16];
#pragma unroll
            for (int q = 0; q < 16; ++q) ab[q] = 0.f;
#pragma unroll
            for (int j = 0; j < 4; ++j)
#pragma unroll
                for (int i = 0; i < 4; ++i) { const float* wr_ = a.in[I_OWIN] + (size_t)(j * 256 + lane * 4 + i) * OIN + 2048; const float hh = hv[j][i];
#pragma unroll
                    for (int q4 = 0; q4 < 4; ++q4) { const f32x4 w = *(const f32x4*)(wr_ + q4 * 4); ab[q4 * 4] += hh * w[0]; ab[q4 * 4 + 1] += hh * w[1]; ab[q4 * 4 + 2] += hh * w[2]; ab[q4 * 4 + 3] += hh * w[3]; } }
#pragma unroll
            for (int q = 0; q < 16; ++q) ab[q] = wave_sum(ab[q]);
            if (lane < 16) { float v = ab[0];
#pragma unroll
                for (int q = 1; q < 16; ++q) v = lane == q ? ab[q] : v;
                ((float*)(a.ws + WS_AB))[(size_t)r * 16 + lane] = v; }
        }
    }
}
template <int LAYER>
DI void phase_rowA(const int wu, const Args& a, LAS unsigned char* lds) {
    const int tid = tid_opq(wu), lane = tid & 63, wv = tid >> 6;
    LAS float* hs = (LAS float*)lds + wv * 1024;
    const float* xl = a.out; const float* xc = (const float*)(a.ws + WS_XC);
    const float* mods = (const float*)(a.ws + WS_MODS) + LAYER * 9 * 6144;
    const float* normw = a.in[I_N2W] + LAYER * DM;
    const float* wg = a.in[I_RGW] + LAYER * DM * 4; const float* bg = a.in[I_RGB] + LAYER * 4; const float* we = a.in[I_REW] + LAYER * DM * 32; const float* be = a.in[I_REB] + LAYER * 32;
    int* cnt = (int*)(a.ws + WS_CTL) + CW_CNT + LAYER * NEXP;
    int* tok_e = (int*)(a.ws + WS_TOKE); int* tok_r = (int*)(a.ws + WS_TOKR); float* tok_g = (float*)(a.ws + WS_TOKG); int* list = (int*)(a.ws + WS_LIST);
    bf16* H = (bf16*)(a.ws + WS_H);
    const int row0 = LAYER == 1 ? NCTX : 0;
    for (int r = row0 + blockIdx.x * NWAVES + wv; r < NTOK; r += gridDim.x * NWAVES) {
        const int mr = row_mod(r);
        const float* xs = r < NCTX ? xc + (size_t)r * DM : xl + (size_t)(r - NCTX) * DM;
        {
            f32x4 x[4]; float ss = 0.f;
#pragma unroll
            for (int j = 0; j < 4; ++j) { x[j] = *(const f32x4*)(xs + j * 256 + lane * 4); ss += (x[j][0] * x[j][0] + x[j][1] * x[j][1]) + (x[j][2] * x[j][2] + x[j][3] * x[j][3]); }
            const float rs = rsqrtf(wave_sum(ss) * (1.f / DM) + EPS);
#pragma unroll
            for (int j = 0; j < 4; ++j) {
                const f32x4 w = *(const f32x4*)(normw + j * 256 + lane * 4), sh = *(const f32x4*)(mods + (size_t)mr * 6144 + 3 * DM + j * 256 + lane * 4), sc = *(const f32x4*)(mods + (size_t)mr * 6144 + 4 * DM + j * 256 + lane * 4);
                const f32x4 hv = x[j] * rs * w * (sc + 1.f) + sh;
                v2u o; o.x = pk2(hv[0], hv[1]); o.y = pk2(hv[2], hv[3]); *(v2u*)(H + (size_t)r * DM + j * 256 + lane * 4) = o;
                *(LAS f32x4*)(hs + j * 256 + lane * 4) = hv; }
        }
        LDS_WAIT();
        float lg[36];
#pragma unroll
        for (int q = 0; q < 36; ++q) lg[q] = 0.f;
#pragma unroll 2
        for (int m = 0; m < 16; ++m) { const int k = m * 64 + lane; const float hh = hs[k];
            const f32x4 g = *(const f32x4*)(wg + (size_t)k * 4); lg[0] += hh * g[0]; lg[1] += hh * g[1]; lg[2] += hh * g[2]; lg[3] += hh * g[3];
#pragma unroll
            for (int q = 0; q < 8; ++q) { const f32x4 e = *(const f32x4*)(we + (size_t)k * 32 + q * 4); lg[4 + q * 4] += hh * e[0]; lg[5 + q * 4] += hh * e[1]; lg[6 + q * 4] += hh * e[2]; lg[7 + q * 4] += hh * e[3]; } }
#pragma unroll
        for (int q = 0; q < 36; ++q) lg[q] = wave_sum(lg[q]);
        if (lane == 0) {
#pragma unroll
            for (int q = 0; q < 4; ++q) lg[q] += bg[q];
#pragma unroll
            for (int q = 0; q < 32; ++q) lg[4 + q] += be[q];
            int grp = 0; float mx = lg[0];
#pragma unroll
            for (int g = 1; g < 4; ++g) if (lg[g] > mx) { mx = lg[g]; grp = g; }
            float den = 0.f;
#pragma unroll
            for (int g = 0; g < 4; ++g) den += expf(lg[g] - mx);
            const float pg = 1.f / den;
            float le[8];
#pragma unroll
            for (int i = 0; i < 8; ++i) { float v = lg[4 + i];
#pragma unroll
                for (int g = 1; g < 4; ++g) v = grp == g ? lg[4 + g * 8 + i] : v;
                le[i] = v; }
            int i0 = 0; float l0 = le[0];
#pragma unroll
            for (int i = 1; i < 8; ++i) if (le[i] > l0) { l0 = le[i]; i0 = i; }
            int i1 = 0; float l1 = -INFINITY;
#pragma unroll
            for (int i = 0; i < 8; ++i) if (i != i0 && le[i] > l1) { l1 = le[i]; i1 = i; }
            const float e1 = expf(l1 - l0), inv = 1.f / (1.f + e1);
            const int ex0 = grp * 8 + i0, ex1 = grp * 8 + i1;
            tok_e[r * 2] = ex0; tok_e[r * 2 + 1] = ex1; tok_g[r * 2] = pg * inv; tok_g[r * 2 + 1] = pg * e1 * inv;
            const int k0 = atomicAdd(cnt + ex0, 1), k1 = atomicAdd(cnt + ex1, 1);
            tok_r[r * 2] = k0; tok_r[r * 2 + 1] = k1; list[(size_t)ex0 * NTOK + k0] = r; list[(size_t)ex1 * NTOK + k1] = r;
        }
    }
}

struct SchedMoe {
    const LAS int* tpre; const LAS int* moff; const int* cnt; const char* A; const char* Bt; const int* list; int which; int G, c;
    DI bool next(int i, pg8::UnitG& u) const {
        const long L = (long)i * G + c; const int tile = (int)(L >> 2), pn = (int)(L & 3);
        if (tile >= tpre[NEXP]) return false;
        int e = 0;
        for (int q = 1; q < NEXP; ++q) e = tile >= tpre[q] ? q : e;
        const int pm = tile - tpre[e]; const int valid = min(256, cnt[e] - pm * 256);
        u.gvalid = valid; u.e0 = valid; u.e1 = 0; u.r0 = moff[e] + pm * 256;
        if (which == 1) { u.A = A; u.gl = list + (size_t)e * NTOK + pm * 256; u.B = Bt + ((size_t)e * 1024 + pn * 256) * DM * 2; u.c0 = pn * 128; }
        else { u.A = A + (size_t)u.r0 * HID * 2; u.gl = nullptr; u.B = Bt + ((size_t)e * 1024 + pn * 256) * HID * 2; u.c0 = pn * 256; }
        return true;
    }
};
template <int WHICH>
DI void phase_moe_gemm(const int wu, const Args& a, int layer, LAS unsigned char* lds) {
    const int tid = tid_opq(wu);
    LAS int* moff = (LAS int*)(lds + LDSCTL_OFF + 256); LAS int* tpre = moff + 40;
    const int* cnt = (const int*)(a.ws + WS_CTL) + CW_CNT + layer * NEXP;
    if (tid == 0) { int s = 0, t = 0; for (int e = 0; e < NEXP; ++e) { moff[e] = s; tpre[e] = t; s += cnt[e]; t += (cnt[e] + 255) >> 8; } moff[NEXP] = s; tpre[NEXP] = t; }
    __syncthreads();
    SchedMoe S; S.tpre = tpre; S.moff = moff; S.cnt = cnt; S.list = (const int*)(a.ws + WS_LIST); S.which = WHICH; S.G = gridDim.x; S.c = blockIdx.x;
    if (WHICH == 1) { S.A = (const char*)(a.ws + WS_H); S.Bt = (const char*)(a.ws + WS_WM1); pg8::EpiSwi E{(bf16*)(a.ws + WS_MIX), HID};
        pg8::gemm_phase<pg8::EpiSwi, SchedMoe, true>(wu, lds, DM, DM, DM, S, E); }
    else { S.A = (const char*)(a.ws + WS_MIX); S.Bt = (const char*)(a.ws + WS_WM2); pg8::EpiBf16G E{(bf16*)(a.ws + WS_LAT), DM, 0};
        pg8::gemm_phase<pg8::EpiBf16G, SchedMoe, false>(wu, lds, HID, HID, HID, S, E); }
}

DI void phase_ret_naive(const int wu, const Args& a, LAS unsigned char* lds) {
    LAS float* Qs = (LAS float*)lds; LAS float* Ks = Qs + 64 * 128; LAS float* Vs = Ks + 64 * 128; LAS float* Ss = Vs + 64 * 128;
    const int tid = tid_opq(wu);
    const bf16* lat = (const bf16*)(a.ws + WS_LAT); bf16* mix = (bf16*)(a.ws + WS_MIX);
    const float* RC = (const float*)(a.ws + WS_ROPE); const float* RS = RC + SEQ * 64;
    for (int task = blockIdx.x; task < 36 * 4 * NB; task += gridDim.x) {
        const int it = task % 36, h = (task / 36) & 3, b = task / 144;
        float lg[2];
#pragma unroll
        for (int d = 0; d < 2; ++d) { const float x = a.in[I_RDEC][d * 4 + h]; lg[d] = -log1pf(expf(-x)) * 1.4426950408889634f; }
        auto srow = [&](int s) { return s < CT ? b * CT + s : NCTX + b * SEQ + (s - CT); };
        auto ldqk = [&](int s, int d, int base) {
            const int row = srow(s); const bf16* p = lat + (size_t)row * EIN + base + h * 128; const int j = d & 63;
            const float x1 = bf2f(p[j]), x2 = bf2f(p[j + 64]);
            if (s < CT) return d < 64 ? x1 : x2;
            const int t = s - CT; const float c = RC[t * 64 + j], sn = RS[t * 64 + j];
            return d < 64 ? x1 * c - x2 * sn : x1 * sn + x2 * c; };
        __syncthreads();
        for (int i = tid; i < 64 * 128; i += NTHR) { const int q = i >> 7, d = i & 127; Qs[i] = ldqk(it * 64 + q, d, 0) * 0.08838834764831845f; }
        float o[16];
#pragma unroll
        for (int i = 0; i < 16; ++i) o[i] = 0.f;
        const int qi = tid >> 3, sub = tid & 7;
        const int si = it * 64 + qi; const int p1i = si < CT ? CT - 1 - si : 2559 - si;
        const int njt = it < 4 ? 4 : 36;
        for (int jt = 0; jt < njt; ++jt) {
            __syncthreads();
            for (int i = tid; i < 64 * 128; i += NTHR) { const int q = i >> 7, d = i & 127; Ks[i] = ldqk(jt * 64 + q, d, 512); Vs[i] = bf2f(lat[(size_t)srow(jt * 64 + q) * EIN + 1024 + h * 128 + d]); }
            __syncthreads();
            for (int kk = 0; kk < 8; ++kk) {
                const int j = sub * 8 + kk; const int sj = jt * 64 + j;
                float dot = 0.f;
                for (int d = 0; d < 128; ++d) dot += Qs[qi * 128 + d] * Ks[j * 128 + d];
                const int p1j = sj < CT ? CT - 1 - sj : 2559 - sj;
                float w = 0.f;
                if (sj <= si) w += exp2f(lg[0] * (float)(si - sj));
                if (p1j <= p1i) w += exp2f(lg[1] * (float)(p1i - p1j));
                Ss[qi * 65 + j] = dot * w;
            }
            __syncthreads();
            for (int j = 0; j < 64; ++j) { const float s = Ss[qi * 65 + j];
#pragma unroll
                for (int dd = 0; dd < 16; ++dd) o[dd] += s * Vs[j * 128 + sub * 16 + dd]; }
        }
        float s = 0.f;
#pragma unroll
        for (int i = 0; i < 16; ++i) s += o[i];
        s += __shfl_xor(s, 1); s += __shfl_xor(s, 2); s += __shfl_xor(s, 4);
        const float mu = s * (1.f / 128.f); float q = 0.f;
#pragma unroll
        for (int i = 0; i < 16; ++i) { o[i] -= mu; q += o[i] * o[i]; }
        q += __shfl_xor(q, 1); q += __shfl_xor(q, 2); q += __shfl_xor(q, 4);
        const float rs = rsqrtf(q * (1.f / 128.f) + EPS);
        const int row = srow(si);
        const bf16* gp = lat + (size_t)row * EIN + 1536 + h * 128 + sub * 16; const float* gw = a.in[I_RGNW] + h * 128 + sub * 16;
        bf16* mp = mix + (size_t)row * DM + h * 128 + sub * 16;
#pragma unroll
        for (int i = 0; i < 16; ++i) mp[i] = (bf16)f2bf(o[i] * rs * gw[i] * siluf(bf2f(gp[i])));
    }
}
struct SchedChan {
    const char* A; const char* lat; int isctx; int G, c;
    DI bool next(int i, pg8::UnitG& u) const { const long L = (long)i * G + c; if (L >= (isctx ? 32 : 256)) return false; const int g = (int)(L & 3), j = (int)(L >> 2);
        const int row0 = isctx ? j * 256 : NCTX + j * 256;
        u.A = A; u.B = lat + ((size_t)row0 * EIN + 2048 + g * 128) * 2; u.gl = nullptr; u.gvalid = 256; u.r0 = 0; u.c0 = 0; u.e0 = g; u.e1 = j; return true; }
};
struct SchedTok {
    const char* A; const char* GT; int isctx; int G, c;
    DI bool next(int i, pg8::UnitG& u) const { const long L = (long)i * G + c; u.gl = nullptr; u.gvalid = 256; u.e0 = 256; u.e1 = 0;
        if (!isctx) { if (L >= 128) return false; const int pn = (int)(L & 1), pm = (int)(L >> 1) & 7, b = (int)(L >> 4);
            u.A = A + (size_t)pm * 256 * 4096 * 2; u.B = GT + ((size_t)b * 512 + pn * 256) * 4096 * 2; u.r0 = NCTX + b * SEQ + pm * 256; u.c0 = 512 + pn * 256; return true; }
        if (L >= 16) return false; const int pn = (int)(L & 1), b = (int)(L >> 1);
        u.A = A; u.B = GT + ((size_t)b * 512 + pn * 256) * 512 * 2; u.r0 = b * CT; u.c0 = 512 + pn * 256; return true; }
};

DI void phase_dn_prep(const int wu, const Args& a, LAS unsigned char* lds) {
    LAS float* buf = (LAS float*)lds; LAS float* nrm = buf + 1536;
    const int tid = tid_opq(wu), wv = tid >> 6, lane = tid & 63;
    const bf16* lat = (const bf16*)(a.ws + WS_LAT); const float* cw = a.in[I_CONVW];
    float* QN = (float*)(a.ws + WS_QN); float* KN = (float*)(a.ws + WS_KN); float* VV = (float*)(a.ws + WS_VV);
    float* beta = (float*)(a.ws + WS_BETA); float* glog = (float*)(a.ws + WS_GLOG); const float* AB = (const float*)(a.ws + WS_AB);
    for (int r = blockIdx.x; r < NTOK; r += gridDim.x) {
        const bool isctx = r < NCTX; const int T = isctx ? CT : SEQ; const int t = isctx ? r % CT : (r - NCTX) % SEQ;
        const bf16* x0 = lat + (size_t)r * L1N;
        __syncthreads();
        for (int i = 0; i < 3; ++i) { const int c = tid + NTHR * i;
            float y = cw[1536 + c] * bf2f(x0[c]);
            if (t > 0) y += cw[c] * bf2f(x0[c - L1N]);
            if (t < T - 1) y += cw[2 * 1536 + c] * bf2f(x0[c + L1N]);
            buf[c] = siluf(y); }
        __syncthreads();
        { const int g = wv; float p = buf[g * 128 + lane], q = buf[g * 128 + lane + 64]; const float s = wave_sum(p * p + q * q); if (lane == 0) nrm[g] = rsqrtf(s + EPS); }
        __syncthreads();
        for (int i = 0; i < 3; ++i) { const int c = tid + NTHR * i;
            if (c < 512) QN[(size_t)r * 512 + c] = buf[c] * nrm[c >> 7] * 0.08838834764831845f;
            else if (c < 1024) KN[(size_t)r * 512 + c - 512] = buf[c] * nrm[c >> 7];
            else VV[(size_t)r * 512 + c - 1024] = buf[c]; }
        if (tid < 8) { const int d = tid >> 2, h = tid & 3;
            const float av = AB[(size_t)r * 16 + d * 4 + h], bt = AB[(size_t)r * 16 + 8 + d * 4 + h];
            const float z = av + a.in[I_DTB][d * 4 + h]; const float sp = z > 20.f ? z : log1pf(expf(z));
            beta[((size_t)d * NTOK + r) * 4 + h] = 1.f / (1.f + expf(-bt));
            glog[((size_t)d * NTOK + r) * 4 + h] = -expf(a.in[I_ALOG][d * 4 + h]) * sp; }
    }
}
DI void phase_dn_scan(const int wu, const Args& a, LAS unsigned char* lds) {
    const int tid = tid_opq(wu), col = tid >> 2, qd = tid & 3;
    LAS float* ks = (LAS float*)lds; LAS float* qs = ks + 16 * 128; LAS float* vs = qs + 16 * 128; LAS float* al = vs + 16 * 128; LAS float* be = al + 16;
    const float* QN = (const float*)(a.ws + WS_QN); const float* KN = (const float*)(a.ws + WS_KN); const float* VV = (const float*)(a.ws + WS_VV);
    const float* beta = (const float*)(a.ws + WS_BETA); const float* glog = (const float*)(a.ws + WS_GLOG);
    float* O0 = (float*)(a.ws + WS_FOUR); float* O1 = O0 + (size_t)NLAT * 512;
    for (int chain = blockIdx.x; chain < 64; chain += gridDim.x) {
        const int b = chain >> 3, h = (chain >> 1) & 3, dir = chain & 1;
        float S[32];
#pragma unroll
        for (int i = 0; i < 32; ++i) S[i] = 0.f;
        float* Od = dir ? O1 : O0;
        for (int s0 = 0; s0 < CT + SEQ; s0 += 16) {
            __syncthreads();
#pragma unroll 1
            for (int i = 0; i < 4; ++i) { const int ii = i * 4 + qd; const int s = s0 + ii; int r;
                if (s < CT) r = b * CT + (dir ? CT - 1 - s : s); else { const int t = s - CT; r = NCTX + b * SEQ + (dir ? SEQ - 1 - t : t); }
                ks[ii * 128 + col] = KN[(size_t)r * 512 + h * 128 + col]; qs[ii * 128 + col] = QN[(size_t)r * 512 + h * 128 + col]; vs[ii * 128 + col] = VV[(size_t)r * 512 + h * 128 + col];
                if (col == 0) { al[ii] = expf(glog[((size_t)dir * NTOK + r) * 4 + h]); be[ii] = beta[((size_t)dir * NTOK + r) * 4 + h]; } }
            __syncthreads();
#pragma unroll 1
            for (int i = 0; i < 16; ++i) {
                const float av = al[i], bt = be[i]; float kS = 0.f;
                const LAS float* kp = ks + i * 128 + qd * 32; const LAS float* qp = qs + i * 128 + qd * 32;
#pragma unroll
                for (int d = 0; d < 32; ++d) { S[d] *= av; kS += kp[d] * S[d]; }
                kS += __shfl_xor(kS, 1); kS += __shfl_xor(kS, 2);
                const float vn = bt * (vs[i * 128 + col] - kS); float o = 0.f;
#pragma unroll
                for (int d = 0; d < 32; ++d) { S[d] += kp[d] * vn; o += qp[d] * S[d]; }
                o += __shfl_xor(o, 1); o += __shfl_xor(o, 2);
                const int s = s0 + i;
                if (s >= CT && qd == 0) { const int t = s - CT; const int r = b * SEQ + (dir ? SEQ - 1 - t : t); Od[(size_t)r * 512 + h * 128 + col] = o; }
            }
        }
    }
}
DI void phase_sgu_naive(const int wu, const Args& a, LAS unsigned char* lds) {
    LAS float* Vn = (LAS float*)lds; LAS float* Ws = Vn + 128 * 128;
    const int tid = tid_opq(wu), wv = tid >> 6, lane = tid & 63;
    const bf16* lat = (const bf16*)(a.ws + WS_LAT); bf16* mix = (bf16*)(a.ws + WS_MIX);
    for (int task = blockIdx.x; task < NB * 16 * 4; task += gridDim.x) {
        const int g = task & 3, n = (task >> 2) & 15, b = task >> 6; const int row0 = NCTX + b * SEQ + n * 128;
        __syncthreads();
        for (int q = wv; q < 128; q += NWAVES) { const bf16* sp = lat + (size_t)(row0 + q) * L1N + 2560 + g * 128;
            float x0 = geluf(bf2f(sp[lane])), x1 = geluf(bf2f(sp[lane + 64]));
            const float mu = wave_sum(x0 + x1) * (1.f / 128.f); x0 -= mu; x1 -= mu;
            const float rs = rsqrtf(wave_sum(x0 * x0 + x1 * x1) * (1.f / 128.f) + EPS);
            Vn[q * 128 + lane] = x0 * rs; Vn[q * 128 + lane + 64] = x1 * rs; }
        for (int half = 0; half < 2; ++half) {
            __syncthreads();
            for (int i = tid; i < 64 * 128; i += NTHR) Ws[i] = a.in[I_SGUW][(size_t)g * 16384 + (size_t)(half * 64) * 128 + i];
            __syncthreads();
            const int p = tid >> 3, cg = tid & 7; float acc[16];
#pragma unroll
            for (int i = 0; i < 16; ++i) acc[i] = 0.f;
            for (int q = 0; q < 128; ++q) { const float w = Ws[p * 128 + q];
#pragma unroll
                for (int i = 0; i < 16; ++i) acc[i] += w * Vn[q * 128 + cg * 16 + i]; }
            const int pp = half * 64 + p, row = row0 + pp; const float bs = a.in[I_SGUB][g * 128 + pp];
            const bf16* up = lat + (size_t)row * L1N + 2048 + g * 128 + cg * 16; bf16* mp = mix + (size_t)row * DM + 512 + g * 128 + cg * 16;
#pragma unroll
            for (int i = 0; i < 16; ++i) mp[i] = (bf16)f2bf(geluf(bf2f(up[i])) * (acc[i] + bs));
        }
    }
}
DI void phase_ghn(const int wu, const Args& a) {
    const int tid = tid_opq(wu), wv = tid >> 6, lane = tid & 63;
    const float* O0 = (const float*)(a.ws + WS_FOUR); const float* O1 = O0 + (size_t)NLAT * 512;
    const bf16* lat = (const bf16*)(a.ws + WS_LAT); bf16* mix = (bf16*)(a.ws + WS_MIX); const float* nw = a.in[I_DNNW];
    for (int w = blockIdx.x * NWAVES + wv; w < NLAT * 4; w += gridDim.x * NWAVES) {
        const int rl = w >> 2, h = w & 3, r = NCTX + rl; const size_t oi = (size_t)rl * 512 + h * 128;
        const float p = O0[oi + lane] + O1[oi + lane], q = O0[oi + lane + 64] + O1[oi + lane + 64];
        const float rs = rsqrtf(wave_sum(p * p + q * q) * (1.f / 128.f) + EPS);
        const bf16* z = lat + (size_t)r * L1N + 1536 + h * 128;
        mix[(size_t)r * DM + h * 128 + lane] = (bf16)f2bf(p * rs * nw[lane] * siluf(bf2f(z[lane])));
        mix[(size_t)r * DM + h * 128 + lane + 64] = (bf16)f2bf(q * rs * nw[lane + 64] * siluf(bf2f(z[lane + 64])));
    }
}

constexpr int NPHASE = 20;
__global__ void __launch_bounds__(NTHR, 2) mk_fwd(Args args) {
    extern __shared__ __attribute__((aligned(16))) unsigned char lds_raw[];
    LAS unsigned char* lds = (LAS unsigned char*)lds_raw;
    const int wu = __builtin_amdgcn_readfirstlane(threadIdx.x >> 6);
    const int tid = tid_opq(wu);
    for (int u = tid; u < (LDS_BYTES - LDSCTL_OFF) / 4; u += NTHR) ((LAS unsigned*)(lds + LDSCTL_OFF))[u] = 0u;
    __syncthreads();
    unsigned* ctl = (unsigned*)(args.ws + WS_CTL);
    XcdBarrier bar; bar.bar = ctl + CW_BAR; bar.x = 0; bar.st = nullptr;
    const bool one = (args.ph_hi - args.ph_lo) > 1;
    if (one) bar = xcd_barrier_post(ctl + CW_BAR, (volatile LAS unsigned*)(lds + LDSCTL_OFF) + 8, tid);
    const int lo = args.ph_lo, hi = args.ph_hi;
#define IN(k) (lo <= (k) && (k) < hi)
#define SEAM(k) do { if (IN(k) && IN((k) + 1)) xcd_barrier(bar, tid_opq(wu)); } while (0)
    const int G = gridDim.x, c = blockIdx.x;
    unsigned char* ws = args.ws;
    if (IN(0)) { phase_prep(wu, args, lds); } SEAM(0);
    if (IN(1)) { phase_rowB<0>(wu, args, lds); } SEAM(1);
    if (IN(2)) {
        pg8::SchedDense S{(const char*)(ws + WS_H), (const char*)(ws + WS_WIN0), DM, DM, 0, NTOK / 256, 0, EIN / 256, 0, 0, 0, 0, G, c};
        pg8::EpiBf16G E{(bf16*)(ws + WS_LAT), EIN, 0};
        pg8::gemm_phase<pg8::EpiBf16G, pg8::SchedDense, false>(wu, lds, DM, DM, DM, S, E);
    } SEAM(2);
    if (IN(3)) {
        { SchedChan S{(const char*)(ws + WS_TCH), (const char*)(ws + WS_LAT), 0, G, c}; pg8::EpiChan<0> E{(bf16*)(ws + WS_FOUR + FOUR_GT)};
          pg8::gemm_phase<pg8::EpiChan<0>, SchedChan, false>(wu, lds, 128, 128, EIN, S, E); }
        { SchedChan S{(const char*)(ws + WS_TCH), (const char*)(ws + WS_LAT), 1, G, c}; pg8::EpiChan<1> E{(bf16*)(ws + WS_FOUR + FOUR_GTC)};
          pg8::gemm_phase<pg8::EpiChan<1>, SchedChan, false>(wu, lds, 128, 128, EIN, S, E); }
        phase_ret_naive(wu, args, lds);
    } SEAM(3);
    if (IN(4)) {
        pg8::EpiBf16G E{(bf16*)(ws + WS_MIX), DM, 0};
        { SchedTok S{(const char*)(ws + WS_FOUR + FOUR_TRIG), (const char*)(ws + WS_FOUR + FOUR_GT), 0, G, c};
          pg8::gemm_phase<pg8::EpiBf16G, SchedTok, false>(wu, lds, 4096, 4096, 4096, S, E); }
        { SchedTok S{(const char*)(ws + WS_T256), (const char*)(ws + WS_FOUR + FOUR_GTC), 1, G, c};
          pg8::gemm_phase<pg8::EpiBf16G, SchedTok, false>(wu, lds, 512, 512, 512, S, E); }
    } SEAM(4);
    if (IN(5)) {
        pg8::SchedDense S{(const char*)(ws + WS_MIX), (const char*)(ws + WS_WOUT0), DM, DM, 0, NTOK / 256, 0, DM / 256, 0, 0, 0, 0, G, c};
        pg8::EpiResid E{args.out, (float*)(ws + WS_XC), (const float*)(ws + WS_MODS)};
        pg8::gemm_phase<pg8::EpiResid, pg8::SchedDense, false>(wu, lds, DM, DM, DM, S, E);
    } SEAM(5);
    if (IN(6)) { phase_rowA<0>(wu, args, lds); } SEAM(6);
    if (IN(7)) { phase_moe_gemm<1>(wu, args, 0, lds); } SEAM(7);
    if (IN(8)) { phase_moe_gemm<2>(wu, args, 0, lds); } SEAM(8);
    if (IN(9)) {
        phase_rowB<1>(wu, args, lds);
        __syncthreads();
        for (int it = c; it < NEXP * 96; it += G) moe_convert_item(args, 1, it, (LAS float*)lds, tid_opq(wu));
    } SEAM(9);
    if (IN(10)) {
        pg8::SchedDense S{(const char*)(ws + WS_H), (const char*)(ws + WS_WIN1), DM, DM, NCTX / 256, NLAT / 256, 0, L1N / 256, 0, NCTX / 256, 2, 4, G, c};
        pg8::EpiBf16G E{(bf16*)(ws + WS_LAT), L1N, 0};
        pg8::gemm_phase<pg8::EpiBf16G, pg8::SchedDense, false>(wu, lds, DM, DM, DM, S, E);
    } SEAM(10);
    if (IN(11)) { phase_dn_prep(wu, args, lds); phase_sgu_naive(wu, args, lds); } SEAM(11);
    if (IN(12)) { phase_dn_scan(wu, args, lds); } SEAM(12);
    if (IN(13)) { phase_ghn(wu, args); } SEAM(13);
    if (IN(14)) {
        pg8::SchedDense S{(const char*)(ws + WS_MIX), (const char*)(ws + WS_WOUT1), DM, DM, NCTX / 256, NLAT / 256, 0, DM / 256, 0, 0, 0, 0, G, c};
        pg8::EpiResid E{args.out, (float*)(ws + WS_XC), (const float*)(ws + WS_MODS) + 9 * 6144};
        pg8::gemm_phase<pg8::EpiResid, pg8::SchedDense, false>(wu, lds, DM, DM, DM, S, E);
    } SEAM(14);
    if (IN(15)) { phase_rowA<1>(wu, args, lds); } SEAM(15);
    if (IN(16)) { phase_moe_gemm<1>(wu, args, 1, lds); } SEAM(16);
    if (IN(17)) { phase_moe_gemm<2>(wu, args, 1, lds); } SEAM(17);
    if (IN(18)) { phase_rowB<2>(wu, args, lds); }
#undef IN
#undef SEAM
}
}

extern "C" void kernel_launch(void* const* d_in, const int* in_sizes, int n_in, void* d_out, int out_size, void* d_ws, size_t ws_size, hipStream_t stream) {
    static int grid = 0;
    if (grid == 0) {
        if (ws_size < WS_END) { fprintf(stderr, "kernel_launch: workspace too small: need %zu, have %zu\n", (size_t)WS_END, ws_size); grid = -1; return; }
        int dev = 0, cus = 0;
        if (hipGetDevice(&dev) != hipSuccess || hipDeviceGetAttribute(&cus, hipDeviceAttributeMultiprocessorCount, dev) != hipSuccess) { grid = -1; return; }
        if (hipFuncSetAttribute((const void*)mk_fwd, hipFuncAttributeMaxDynamicSharedMemorySize, LDS_BYTES) != hipSuccess) { fprintf(stderr, "kernel_launch: hipFuncSetAttribute failed\n"); grid = -1; return; }
        grid = cus;
    }
    if (grid < 0) return;
    (void)hipMemsetAsync((char*)d_ws + WS_CTL, 0, CTL_BYTES, stream);
    Args a{};
    for (int i = 0; i < 28; ++i) a.in[i] = (const float*)d_in[i];
    a.out = (float*)d_out; a.ws = (unsigned char*)d_ws;
#if MK_ONE_LAUNCH
    a.ph_lo = 0; a.ph_hi = NPHASE;
    hipLaunchKernelGGL(mk_fwd, dim3(grid), dim3(NTHR), LDS_BYTES, stream, a);
#else
    for (int p = 0; p < 19; ++p) { a.ph_lo = p; a.ph_hi = p + 1; hipLaunchKernelGGL(mk_fwd, dim3(grid), dim3(NTHR), LDS_BYTES, stream, a); }
#endif
}
```

```cpp
#include <hip/hip_runtime.h>
#include <cstdio>
#include <cstdint>
#include <cmath>

#define GAS __attribute__((address_space(1)))
#define LAS __attribute__((address_space(3)))
typedef unsigned short bf16;
typedef unsigned v4u __attribute__((ext_vector_type(4)));
typedef unsigned v2u __attribute__((ext_vector_type(2)));
typedef float f32x4 __attribute__((ext_vector_type(4)));
typedef float f32x2 __attribute__((ext_vector_type(2)));
typedef short bf16x8 __attribute__((ext_vector_type(8)));
#define DI __device__ __forceinline__

#ifndef MK_ONE_LAUNCH
#define MK_ONE_LAUNCH 1
#endif

namespace {
constexpr int DM = 1024, NB = 8, SEQ = 2048, CT = 256;
constexpr int NCTX = NB * CT, NLAT = NB * SEQ, NTOK = NCTX + NLAT;
constexpr int EIN = 2560, OIN = 3088, L1N = 3072;
constexpr int NEXP = 32, HID = 512;
constexpr float EPS = 1e-6f;
constexpr float PI2 = 6.283185307179586f;
constexpr int NTHR = 512, NWAVES = 8;
constexpr int NSLOT = NTOK * 2 + 256;

constexpr size_t al(size_t x) { return (x + 255) & ~(size_t)255; }
constexpr size_t WS_CTL = 0, CTL_BYTES = 1u << 20, CTL_ZERO_BYTES = 98304;
constexpr size_t WS_MODS = WS_CTL + CTL_BYTES;
constexpr size_t WS_TOKE = WS_MODS + al((size_t)2 * 9 * 6144 * 4);
constexpr size_t WS_TOKR = WS_TOKE + al((size_t)NTOK * 2 * 4);
constexpr size_t WS_TOKG = WS_TOKR + al((size_t)NTOK * 2 * 4);
constexpr size_t WS_LIST = WS_TOKG + al((size_t)NTOK * 2 * 4);
constexpr size_t WS_AB = WS_LIST + al((size_t)NEXP * NTOK * 4);
constexpr size_t WS_ROPE = WS_AB + al((size_t)NTOK * 16 * 4);
constexpr size_t WS_TCH = WS_ROPE + al((size_t)2 * SEQ * 64 * 4);
constexpr size_t WS_T256 = WS_TCH + al((size_t)256 * 128 * 2);
constexpr size_t WS_W64 = WS_T256 + al((size_t)256 * 512 * 2);
constexpr size_t WS_W32 = WS_W64 + al((size_t)128 * 64 * 2);
constexpr size_t WS_CHT = WS_W32 + al((size_t)64 * 64 * 2);
constexpr size_t WS_TW = WS_CHT + al((size_t)128 * 256 * 2);
constexpr size_t WS_WIN0 = WS_TW + al((size_t)32 * 64 * 2 * 4);
constexpr size_t WS_WOUT0 = WS_WIN0 + al((size_t)EIN * DM * 2);
constexpr size_t WS_WIN1 = WS_WOUT0 + al((size_t)DM * DM * 2);
constexpr size_t WS_WOUT1 = WS_WIN1 + al((size_t)L1N * DM * 2);
constexpr size_t WS_WM1 = WS_WOUT1 + al((size_t)DM * DM * 2);
constexpr size_t WS_WM2 = WS_WM1 + al((size_t)NEXP * 1024 * DM * 2);
constexpr size_t WS_XC = WS_WM2 + al((size_t)NEXP * DM * HID * 2);
constexpr size_t WS_H = WS_XC + al((size_t)NCTX * DM * 4);
constexpr size_t WS_LAT = WS_H + al((size_t)NTOK * DM * 2);
constexpr size_t WS_MIX = WS_LAT + al((size_t)NTOK * L1N * 2);
constexpr size_t WS_FOUR = WS_MIX + al((size_t)NSLOT * HID * 2);
constexpr size_t FOUR_TRIG = 0, FOUR_GT = (size_t)SEQ * 4096 * 2, FOUR_GTC = FOUR_GT + (size_t)NB * 512 * 4096 * 2;
constexpr size_t FOUR_BYTES = (size_t)SEQ * 4096 * 2 + (size_t)NB * 512 * 4096 * 2 + (size_t)NB * 512 * 512 * 2;
constexpr size_t WS_DELTA = WS_FOUR + al(FOUR_BYTES);
constexpr int NDT = NB * 4 * 2 * 36;
constexpr size_t WS_DW = WS_DELTA;
constexpr size_t WS_DK = WS_DW + (size_t)NDT * 8192 * 2;
constexpr size_t WS_DQ = WS_DK + (size_t)NDT * 8192 * 2;
constexpr size_t WS_DU = WS_DQ + (size_t)NDT * 8192 * 2;
constexpr size_t WS_DA = WS_DU + (size_t)NDT * 8192 * 2;
constexpr size_t WS_DG = WS_DA + (size_t)NDT * 4096 * 2;
constexpr size_t WS_END = WS_DG + al((size_t)NDT * 4);
constexpr size_t WS_SPREV = WS_DELTA;
static_assert(WS_END <= 560000000ull, "d_ws budget (ws_size >= sum of inputs = 560,692,096 bytes)");
static_assert(FOUR_GTC + (size_t)NB * 512 * 512 * 2 <= FOUR_BYTES && (size_t)2 * NLAT * 512 * 2 <= FOUR_BYTES, "four region");
static_assert((size_t)NSLOT * DM * 2 <= (size_t)NTOK * L1N * 2, "Y overlay");
constexpr int CW_BAR = 4096, CW_CNT = 16384, CW_CTXDONE = 20480;
static_assert((CW_CTXDONE + 64) * 4 <= 98304 && (CW_BAR + 3456) * 4 <= 98304 && (CW_CNT + 64) * 4 <= 98304, "control words inside the per-call memset");

constexpr int RING_BYTES = 151552, LDSCTL_OFF = RING_BYTES, LDS_BYTES = 155648;

DI float bf2f(unsigned short u) { return __uint_as_float((unsigned)u << 16); }
DI unsigned f2bf(float f) { unsigned u = __float_as_uint(f); return (u + 0x7fffu + ((u >> 16) & 1u)) >> 16; }
typedef __bf16 bf16x2_t __attribute__((ext_vector_type(2)));
DI unsigned pk2(float lo, float hi) { const f32x2 v = {lo, hi}; return __builtin_bit_cast(unsigned, __builtin_convertvector(v, bf16x2_t)); }
DI float siluf(float v) { return v * __builtin_amdgcn_rcpf(1.f + __expf(-v)); }
DI float geluf(float v) {
    const float av = fabsf(v), t = __builtin_amdgcn_rcpf(av * 0.2316418882f + 1.0f);
    float q = t * 0.5307027145f + (-0.7265760135f); q = q * t + 0.7107068705f; q = q * t + (-0.142248368f); q = q * t + 0.127414796f; q = q * t;
    const float m = v * (q * __builtin_amdgcn_exp2f(v * v * (-0.72134752044f)));
    return v < 0.f ? m : v - m;
}
DI int tid_opq(int wu) {
    int t; asm volatile("v_mbcnt_lo_u32_b32 %0, -1, 0\n\tv_mbcnt_hi_u32_b32 %0, -1, %0\n\tv_lshl_add_u32 %0, %1, 6, %0" : "=&v"(t) : "s"(wu)); return t; }
DI int row_mod(int r) { return r < NCTX ? 8 : (r - NCTX) / SEQ; }
DI float wave_sum(float v) {
#pragma unroll
    for (int o = 1; o < 64; o <<= 1) v += __shfl_xor(v, o);
    return v;
}
#define VM_WAIT() asm volatile("s_waitcnt vmcnt(0)" ::: "memory")
#define LDS_WAIT() asm volatile("s_waitcnt lgkmcnt(0)" ::: "memory")
#define RLX_AGENT __ATOMIC_RELAXED, __HIP_MEMORY_SCOPE_AGENT

#define XB_TMO      128
#define XB_XCNT(j)  (256  + 64 * (j))
#define XB_XSUB(j)  (1280 + 64 * (j))
#define XB_XGEN(j)  (2304 + 64 * (j))
#define XB_TOP      3328
#define XB_TOPGEN   3392
#define XCD_BAR_WORDS 3456
#define XB_SPIN_CAP (1u << 18)
DI unsigned xb_ld(unsigned* p)              { return __hip_atomic_load(p, __ATOMIC_RELAXED, __HIP_MEMORY_SCOPE_AGENT); }
DI unsigned xb_add(unsigned* p, unsigned v) { return __hip_atomic_fetch_add(p, v, __ATOMIC_RELAXED, __HIP_MEMORY_SCOPE_AGENT); }
DI unsigned xb_xcc_id() { return (unsigned)__builtin_amdgcn_s_getreg((3 << 11) | 20) & 0xFu; }
#define XB_SPIN(cond, bar) do { unsigned _sp = 0; while (cond) { __builtin_amdgcn_s_sleep(1); \
    if ((++_sp & 255u) == 0u) { if (xb_ld(&(bar)[XB_TMO])) break; if (_sp > XB_SPIN_CAP) { atomicAdd(&(bar)[XB_TMO], 1u); break; } } } } while (0)
struct XcdBarrier { unsigned* bar; unsigned x; volatile LAS unsigned* st; };
DI XcdBarrier xcd_barrier_post(unsigned* bar, volatile LAS unsigned* st, int tid0) {
    XcdBarrier b; b.bar = bar; b.x = xb_xcc_id(); b.st = st;
    if (tid0 == 0) (void)xb_add(&bar[XB_XCNT(b.x)], 1u);
    return b;
}
DI void xcd_barrier_complete(unsigned* bar, unsigned x, unsigned& nloc, unsigned& nx) {
    const unsigned G = gridDim.x * gridDim.y * gridDim.z;
    unsigned sum, cnt, mine, sp = 0u;
    for (;;) {
        sum = 0u; cnt = 0u; mine = 0u;
#pragma unroll
        for (unsigned j = 0; j < 16; ++j) { const unsigned c = xb_ld(&bar[XB_XCNT(j)]); sum += c; cnt += (c > 0u) ? 1u : 0u; mine = (j == x) ? c : mine; }
        if (sum == G) break;
        __builtin_amdgcn_s_sleep(1);
        if ((++sp & 255u) == 0u) { if (xb_ld(&bar[XB_TMO])) break; if (sp > XB_SPIN_CAP) { atomicAdd(&bar[XB_TMO], 1u); break; } }
    }
    nloc = mine > 0u ? mine : 1u; nx = cnt > 0u ? cnt : 1u;
}
DI void xcd_barrier(const XcdBarrier& b, int tid0) {
    asm volatile("s_waitcnt vmcnt(0)" ::: "memory");
    __syncthreads();
    if (tid0 == 0) {
        unsigned* bar = b.bar;
        __builtin_amdgcn_s_waitcnt(0);
        unsigned nloc = b.st[0], nx = b.st[1];
        if (nloc == 0u) { xcd_barrier_complete(bar, b.x, nloc, nx); b.st[0] = nloc; b.st[1] = nx; }
        const unsigned old = xb_add(&bar[XB_XSUB(b.x)], 1u);
        const unsigned gen = old / nloc;
        if (old + 1u == (gen + 1u) * nloc) {
            __builtin_amdgcn_fence(__ATOMIC_RELEASE, "agent");
            asm volatile("s_waitcnt vmcnt(0)" ::: "memory");
            const unsigned og = xb_add(&bar[XB_TOP], 1u);
            const unsigned tg = og / nx;
            if (og + 1u == (tg + 1u) * nx) xb_add(&bar[XB_TOPGEN], 1u);
            else XB_SPIN(xb_ld(&bar[XB_TOPGEN]) == tg, bar);
            __builtin_amdgcn_fence(__ATOMIC_ACQUIRE, "agent");
            xb_add(&bar[XB_XGEN(b.x)], 1u);
            asm volatile("s_waitcnt vmcnt(0)" ::: "memory");
        } else {
            XB_SPIN(xb_ld(&bar[XB_XGEN(b.x)]) == gen, bar);
            __builtin_amdgcn_fence(__ATOMIC_ACQUIRE, "agent");
            asm volatile("s_waitcnt vmcnt(0)" ::: "memory");
        }
    }
    __syncthreads();
}

namespace pg8 {
constexpr int BM = 256, BK = 64, HALF = 128, HTB = HALF * BK * 2, NXCD = 8, WGM = 8;
DI int lds_byte(int r, int c) { const int st = (r >> 4) * 2 + (c >> 5), rr = r & 15, cc = c & 31, ob = rr * 64 + cc * 2; return st * 1024 + (ob ^ (((ob >> 9) & 1) << 5)); }
DI void stage_rc(int b, int& R, int& C) { const int st = b / 1024, sb = b % 1024, swz = sb ^ (((sb >> 9) & 1) << 5); R = (st >> 1) * 16 + swz / 64; C = (st & 1) * 32 + (swz % 64) / 2; }
DI int perm32(int rho) { const int n = rho >> 4, i = rho & 15; return 8 * (i >> 2) + 4 * n + (i & 3); }

struct UnitG { const char* A; const char* B; const int* gl; int gvalid; int r0, c0, e0, e1; int hm; };
DI unsigned cvt_pk_bf16(float lo, float hi) { return pk2(lo, hi); }

template <class Epi, class Sched, bool GATHER>
DI void gemm_phase(const int wu, LAS unsigned char* lds, const int K_, const int lda, const int ldb, const Sched& S, const Epi& E) {
    int K = K_; asm volatile("" : "+s"(K));
    int tid_ = tid_opq(wu);
    const int tid = tid_, wid = __builtin_amdgcn_readfirstlane(tid >> 6), lane = tid & 63, wr = wid >> 2, wc = wid & 3, fr = lane & 15, fq = lane >> 4;
    const int nt = K / BK;
    unsigned voffA[2][2], voffAn[2][2], voffB[2];
#pragma unroll
    for (int i = 0; i < 2; ++i) { int R, C; stage_rc(tid * 16 + i * 8192, R, C); const int Rb = Epi::PERM ? ((R & ~31) + perm32(R & 31)) : R;
        voffB[i] = (unsigned)(Rb * ldb + C) * 2u;
        voffA[0][i] = (unsigned)(R * lda + C) * 2u; voffA[1][i] = (unsigned)((R + HALF) * lda + C) * 2u; voffAn[0][i] = voffA[0][i]; voffAn[1][i] = voffA[1][i]; }
    const size_t kstep = (size_t)(BK * 2);
    const size_t hstepB = (size_t)HALF * ldb * 2;
    const unsigned ldsw = (unsigned)wid * 1024u;
    const int aoff = lds_byte(wr * 64 + fr, fq * 8), boff = lds_byte(wc * 32 + fr, fq * 8);
#define PG8_SA(b, h) (((b) * 2 + (h)) * HTB)
#define PG8_SB(b, h) ((4 + (b) * 2 + (h)) * HTB)
#define PG8_STAGEB(bufoff, gbase) do { _Pragma("unroll") for (int _i = 0; _i < 2; ++_i) \
        __builtin_amdgcn_global_load_lds((const unsigned*)((const char*)(gbase) + voffB[_i]), (LAS unsigned*)(lds + (bufoff) + ldsw + _i * 8192), 16, 0, 0); } while (0)
#define PG8_STAGEA(bufoff, gbase, v0, v1) do { \
        __builtin_amdgcn_global_load_lds((const unsigned*)((const char*)(gbase) + (v0)), (LAS unsigned*)(lds + (bufoff) + ldsw), 16, 0, 0); \
        __builtin_amdgcn_global_load_lds((const unsigned*)((const char*)(gbase) + (v1)), (LAS unsigned*)(lds + (bufoff) + ldsw + 8192), 16, 0, 0); } while (0)
#define PG8_LDA(dst, b, h) do { _Pragma("unroll") for (int m = 0; m < 4; ++m) _Pragma("unroll") for (int k = 0; k < 2; ++k) dst[m][k] = *(const LAS bf16x8*)(lds + PG8_SA(b, h) + aoff + m * 2048 + k * 1024); } while (0)
#define PG8_LDB(dst, b, h) do { _Pragma("unroll") for (int n = 0; n < 2; ++n) _Pragma("unroll") for (int k = 0; k < 2; ++k) dst[n][k] = *(const LAS bf16x8*)(lds + PG8_SB(b, h) + boff + n * 2048 + k * 1024); } while (0)
#define PG8_MMA(ai, bj, At, Bt) do { __builtin_amdgcn_s_setprio(1); _Pragma("unroll") for (int m = 0; m < 4; ++m) _Pragma("unroll") for (int n = 0; n < 2; ++n) _Pragma("unroll") for (int k = 0; k < 2; ++k) \
        acc[ai][bj][m][n] = __builtin_amdgcn_mfma_f32_16x16x32_bf16(Bt[n][k], At[m][k], acc[ai][bj][m][n], 0, 0, 0); __builtin_amdgcn_s_setprio(0); } while (0)
#define PG8_WAIT_V(n) asm volatile("s_waitcnt vmcnt(" #n ")" ::: "memory")
#define PG8_WAIT_L(n) asm volatile("s_waitcnt lgkmcnt(" #n ")" ::: "memory")
#define PG8_BAR __builtin_amdgcn_s_barrier()
#define PG8_SCHED __builtin_amdgcn_sched_barrier(0)
    UnitG cur, nxt; int ui = 0;
    __syncthreads();
    if (!S.next(0, cur)) return;
    if constexpr (GATHER) {
#pragma unroll
        for (int h = 0; h < 2; ++h)
#pragma unroll
            for (int i = 0; i < 2; ++i) { int R, C; stage_rc(tid * 16 + i * 8192, R, C); int rr = h * HALF + R; rr = rr < cur.gvalid ? rr : cur.gvalid - 1; voffA[h][i] = (unsigned)(cur.gl[rr] * lda + C) * 2u; }
    }
    f32x4 acc[2][2][4][2];
#pragma unroll
    for (int a = 0; a < 2; ++a)
#pragma unroll
        for (int b = 0; b < 2; ++b)
#pragma unroll
            for (int m = 0; m < 4; ++m)
#pragma unroll
                for (int n = 0; n < 2; ++n) acc[a][b][m][n] = (f32x4){0.f, 0.f, 0.f, 0.f};
    bf16x8 At[4][2], B0[2][2], B1[2][2];
    const char* cA = cur.A; const char* cB = cur.B;
    PG8_STAGEB(PG8_SB(0, 0), cB); PG8_STAGEB(PG8_SB(0, 1), cB + hstepB); PG8_STAGEA(PG8_SA(0, 0), cA, voffA[0][0], voffA[0][1]); PG8_STAGEA(PG8_SA(0, 1), cA, voffA[1][0], voffA[1][1]);
    if (wr == 1) PG8_BAR;
    PG8_WAIT_V(2); PG8_BAR;
    PG8_STAGEB(PG8_SB(1, 0), cB + kstep); PG8_STAGEA(PG8_SA(1, 0), cA + kstep, voffA[0][0], voffA[0][1]); PG8_STAGEB(PG8_SB(1, 1), cB + hstepB + kstep);
    PG8_WAIT_V(6); PG8_BAR;
    for (;;) {
        const bool has_next = S.next(ui + 1, nxt);
        const char* nA = has_next ? nxt.A : cA; const char* nB = has_next ? nxt.B : cB;
        if constexpr (GATHER) {
            if (has_next) {
#pragma unroll
                for (int h = 0; h < 2; ++h)
#pragma unroll
                    for (int i = 0; i < 2; ++i) { int R, C; stage_rc(tid * 16 + i * 8192, R, C); int rr = h * HALF + R; rr = rr < nxt.gvalid ? rr : nxt.gvalid - 1; voffAn[h][i] = (unsigned)(nxt.gl[rr] * lda + C) * 2u; }
            } else {
#pragma unroll
                for (int h = 0; h < 2; ++h)
#pragma unroll
                    for (int i = 0; i < 2; ++i) voffAn[h][i] = voffA[h][i];
            }
        }
        const int hmu = __builtin_amdgcn_readfirstlane(cur.hm); const bool hm0 = (hmu & 1) != 0, hm1 = (hmu & 2) != 0;
        for (int t = 0; t < nt; t += 2) {
            const bool last = (t == nt - 2);
            const char* a1 = cA + (size_t)(t + 1) * kstep;
            const char* a2 = last ? nA : cA + (size_t)(t + 2) * kstep; const char* b2 = last ? nB : cB + (size_t)(t + 2) * kstep;
            const char* a3 = a2 + kstep; const char* b3 = b2 + kstep;
            PG8_LDB(B0, 0, 0); PG8_LDB(B1, 0, 1); PG8_SCHED; PG8_LDA(At, 0, 0); PG8_STAGEA(PG8_SA(1, 1), a1, voffA[1][0], voffA[1][1]);
            PG8_WAIT_V(8); PG8_WAIT_L(0); PG8_BAR; if (hm0) { PG8_MMA(0, 0, At, B0); PG8_MMA(0, 1, At, B1); } PG8_BAR; PG8_SCHED;
            if constexpr (GATHER) { if (last) { voffA[0][0] = voffAn[0][0]; voffA[0][1] = voffAn[0][1]; voffA[1][0] = voffAn[1][0]; voffA[1][1] = voffAn[1][1]; } }
            PG8_LDA(At, 0, 1); PG8_STAGEB(PG8_SB(0, 0), b2); PG8_STAGEB(PG8_SB(0, 1), b2 + hstepB); PG8_STAGEA(PG8_SA(0, 0), a2, voffA[0][0], voffA[0][1]);
            PG8_WAIT_V(8); PG8_WAIT_L(0); PG8_BAR; if (hm1) { PG8_MMA(1, 0, At, B0); PG8_MMA(1, 1, At, B1); } PG8_BAR; PG8_SCHED;
            PG8_LDB(B0, 1, 0); PG8_LDB(B1, 1, 1); PG8_SCHED; PG8_LDA(At, 1, 0); PG8_STAGEA(PG8_SA(0, 1), a2, voffA[1][0], voffA[1][1]);
            PG8_WAIT_V(8); PG8_WAIT_L(0); PG8_BAR; if (hm0) { PG8_MMA(0, 0, At, B0); PG8_MMA(0, 1, At, B1); } PG8_BAR; PG8_SCHED;
            PG8_LDA(At, 1, 1); PG8_STAGEB(PG8_SB(1, 0), b3); PG8_STAGEB(PG8_SB(1, 1), b3 + hstepB); PG8_STAGEA(PG8_SA(1, 0), a3, voffA[0][0], voffA[0][1]);
            PG8_WAIT_V(8); PG8_WAIT_L(0); PG8_BAR; if (hm1) { PG8_MMA(1, 0, At, B0); PG8_MMA(1, 1, At, B1); } PG8_BAR; PG8_SCHED;
        }
        if (wr == 0) PG8_BAR;
        E(acc, cur, wr, wc, fr, fq);
        if (!has_next) break;
#pragma unroll
        for (int a = 0; a < 2; ++a)
#pragma unroll
            for (int b = 0; b < 2; ++b)
#pragma unroll
                for (int m = 0; m < 4; ++m)
#pragma unroll
                    for (int n = 0; n < 2; ++n) acc[a][b][m][n] = (f32x4){0.f, 0.f, 0.f, 0.f};
        cur = nxt; cA = nA; cB = nB; ++ui;
        if (wr == 1) PG8_BAR;
    }
    PG8_WAIT_V(0);
    PG8_BAR;
#undef PG8_SA
#undef PG8_SB
#undef PG8_STAGEA
#undef PG8_STAGEB
#undef PG8_LDA
#undef PG8_LDB
#undef PG8_MMA
#undef PG8_WAIT_V
#undef PG8_WAIT_L
#undef PG8_BAR
#undef PG8_SCHED
}

DI void static_order_L(int nM, int nN, int Lidx, int& pm, int& pn) {
    const int nwg = nM * nN;
    int wgid = Lidx; { const int q = nwg / NXCD, r = nwg % NXCD, xcd = wgid % NXCD, off = wgid / NXCD; wgid = (xcd < r ? xcd * (q + 1) : r * (q + 1) + (xcd - r) * q) + off; }
    const int nig = WGM * nN, gid = wgid / nig, fm = gid * WGM, gsz = (nM - fm) < WGM ? (nM - fm) : WGM;
    pm = fm + ((wgid % nig) % gsz); pn = (wgid % nig) / gsz;
}
DI bool split_round(long L, int U, int G, int& unit, int& hm) {
    const int NF = (U / G) * G, Lo = U - NF;
    hm = 3;
    if (L < NF) { unit = (int)L; return true; }
    if (2 * Lo <= G) { const long hu = L - NF; if (hu >= 2 * Lo) return false; unit = NF + (int)(hu >> 1); hm = 1 << (int)(hu & 1); return true; }
    if (L >= U) return false;
    unit = (int)L; return true;
}
struct SchedDense {
    const char* A; const char* Bt; int lda, ldb; int pm0, nM, pn0, nN; int pm0b, nMb, pn0b, nNb; int G, c;
    DI bool next(int i, UnitG& u) const {
        int pm, pn, unit, hm; const int n1 = nM * nN, n2 = nMb * nNb;
        if (!split_round((long)i * G + c, n1 + n2, G, unit, hm)) return false;
        if (unit < n1) { static_order_L(nM, nN, unit, pm, pn); pm += pm0; pn += pn0; }
        else { const int L2 = unit - n1; pm = pm0b + L2 % nMb; pn = pn0b + L2 / nMb; }
        u.A = A + (size_t)pm * BM * lda * 2; u.B = Bt + (size_t)pn * BM * ldb * 2; u.gl = nullptr; u.gvalid = BM; u.r0 = pm * BM; u.c0 = pn * BM; u.e0 = BM; u.e1 = 0; u.hm = hm; return true;
    }
};
struct EpiBf16G {
    static constexpr bool PERM = true;
    bf16* O; int ldc; int coff;
    DI void operator()(const f32x4 (&acc)[2][2][4][2], const UnitG& u, int wr, int wc, int fr, int fq) const {
        const int col0 = u.c0 + coff + wc * 32 + 8 * fq;
#pragma unroll
        for (int ai = 0; ai < 2; ++ai)
#pragma unroll
            for (int m = 0; m < 4; ++m) { const int lr = ai * HALF + wr * 64 + m * 16 + fr;
                if (lr < u.e0 && ((u.hm >> ai) & 1)) { bf16* rowp = O + (size_t)(u.r0 + lr) * ldc + col0;
#pragma unroll
                    for (int bj = 0; bj < 2; ++bj) { const f32x4 v0 = acc[ai][bj][m][0], v1 = acc[ai][bj][m][1];
                        v4u w; w.x = cvt_pk_bf16(v0[0], v0[1]); w.y = cvt_pk_bf16(v0[2], v0[3]); w.z = cvt_pk_bf16(v1[0], v1[1]); w.w = cvt_pk_bf16(v1[2], v1[3]);
                        *(v4u*)(rowp + bj * HALF) = w; } } }
    }
};
struct EpiSwi {
    static constexpr bool PERM = true;
    bf16* O; int ldc;
    DI void operator()(const f32x4 (&acc)[2][2][4][2], const UnitG& u, int wr, int wc, int fr, int fq) const {
        const int col0 = u.c0 + wc * 32 + 8 * fq;
#pragma unroll
        for (int ai = 0; ai < 2; ++ai)
#pragma unroll
            for (int m = 0; m < 4; ++m) { const int lr = ai * HALF + wr * 64 + m * 16 + fr;
                if (lr < u.e0 && ((u.hm >> ai) & 1)) { bf16* rowp = O + (size_t)(u.r0 + lr) * ldc + col0;
                    float o[8];
#pragma unroll
                    for (int n = 0; n < 2; ++n)
#pragma unroll
                        for (int j = 0; j < 4; ++j) { const float g = acc[ai][0][m][n][j], up = acc[ai][1][m][n][j]; o[n * 4 + j] = siluf(g) * up; }
                    v4u w; w.x = cvt_pk_bf16(o[0], o[1]); w.y = cvt_pk_bf16(o[2], o[3]); w.z = cvt_pk_bf16(o[4], o[5]); w.w = cvt_pk_bf16(o[6], o[7]);
                    *(v4u*)rowp = w; } }
    }
};
struct EpiResid {
    static constexpr bool PERM = false;
    float* xl; float* xc; const float* mods; const float* sl; const float* sc_;
    DI void operator()(const f32x4 (&acc)[2][2][4][2], const UnitG& u, int wr, int wc, int fr, int fq) const {
        const int col0 = u.c0 + wc * 32 + 4 * fq;
#pragma unroll
        for (int ai = 0; ai < 2; ++ai) { if (!((u.hm >> ai) & 1)) continue;
#pragma unroll
            for (int m = 0; m < 4; ++m) { const int row = u.r0 + ai * HALF + wr * 64 + m * 16 + fr;
                const size_t ro = (row < NCTX ? (size_t)row : (size_t)(row - NCTX)) * DM + col0;
                float* xr = (row < NCTX ? xc : xl) + ro; const float* xs = (row < NCTX ? sc_ : sl) + ro;
                const float* g1 = mods + (size_t)row_mod(row) * 6144 + 2 * DM + col0;
#pragma unroll
                for (int bj = 0; bj < 2; ++bj)
#pragma unroll
                    for (int n = 0; n < 2; ++n) { const int o = bj * HALF + n * 16; const f32x4 g = *(const f32x4*)(g1 + o); f32x4 x = *(const f32x4*)(xs + o); x = x + g * acc[ai][bj][m][n]; *(f32x4*)(xr + o) = x; } } }
    }
};
template <int ISCTX> struct EpiChan {
    static constexpr bool PERM = false;
    bf16* GT;
    DI void operator()(const f32x4 (&acc)[2][2][4][2], const UnitG& u, int wr, int wc, int fr, int fq) const {
        constexpr int T = ISCTX ? CT : SEQ, ld = 2 * T;
        const int g = u.e0, j = u.e1;
        bf16* base = ISCTX ? GT + (size_t)j * 512 * ld : GT + (size_t)(j >> 3) * 512 * ld + (j & 7) * 256;
        base += (size_t)(g * 128 + wr * 64 + fr) * ld + wc * 32 + 4 * fq;
#pragma unroll
        for (int ai = 0; ai < 2; ++ai)
#pragma unroll
            for (int m = 0; m < 4; ++m) {
                bf16* rowp = base + (size_t)(m * 16) * ld + ai * T;
#pragma unroll
                for (int bj = 0; bj < 2; ++bj)
#pragma unroll
                    for (int n = 0; n < 2; ++n) { const f32x4 v = acc[ai][bj][m][n]; v2u w; w.x = cvt_pk_bf16(v[0], v[1]); w.y = cvt_pk_bf16(v[2], v[3]); *(v2u*)(rowp + bj * HALF + n * 16) = w; } }
    }
};
}

struct Args { const float* in[28]; float* out; unsigned char* ws; int ph_lo, ph_hi, bar_region, pad; };
enum { I_X = 0, I_C, I_CTX, I_CCTX, I_N1W, I_N2W, I_ADAW, I_ADAB, I_EWIN, I_RDEC, I_RGNW, I_EWOUT, I_OWIN, I_CONVW, I_ALOG, I_DTB, I_DNNW, I_SGUW, I_SGUB, I_OWOUT,
       I_RGW, I_RGB, I_REW, I_REB, I_MWG, I_MWU, I_MWD, I_FNW };

DI void transpose_super(const float* __restrict__ W, int ldw, int k0, int n0, bf16* __restrict__ WT, int ldt, int mode, int dbase, LAS float* scr, int tid) {
    float4 v[8];
#pragma unroll
    for (int i = 0; i < 8; ++i) { const int idx = tid + 512 * i, kk = idx >> 6, n4 = idx & 63; const f32x4 t_ = __builtin_nontemporal_load((const f32x4*)(W + (size_t)(k0 + kk) * ldw + n0 + n4 * 4)); v[i] = make_float4(t_[0], t_[1], t_[2], t_[3]); }
#pragma unroll
    for (int i = 0; i < 8; ++i) { const int idx = tid + 512 * i, kk = idx >> 6, n4 = idx & 63; LAS float* d = scr + (n4 >> 4) * (64 * 65 + 1) + kk * 65 + (n4 & 15) * 4; d[0] = v[i].x; d[1] = v[i].y; d[2] = v[i].z; d[3] = v[i].w; }
    __syncthreads();
#pragma unroll
    for (int s = 0; s < 4; ++s) {
        const int n = tid >> 3, kc = tid & 7; const LAS float* src = scr + s * (64 * 65 + 1) + (kc * 8) * 65 + n;
        v4u o; o.x = pk2(src[0], src[65]); o.y = pk2(src[2 * 65], src[3 * 65]); o.z = pk2(src[4 * 65], src[5 * 65]); o.w = pk2(src[6 * 65], src[7 * 65]);
        const int j = n0 + s * 64 + n;
        const int drow = mode == 0 ? dbase + j : (((j >> 7) << 8) + dbase + (j & 127));
        *(v4u*)(WT + (size_t)drow * ldt + k0 + kc * 8) = o;
    }
    __syncthreads();
}
struct CvtItem { const float* W; bf16* WT; int ldw, k0, n0, ldt, mode, dbase; };
DI CvtItem moe_item(const Args& a, int layer, int item) {
    const int e = item / 96, r = item % 96; CvtItem c;
    bf16* WM1 = (bf16*)(a.ws + WS_WM1) + (size_t)e * 1024 * DM; bf16* WM2 = (bf16*)(a.ws + WS_WM2) + (size_t)e * DM * HID;
    if (r < 32) { c.W = a.in[I_MWG] + ((size_t)layer * NEXP + e) * DM * HID; c.ldw = HID; c.k0 = (r >> 1) * 64; c.n0 = (r & 1) * 256; c.WT = WM1; c.ldt = DM; c.mode = 1; c.dbase = 0; }
    else if (r < 64) { const int q = r - 32; c.W = a.in[I_MWU] + ((size_t)layer * NEXP + e) * DM * HID; c.ldw = HID; c.k0 = (q >> 1) * 64; c.n0 = (q & 1) * 256; c.WT = WM1; c.ldt = DM; c.mode = 1; c.dbase = 128; }
    else { const int q = r - 64; c.W = a.in[I_MWD] + ((size_t)layer * NEXP + e) * HID * DM; c.ldw = DM; c.k0 = (q >> 2) * 64; c.n0 = (q & 3) * 256; c.WT = WM2; c.ldt = HID; c.mode = 0; c.dbase = 0; }
    return c;
}
DI void cvt_load(const CvtItem& c, float4 (&v)[8], int tid) {
#pragma unroll
    for (int i = 0; i < 8; ++i) { const int idx = tid + 512 * i, kk = idx >> 6, n4 = idx & 63; const f32x4 t_ = __builtin_nontemporal_load((const f32x4*)(c.W + (size_t)(c.k0 + kk) * c.ldw + c.n0 + n4 * 4)); v[i] = make_float4(t_[0], t_[1], t_[2], t_[3]); }
}
DI void cvt_store(const CvtItem& c, const float4 (&v)[8], LAS float* scr, int tid) {
#pragma unroll
    for (int i = 0; i < 8; ++i) { const int idx = tid + 512 * i, kk = idx >> 6, n4 = idx & 63; LAS float* d = scr + (n4 >> 4) * (64 * 65 + 1) + kk * 65 + (n4 & 15) * 4; d[0] = v[i].x; d[1] = v[i].y; d[2] = v[i].z; d[3] = v[i].w; }
    __syncthreads();
#pragma unroll
    for (int s4 = 0; s4 < 4; ++s4) {
        const int n = tid >> 3, kc = tid & 7; const LAS float* src = scr + s4 * (64 * 65 + 1) + (kc * 8) * 65 + n;
        v4u o; o.x = pk2(src[0], src[65]); o.y = pk2(src[2 * 65], src[3 * 65]); o.z = pk2(src[4 * 65], src[5 * 65]); o.w = pk2(src[6 * 65], src[7 * 65]);
        const int j = c.n0 + s4 * 64 + n;
        const int drow = c.mode == 0 ? c.dbase + j : (((j >> 7) << 8) + c.dbase + (j & 127));
        __builtin_nontemporal_store(o, (v4u*)(c.WT + (size_t)drow * c.ldt + c.k0 + kc * 8));
    }
}
DI void moe_convert_stream(const Args& a, int layer, int first, int stride, LAS unsigned char* lds, int tid) {
    constexpr int NI = NEXP * 96;
    if (first >= NI) return;
    __syncthreads();
    CvtItem c0 = moe_item(a, layer, first), c1 = c0, c2 = c0; float4 v0[8], v1[8], v2[8];
    cvt_load(c0, v0, tid);
    if (first + stride < NI) { c1 = moe_item(a, layer, first + stride); cvt_load(c1, v1, tid); }
    int par = 0;
    for (int it = first; it < NI; it += stride) {
        const int n2 = it + 2 * stride;
        if (n2 < NI) { c2 = moe_item(a, layer, n2); cvt_load(c2, v2, tid); }
        cvt_store(c0, v0, (LAS float*)(lds + par * 66576), tid); par ^= 1;
        c0 = c1; c1 = c2;
#pragma unroll
        for (int i = 0; i < 8; ++i) { v0[i] = v1[i]; v1[i] = v2[i]; }
    }
    __syncthreads();
}
DI void phase_prep(const int wu, const Args& a, LAS unsigned char* lds) {
    const int tid = tid_opq(wu), bid = blockIdx.x, G = gridDim.x;
    {
        LAS float* s = (LAS float*)lds;
        LAS float* red = s + 9 * 1024;
        bool have = false;
        for (int task = bid; task < 192; task += G) {
            if (!have) { for (int i = tid; i < 9 * 1024; i += NTHR) { const int r = i >> 10, k = i & 1023; const float v = r < 8 ? a.in[I_C][r * 1024 + k] : a.in[I_CCTX][k]; s[i] = v / (1.f + expf(-v)); } have = true; __syncthreads(); }
            const int layer = task / 96, j0 = (task % 96) * 64;
            const int cg = tid & 15, kg = tid >> 4;
            float acc[9][4];
#pragma unroll
            for (int r = 0; r < 9; ++r)
#pragma unroll
                for (int q = 0; q < 4; ++q) acc[r][q] = 0.f;
            const float* W = a.in[I_ADAW] + (size_t)layer * 1024 * 6144 + j0 + cg * 4;
            for (int i = 0; i < 32; ++i) { const int k = kg + 32 * i; const f32x4 w_ = __builtin_nontemporal_load((const f32x4*)(W + (size_t)k * 6144)); const float4 w = make_float4(w_[0], w_[1], w_[2], w_[3]);
#pragma unroll
                for (int r = 0; r < 9; ++r) { const float sv = s[r * 1024 + k]; acc[r][0] += sv * w.x; acc[r][1] += sv * w.y; acc[r][2] += sv * w.z; acc[r][3] += sv * w.w; } }
#pragma unroll
            for (int r = 0; r < 9; ++r)
#pragma unroll
                for (int q = 0; q < 4; ++q) red[(kg * 9 + r) * 64 + cg * 4 + q] = acc[r][q];
            __syncthreads();
            for (int o = tid; o < 9 * 64; o += NTHR) { const int r = o >> 6, c = o & 63; float t = 0.f; for (int g = 0; g < 32; ++g) t += red[(g * 9 + r) * 64 + c];
                ((float*)(a.ws + WS_MODS))[((size_t)layer * 9 + r) * 6144 + j0 + c] = t + a.in[I_ADAB][layer * 6144 + j0 + c]; }
            __syncthreads();
        }
        __syncthreads();
    }
    {
        LAS float* scr = (LAS float*)lds;
        constexpr int I0 = 16 * 10, I1 = 16 * 4, I2 = 16 * 12, I3 = 16 * 4;
        for (int it = bid; it < I0 + I1 + I2 + I3; it += G) {
            int r = it;
            if (r < I0) { transpose_super(a.in[I_EWIN], EIN, (r / 10) * 64, (r % 10) * 256, (bf16*)(a.ws + WS_WIN0), DM, 0, 0, scr, tid); continue; } r -= I0;
            if (r < I1) { transpose_super(a.in[I_EWOUT], DM, (r / 4) * 64, (r % 4) * 256, (bf16*)(a.ws + WS_WOUT0), DM, 0, 0, scr, tid); continue; } r -= I1;
            if (r < I2) { const int ns = r % 12; const int n0 = ns < 8 ? ns * 256 : 2064 + (ns - 8) * 256;
                transpose_super(a.in[I_OWIN], OIN, (r / 12) * 64, n0, (bf16*)(a.ws + WS_WIN1), DM, 0, ns * 256 - n0, scr, tid); continue; } r -= I2;
            transpose_super(a.in[I_OWOUT], DM, (r / 4) * 64, (r % 4) * 256, (bf16*)(a.ws + WS_WOUT1), DM, 0, 0, scr, tid);
        }
    }
    {
        const int gt = bid * NTHR + tid, NT = G * NTHR;
        bf16* W64 = (bf16*)(a.ws + WS_W64);
        for (int it = gt; it < 128 * 64; it += NT) { const int rr = it >> 6, t2 = it & 63, t2p = rr & 63; const float ang = (float)((t2 * t2p) & 63) * (PI2 / 64.f);
            W64[it] = (bf16)f2bf((rr < 64 ? __cosf(ang) : __sinf(ang)) * 0.125f); }
        bf16* W32 = (bf16*)(a.ws + WS_W32);
        for (int it = gt; it < 64 * 64; it += NT) { const int rr = it >> 6, kk = it & 63, pq = rr >> 5, t1p = rr & 31, cs = kk >> 5, t1 = kk & 31; const float ang = (float)((t1 * t1p) & 31) * (PI2 / 32.f);
            const float cv = __cosf(ang), sv = __sinf(ang); W32[it] = (bf16)f2bf((pq == cs ? cv : (pq ? sv : -sv)) * 0.17677669529663687f); }
        bf16* CHT = (bf16*)(a.ws + WS_CHT);
        for (int it = gt; it < 128 * 256; it += NT) { const int cp = it >> 8, kk = it & 255, cc = kk & 127; const float ang = (float)((cp * cc) & 127) * (PI2 / 128.f);
            CHT[it] = (bf16)f2bf((kk < 128 ? __cosf(ang) : -__sinf(ang)) * 0.08838834764831845f); }
        float* TW = (float*)(a.ws + WS_TW);
        for (int it = gt; it < 32 * 64; it += NT) { const int t1 = it >> 6, t2p = it & 63; const float ang = (float)(t1 * t2p) * (PI2 / 2048.f); TW[it * 2] = __cosf(ang); TW[it * 2 + 1] = __sinf(ang); }
        bf16* T256 = (bf16*)(a.ws + WS_T256);
        for (int it = gt; it < 256 * 512; it += NT) { const int tp = it / 512, col = it % 512; const int t = col & 255; const int m = (tp * t) & 255; const float ang = (float)m * (PI2 / 256.f);
            T256[it] = (bf16)f2bf((col < 256 ? __cosf(ang) : -__sinf(ang)) * 0.0625f); }
        bf16* TCH = (bf16*)(a.ws + WS_TCH);
        for (int it = gt; it < 256 * 128; it += NT) { const int rr = it / 128, c = it % 128; const int cp = rr & 127; const int m = (cp * c) & 127; const float ang = (float)m * (PI2 / 128.f);
            TCH[it] = (bf16)f2bf((rr < 128 ? __cosf(ang) : __sinf(ang)) * 0.08838834764831845f); }
        float* RC = (float*)(a.ws + WS_ROPE); float* RS = RC + SEQ * 64;
        for (int it = gt; it < SEQ * 64; it += NT) { const int t = it >> 6, j = it & 63; const int f = j & 31; const float pos = j < 32 ? (float)(t >> 6) : (float)(t & 63);
            const float inv = powf(10000.f, -(float)f / 32.f); float sn, cs; sincosf(pos * inv, &sn, &cs); RC[it] = cs; RS[it] = sn; }
    }
}

DI void moe_offsets_to_lds(const Args& a, int layer, LAS int* moff, int tid) {
    if (tid == 0) { const int* cnt = (const int*)(a.ws + WS_CTL) + CW_CNT + layer * NEXP; int s = 0; for (int e = 0; e < NEXP; ++e) { moff[e] = s; s += cnt[e]; } moff[NEXP] = s; }
    __syncthreads();
}
template <int MODE>
DI void phase_rowB(const int wu, const Args& a, LAS unsigned char* lds, const int nzero = 0) {
    const int tid = tid_opq(wu), lane = tid & 63, wv = tid >> 6, fr = lane & 15, fq = lane >> 4;
    LAS int* moff = (LAS int*)(lds + LDSCTL_OFF + 256);
    LAS float* hs = (LAS float*)lds;
    LAS float* part = hs + 32 * 1026;
    if (MODE != 0) moe_offsets_to_lds(a, MODE - 1, moff, tid);
    float* xl = a.out; float* xc = (float*)(a.ws + WS_XC);
    const float* modsP = (const float*)(a.ws + WS_MODS) + (MODE == 2 ? 9 * 6144 : 0);
    const float* modsN = (const float*)(a.ws + WS_MODS) + (MODE == 1 ? 9 * 6144 : 0);
    const float* normw = MODE == 2 ? a.in[I_FNW] : a.in[I_N1W] + (MODE == 1 ? DM : 0);
    const int* tok_e = (const int*)(a.ws + WS_TOKE); const int* tok_r = (const int*)(a.ws + WS_TOKR); const float* tok_g = (const float*)(a.ws + WS_TOKG);
    const bf16* Y = (const bf16*)(a.ws + WS_LAT);
    bf16* H = (bf16*)(a.ws + WS_H);
    const int row0 = MODE == 2 ? NCTX : 0, ngrp = (NTOK - row0) / 32;
    float Bf[32];
    if (MODE == 1) {
#pragma unroll
        for (int s2 = 0; s2 < 32; ++s2) Bf[s2] = a.in[I_OWIN][(size_t)(128 * wv + 4 * s2 + fq) * OIN + 2048 + fr];
    }
    f32x4 nw4[4];
#pragma unroll
    for (int j = 0; j < 4; ++j) nw4[j] = *(const f32x4*)(normw + j * 256 + lane * 4);
    for (int grp = blockIdx.x; grp < ngrp; grp += gridDim.x) {
        if (MODE == 1) __syncthreads();
        const int rb = row0 + grp * 32 + 4 * wv, mr = row_mod(rb);
        f32x4 x[4][4];
        if (MODE == 0) {
#pragma unroll
            for (int rr = 0; rr < 4; ++rr) { const int r = rb + rr; const float* src = r < NCTX ? a.in[I_CTX] + (size_t)r * DM : a.in[I_X] + (size_t)(r - NCTX) * DM;
#pragma unroll
                for (int j = 0; j < 4; ++j) x[rr][j] = __builtin_nontemporal_load((const f32x4*)(src + j * 256 + lane * 4)); }
        } else {
            int s0[4], s1[4]; float g0[4], g1[4];
#pragma unroll
            for (int rr = 0; rr < 4; ++rr) { const int r = rb + rr; s0[rr] = moff[tok_e[r * 2]] + tok_r[r * 2]; s1[rr] = moff[tok_e[r * 2 + 1]] + tok_r[r * 2 + 1]; g0[rr] = tok_g[r * 2]; g1[rr] = tok_g[r * 2 + 1]; }
            v2u y0[4][4], y1[4][4];
#pragma unroll
            for (int rr = 0; rr < 4; ++rr) { const int r = rb + rr; const float* xs = r < NCTX ? xc + (size_t)r * DM : xl + (size_t)(r - NCTX) * DM;
#pragma unroll
                for (int j = 0; j < 4; ++j) { x[rr][j] = MODE == 2 ? __builtin_nontemporal_load((const f32x4*)(xs + j * 256 + lane * 4)) : *(const f32x4*)(xs + j * 256 + lane * 4); y0[rr][j] = __builtin_nontemporal_load((const v2u*)(Y + (size_t)s0[rr] * DM + j * 256 + lane * 4)); y1[rr][j] = __builtin_nontemporal_load((const v2u*)(Y + (size_t)s1[rr] * DM + j * 256 + lane * 4)); } }
#pragma unroll
            for (int j = 0; j < 4; ++j) { const f32x4 g2 = *(const f32x4*)(modsP + (size_t)mr * 6144 + 5 * DM + j * 256 + lane * 4);
#pragma unroll
                for (int rr = 0; rr < 4; ++rr) { const v2u a0 = y0[rr][j], a1 = y1[rr][j]; f32x4 mo;
                    mo[0] = g0[rr] * __uint_as_float(a0.x << 16) + g1[rr] * __uint_as_float(a1.x << 16); mo[1] = g0[rr] * __uint_as_float(a0.x & 0xffff0000u) + g1[rr] * __uint_as_float(a1.x & 0xffff0000u);
                    mo[2] = g0[rr] * __uint_as_float(a0.y << 16) + g1[rr] * __uint_as_float(a1.y << 16); mo[3] = g0[rr] * __uint_as_float(a0.y & 0xffff0000u) + g1[rr] * __uint_as_float(a1.y & 0xffff0000u);
                    x[rr][j] = x[rr][j] + g2 * mo; } }
        }
        f32x4 sh[4], sc[4];
        if (MODE != 2) {
#pragma unroll
            for (int j = 0; j < 4; ++j) { sh[j] = *(const f32x4*)(modsN + (size_t)mr * 6144 + j * 256 + lane * 4); sc[j] = *(const f32x4*)(modsN + (size_t)mr * 6144 + DM + j * 256 + lane * 4); }
        }
#pragma unroll
        for (int rr = 0; rr < 4; ++rr) {
            const int r = rb + rr;
            float* xs = r < NCTX ? xc + (size_t)r * DM : xl + (size_t)(r - NCTX) * DM;
            float ss = 0.f;
#pragma unroll
            for (int j = 0; j < 4; ++j) ss += (x[rr][j][0] * x[rr][j][0] + x[rr][j][1] * x[rr][j][1]) + (x[rr][j][2] * x[rr][j][2] + x[rr][j][3] * x[rr][j][3]);
            const float rs = rsqrtf(wave_sum(ss) * (1.f / DM) + EPS);
            if (MODE == 2) {
#pragma unroll
                for (int j = 0; j < 4; ++j) { f32x4 ov = x[rr][j] * rs * nw4[j]; if (r - NCTX < nzero) ov = (f32x4){0.f, 0.f, 0.f, 0.f}; __builtin_nontemporal_store(ov, (f32x4*)(a.out + (size_t)(r - NCTX) * DM + j * 256 + lane * 4)); }
            } else {
#pragma unroll
                for (int j = 0; j < 4; ++j) { if (MODE != 0) __builtin_nontemporal_store(x[rr][j], (f32x4*)(xs + j * 256 + lane * 4));
                    const f32x4 hv = x[rr][j] * rs * nw4[j] * (sc[j] + 1.f) + sh[j];
                    v2u o; o.x = pk2(hv[0], hv[1]); o.y = pk2(hv[2], hv[3]); *(v2u*)(H + (size_t)r * DM + j * 256 + lane * 4) = o;
                    if (MODE == 1) { LAS float* hp = hs + (4 * wv + rr) * 1026 + j * 256 + lane * 4; *(LAS f32x2*)hp = (f32x2){hv[0], hv[1]}; *(LAS f32x2*)(hp + 2) = (f32x2){hv[2], hv[3]}; } }
            }
        }
        if (MODE == 1) {
            __syncthreads();
            f32x4 acc0 = (f32x4){0.f, 0.f, 0.f, 0.f}, acc1 = acc0;
            const LAS float* ap = hs + fr * 1026 + 128 * wv + fq;
#pragma unroll
            for (int s2 = 0; s2 < 32; ++s2) { acc0 = __builtin_amdgcn_mfma_f32_16x16x4f32(ap[4 * s2], Bf[s2], acc0, 0, 0, 0); acc1 = __builtin_amdgcn_mfma_f32_16x16x4f32(ap[16 * 1026 + 4 * s2], Bf[s2], acc1, 0, 0, 0); }
#pragma unroll
            for (int r = 0; r < 4; ++r) { part[(wv * 32 + 4 * fq + r) * 16 + fr] = acc0[r]; part[(wv * 32 + 16 + 4 * fq + r) * 16 + fr] = acc1[r]; }
            __syncthreads();
            { float t = 0.f;
#pragma unroll
                for (int w = 0; w < 8; ++w) t += part[w * 512 + tid];
                ((float*)(a.ws + WS_AB))[(size_t)(row0 + grp * 32) * 16 + tid] = t; }
        }
    }
}
DI f32x4 mfma_f32(float a, float b, f32x4 c) { return __builtin_amdgcn_mfma_f32_16x16x4f32(a, b, c, 0, 0, 0); }
constexpr int HSP = 1026;
template <int LAYER>
DI void phase_rowA(const int wu, const Args& a, LAS unsigned char* lds) {
    const int tid = tid_opq(wu), lane = tid & 63, wv = tid >> 6, fr = lane & 15, fq = lane >> 4;
    LAS float* hs = (LAS float*)lds;
    LAS float* part = hs + 16 * HSP;
    LAS float* lgs = part + 8 * 16 * 48;
    LAS int* lcnt = (LAS int*)(lds + LDSCTL_OFF + 1024); LAS int* lbase = lcnt + 32;
    const float* xl = a.out; const float* xc = (const float*)(a.ws + WS_XC);
    const float* mods = (const float*)(a.ws + WS_MODS) + LAYER * 9 * 6144;
    const float* normw = a.in[I_N2W] + LAYER * DM;
    const float* wg = a.in[I_RGW] + LAYER * DM * 4; const float* bg = a.in[I_RGB] + LAYER * 4; const float* we = a.in[I_REW] + LAYER * DM * 32; const float* be = a.in[I_REB] + LAYER * 32;
    int* cnt = (int*)(a.ws + WS_CTL) + CW_CNT + LAYER * NEXP;
    int* tok_e = (int*)(a.ws + WS_TOKE); int* tok_r = (int*)(a.ws + WS_TOKR); float* tok_g = (float*)(a.ws + WS_TOKG); int* list = (int*)(a.ws + WS_LIST);
    bf16* H = (bf16*)(a.ws + WS_H);
    const int row0 = LAYER == 1 ? NCTX : 0, ngrp = (NTOK - row0) / 16;
    __syncthreads();
    if (tid < 32) lcnt[tid] = 0;
    float Bf[32][3];
#pragma unroll
    for (int s2 = 0; s2 < 32; ++s2) { const int k = 128 * wv + 4 * s2 + fq;
        Bf[s2][0] = fr < 4 ? wg[(size_t)k * 4 + fr] : we[(size_t)k * 32 + fr - 4];
        Bf[s2][1] = we[(size_t)k * 32 + 12 + fr];
        Bf[s2][2] = fr < 4 ? we[(size_t)k * 32 + 28 + fr] : 0.f; }
    f32x4 nw4[4];
#pragma unroll
    for (int j = 0; j < 4; ++j) nw4[j] = *(const f32x4*)(normw + j * 256 + lane * 4);
    f32x4 xn[2][4], shn[4], scn[4];
#define ROWA_LOAD(g_) do { const int _r0 = row0 + (g_) * 16 + 2 * wv; const int _mr = row_mod(_r0); \
        _Pragma("unroll") for (int rr = 0; rr < 2; ++rr) { const int _r = _r0 + rr; const float* _xs = _r < NCTX ? xc + (size_t)_r * DM : xl + (size_t)(_r - NCTX) * DM; \
            _Pragma("unroll") for (int j = 0; j < 4; ++j) xn[rr][j] = *(const f32x4*)(_xs + j * 256 + lane * 4); } \
        _Pragma("unroll") for (int j = 0; j < 4; ++j) { shn[j] = *(const f32x4*)(mods + (size_t)_mr * 6144 + 3 * DM + j * 256 + lane * 4); scn[j] = *(const f32x4*)(mods + (size_t)_mr * 6144 + 4 * DM + j * 256 + lane * 4); } } while (0)
    const int bid = blockIdx.x, G_ = gridDim.x;
    constexpr int NPASS = LAYER == 0 ? 2 : 1;
#define ROWA_RANGE(pass_) int gfirst, gend, gstride; \
        if (LAYER == 1) { gfirst = bid; gend = ngrp; gstride = G_; } \
        else if ((pass_) == 0) { gfirst = bid >= 32 ? 128 + bid - 32 : ngrp; gend = ngrp; gstride = G_ - 32; } \
        else { gfirst = bid >= 160 ? bid - 160 : (bid < 32 ? 96 + bid : 128); gend = 128; gstride = 128; }
    for (int pass = 0; pass < NPASS; ++pass) {
    ROWA_RANGE(pass)
    if (LAYER == 0 && pass == 1) {
        if (tid == 0) { unsigned* dn = (unsigned*)(a.ws + WS_CTL) + CW_CTXDONE; unsigned sp = 0;
            while (__hip_atomic_load(dn, __ATOMIC_RELAXED, __HIP_MEMORY_SCOPE_AGENT) < 32u && ++sp < (1u << 22)) __builtin_amdgcn_s_sleep(2);
            __builtin_amdgcn_fence(__ATOMIC_ACQUIRE, "agent"); asm volatile("s_waitcnt vmcnt(0)" ::: "memory"); }
        __syncthreads();
    }
    if (gfirst < gend) ROWA_LOAD(gfirst);
    for (int grp = gfirst; grp < gend; grp += gstride) {
        const int r0 = row0 + grp * 16;
        __syncthreads();
#pragma unroll
        for (int rr = 0; rr < 2; ++rr) {
            const int r = r0 + 2 * wv + rr;
            float ss = 0.f;
#pragma unroll
            for (int j = 0; j < 4; ++j) ss += (xn[rr][j][0] * xn[rr][j][0] + xn[rr][j][1] * xn[rr][j][1]) + (xn[rr][j][2] * xn[rr][j][2] + xn[rr][j][3] * xn[rr][j][3]);
            const float rs = rsqrtf(wave_sum(ss) * (1.f / DM) + EPS);
#pragma unroll
            for (int j = 0; j < 4; ++j) {
                const f32x4 hv = xn[rr][j] * rs * nw4[j] * (scn[j] + 1.f) + shn[j];
                v2u o; o.x = pk2(hv[0], hv[1]); o.y = pk2(hv[2], hv[3]); *(v2u*)(H + (size_t)r * DM + j * 256 + lane * 4) = o;
                LAS float* hp = hs + (2 * wv + rr) * HSP + j * 256 + lane * 4;
                *(LAS f32x2*)hp = (f32x2){hv[0], hv[1]}; *(LAS f32x2*)(hp + 2) = (f32x2){hv[2], hv[3]}; }
        }
        if (grp + gstride < gend) ROWA_LOAD(grp + gstride);
        __syncthreads();
        {
            f32x4 acc[3];
#pragma unroll
            for (int cb = 0; cb < 3; ++cb) acc[cb] = (f32x4){0.f, 0.f, 0.f, 0.f};
            const LAS float* ap = hs + fr * HSP + 128 * wv + fq;
#pragma unroll
            for (int s2 = 0; s2 < 32; ++s2) { const float av = ap[4 * s2];
#pragma unroll
                for (int cb = 0; cb < 3; ++cb) acc[cb] = mfma_f32(av, Bf[s2][cb], acc[cb]); }
#pragma unroll
            for (int cb = 0; cb < 3; ++cb)
#pragma unroll
                for (int r = 0; r < 4; ++r) part[(wv * 16 + 4 * fq + r) * 48 + 16 * cb + fr] = acc[cb][r];
        }
        __syncthreads();
        for (int o = tid; o < 16 * 36; o += NTHR) { const int i = o / 36, j = o % 36; float t = j < 4 ? bg[j] : be[j - 4];
#pragma unroll
            for (int w = 0; w < 8; ++w) t += part[(w * 16 + i) * 48 + j];
            lgs[o] = t; }
        __syncthreads();
        if (tid < 16) {
            const int r = r0 + tid; const LAS float* lg = lgs + tid * 36;
            int grpi = 0; float mx = lg[0];
            for (int g = 1; g < 4; ++g) if (lg[g] > mx) { mx = lg[g]; grpi = g; }
            float den = 0.f;
            for (int g = 0; g < 4; ++g) den += __expf(lg[g] - mx);
            const float pg = 1.f / den;
            const LAS float* le = lg + 4 + grpi * 8;
            int i0 = 0; float l0 = le[0];
            for (int i = 1; i < 8; ++i) if (le[i] > l0) { l0 = le[i]; i0 = i; }
            int i1 = 0; float l1 = -INFINITY;
            for (int i = 0; i < 8; ++i) if (i != i0 && le[i] > l1) { l1 = le[i]; i1 = i; }
            const float e1 = __expf(l1 - l0), inv = 1.f / (1.f + e1);
            const int ex0 = grpi * 8 + i0, ex1 = grpi * 8 + i1;
            tok_e[r * 2] = ex0; tok_e[r * 2 + 1] = ex1; tok_g[r * 2] = pg * inv; tok_g[r * 2 + 1] = pg * e1 * inv;
            tok_r[r * 2] = __hip_atomic_fetch_add(lcnt + ex0, 1, __ATOMIC_RELAXED, __HIP_MEMORY_SCOPE_WORKGROUP); tok_r[r * 2 + 1] = __hip_atomic_fetch_add(lcnt + ex1, 1, __ATOMIC_RELAXED, __HIP_MEMORY_SCOPE_WORKGROUP);
        }
    }
    }
    __syncthreads();
    if (tid < 32) { const int n = lcnt[tid]; lbase[tid] = n ? atomicAdd(cnt + tid, n) : 0; }
    __syncthreads();
#undef ROWA_LOAD
    for (int pass = 0; pass < NPASS; ++pass) {
        ROWA_RANGE(pass)
        for (int grp = gfirst; grp < gend; grp += gstride) {
            if (tid < 32) { const int r = row0 + grp * 16 + (tid >> 1), q = tid & 1; const int e = tok_e[r * 2 + q]; const int k = lbase[e] + tok_r[r * 2 + q]; tok_r[r * 2 + q] = k; list[(size_t)e * NTOK + k] = r; }
        }
    }
#undef ROWA_RANGE
}

struct SchedMoe {
    const LAS int* tpre; const LAS int* moff; const int* cnt; const char* A; const char* Bt; const int* list; int which; int G, c;
    DI bool next(int i, pg8::UnitG& u) const {
        int unit, hm;
        if (!pg8::split_round((long)i * G + c, tpre[NEXP] * 4, G, unit, hm)) return false;
        const int tile = unit >> 2, pn = unit & 3; u.hm = hm;
        int e = 0;
        for (int q = 1; q < NEXP; ++q) e = tile >= tpre[q] ? q : e;
        const int pm = tile - tpre[e]; const int valid = min(256, cnt[e] - pm * 256);
        u.gvalid = valid; u.e0 = valid; u.e1 = 0; u.r0 = moff[e] + pm * 256;
        if (which == 1) { u.A = A; u.gl = list + (size_t)e * NTOK + pm * 256; u.B = Bt + ((size_t)e * 1024 + pn * 256) * DM * 2; u.c0 = pn * 128; }
        else { u.A = A + (size_t)u.r0 * HID * 2; u.gl = nullptr; u.B = Bt + ((size_t)e * 1024 + pn * 256) * HID * 2; u.c0 = pn * 256; }
        return true;
    }
};
template <int WHICH>
DI void phase_moe_gemm(const int wu, const Args& a, int layer, LAS unsigned char* lds) {
    const int tid = tid_opq(wu);
    LAS int* moff = (LAS int*)(lds + LDSCTL_OFF + 256); LAS int* tpre = moff + 40;
    const int* cnt = (const int*)(a.ws + WS_CTL) + CW_CNT + layer * NEXP;
    if (tid == 0) { int s = 0, t = 0; for (int e = 0; e < NEXP; ++e) { moff[e] = s; tpre[e] = t; s += cnt[e]; t += (cnt[e] + 255) >> 8; } moff[NEXP] = s; tpre[NEXP] = t; }
    __syncthreads();
    SchedMoe S; S.tpre = tpre; S.moff = moff; S.cnt = cnt; S.list = (const int*)(a.ws + WS_LIST); S.which = WHICH; S.G = gridDim.x; S.c = blockIdx.x;
    if (WHICH == 1) { S.A = (const char*)(a.ws + WS_H); S.Bt = (const char*)(a.ws + WS_WM1); pg8::EpiSwi E{(bf16*)(a.ws + WS_MIX), HID};
        pg8::gemm_phase<pg8::EpiSwi, SchedMoe, true>(wu, lds, DM, DM, DM, S, E); }
    else { S.A = (const char*)(a.ws + WS_MIX); S.Bt = (const char*)(a.ws + WS_WM2); pg8::EpiBf16G E{(bf16*)(a.ws + WS_LAT), DM, 0};
        pg8::gemm_phase<pg8::EpiBf16G, SchedMoe, false>(wu, lds, HID, HID, HID, S, E); }
}

DI void phase_ret_naive(const int wu, const Args& a, LAS unsigned char* lds) {
    LAS float* Qs = (LAS float*)lds; LAS float* Ks = Qs + 64 * 128; LAS float* Vs = Ks + 64 * 128; LAS float* Ss = Vs + 64 * 128;
    const int tid = tid_opq(wu);
    const bf16* lat = (const bf16*)(a.ws + WS_LAT); bf16* mix = (bf16*)(a.ws + WS_MIX);
    const float* RC = (const float*)(a.ws + WS_ROPE); const float* RS = RC + SEQ * 64;
    for (int task = blockIdx.x; task < 36 * 4 * NB; task += gridDim.x) {
        const int it = task % 36, h = (task / 36) & 3, b = task / 144;
        float lg[2];
#pragma unroll
        for (int d = 0; d < 2; ++d) { const float x = a.in[I_RDEC][d * 4 + h]; lg[d] = -log1pf(expf(-x)) * 1.4426950408889634f; }
        auto srow = [&](int s) { return s < CT ? b * CT + s : NCTX + b * SEQ + (s - CT); };
        auto ldqk = [&](int s, int d, int base) {
            const int row = srow(s); const bf16* p = lat + (size_t)row * EIN + base + h * 128; const int j = d & 63;
            const float x1 = bf2f(p[j]), x2 = bf2f(p[j + 64]);
            if (s < CT) return d < 64 ? x1 : x2;
            const int t = s - CT; const float c = RC[t * 64 + j], sn = RS[t * 64 + j];
            return d < 64 ? x1 * c - x2 * sn : x1 * sn + x2 * c; };
        __syncthreads();
        for (int i = tid; i < 64 * 128; i += NTHR) { const int q = i >> 7, d = i & 127; Qs[i] = ldqk(it * 64 + q, d, 0) * 0.08838834764831845f; }
        float o[16];
#pragma unroll
        for (int i = 0; i < 16; ++i) o[i] = 0.f;
        const int qi = tid >> 3, sub = tid & 7;
        const int si = it * 64 + qi; const int p1i = si < CT ? CT - 1 - si : 2559 - si;
        const int njt = it < 4 ? 4 : 36;
        for (int jt = 0; jt < njt; ++jt) {
            __syncthreads();
            for (int i = tid; i < 64 * 128; i += NTHR) { const int q = i >> 7, d = i & 127; Ks[i] = ldqk(jt * 64 + q, d, 512); Vs[i] = bf2f(lat[(size_t)srow(jt * 64 + q) * EIN + 1024 + h * 128 + d]); }
            __syncthreads();
            for (int kk = 0; kk < 8; ++kk) {
                const int j = sub * 8 + kk; const int sj = jt * 64 + j;
                float dot = 0.f;
                for (int d = 0; d < 128; ++d) dot += Qs[qi * 128 + d] * Ks[j * 128 + d];
                const int p1j = sj < CT ? CT - 1 - sj : 2559 - sj;
                float w = 0.f;
                if (sj <= si) w += exp2f(lg[0] * (float)(si - sj));
                if (p1j <= p1i) w += exp2f(lg[1] * (float)(p1i - p1j));
                Ss[qi * 65 + j] = dot * w;
            }
            __syncthreads();
            for (int j = 0; j < 64; ++j) { const float s = Ss[qi * 65 + j];
#pragma unroll
                for (int dd = 0; dd < 16; ++dd) o[dd] += s * Vs[j * 128 + sub * 16 + dd]; }
        }
        float s = 0.f;
#pragma unroll
        for (int i = 0; i < 16; ++i) s += o[i];
        s += __shfl_xor(s, 1); s += __shfl_xor(s, 2); s += __shfl_xor(s, 4);
        const float mu = s * (1.f / 128.f); float q = 0.f;
#pragma unroll
        for (int i = 0; i < 16; ++i) { o[i] -= mu; q += o[i] * o[i]; }
        q += __shfl_xor(q, 1); q += __shfl_xor(q, 2); q += __shfl_xor(q, 4);
        const float rs = rsqrtf(q * (1.f / 128.f) + EPS);
        const int row = srow(si);
        const bf16* gp = lat + (size_t)row * EIN + 1536 + h * 128 + sub * 16; const float* gw = a.in[I_RGNW] + h * 128 + sub * 16;
        bf16* mp = mix + (size_t)row * DM + h * 128 + sub * 16;
#pragma unroll
        for (int i = 0; i < 16; ++i) mp[i] = (bf16)f2bf(o[i] * rs * gw[i] * siluf(bf2f(gp[i])));
    }
}

constexpr int TRP = 272;
constexpr int P64 = 144;
DI bf16x8 frag_row64(const LAS unsigned char* base, int r0, int k0, int lane) { return *(const LAS bf16x8*)(base + (r0 + (lane & 15)) * P64 + (k0 + 8 * (lane >> 4)) * 2); }
DI f32x4 mfma16(bf16x8 a, bf16x8 b, f32x4 c) { return __builtin_amdgcn_mfma_f32_16x16x32_bf16(a, b, c, 0, 0, 0); }
DI bf16x8 frag_row(const LAS unsigned char* base, int r0, int k0, int lane) { return *(const LAS bf16x8*)(base + (r0 + (lane & 15)) * TRP + (k0 + 8 * (lane >> 4)) * 2); }
DI unsigned tr_lane_off(int lane) { const int g = lane >> 4, q = (lane & 15) >> 2, p = lane & 3; return (unsigned)((8 * g + q) * TRP + 8 * p); }
DI void tr_frag4(unsigned addr, bf16x8 (&f)[4]) {
    v2u l0, h0, l1, h1, l2, h2, l3, h3;
    asm volatile("ds_read_b64_tr_b16 %0, %8\n\tds_read_b64_tr_b16 %1, %8 offset:1088\n\t"
                 "ds_read_b64_tr_b16 %2, %8 offset:8704\n\tds_read_b64_tr_b16 %3, %8 offset:9792\n\t"
                 "ds_read_b64_tr_b16 %4, %8 offset:17408\n\tds_read_b64_tr_b16 %5, %8 offset:18496\n\t"
                 "ds_read_b64_tr_b16 %6, %8 offset:26112\n\tds_read_b64_tr_b16 %7, %8 offset:27200\n\ts_waitcnt lgkmcnt(0)"
                 : "=&v"(l0), "=&v"(h0), "=&v"(l1), "=&v"(h1), "=&v"(l2), "=&v"(h2), "=&v"(l3), "=&v"(h3) : "v"(addr) : "memory");
    f[0] = __builtin_bit_cast(bf16x8, (v4u){l0.x, l0.y, h0.x, h0.y}); f[1] = __builtin_bit_cast(bf16x8, (v4u){l1.x, l1.y, h1.x, h1.y});
    f[2] = __builtin_bit_cast(bf16x8, (v4u){l2.x, l2.y, h2.x, h2.y}); f[3] = __builtin_bit_cast(bf16x8, (v4u){l3.x, l3.y, h3.x, h3.y});
}
DI void unpack8(v4u x, float (&o)[8]) {
#pragma unroll
    for (int e = 0; e < 4; ++e) { o[2 * e] = __uint_as_float(x[e] << 16); o[2 * e + 1] = __uint_as_float(x[e] & 0xffff0000u); }
}
DI v4u pack8(const float (&o)[8]) { v4u w; w.x = pg8::cvt_pk_bf16(o[0], o[1]); w.y = pg8::cvt_pk_bf16(o[2], o[3]); w.z = pg8::cvt_pk_bf16(o[4], o[5]); w.w = pg8::cvt_pk_bf16(o[6], o[7]); return w; }
DI void stage_rope_tile(LAS unsigned char* dst, const bf16* src, const float* RC, const float* RS, int tl0, bool rope, float lgw, int wmode, float scale, int tid) {
#pragma unroll
    for (int i = 0; i < 2; ++i) {
        const int id = tid + NTHR * i, r = id >> 3, j0 = (id & 7) * 8;
        const bf16* kp = src + (size_t)r * EIN + j0;
        float x1[8], x2[8], o1[8], o2[8];
        unpack8(*(const v4u*)kp, x1); unpack8(*(const v4u*)(kp + 64), x2);
        float w = scale;
        if (wmode == 1) w *= __builtin_amdgcn_exp2f(lgw * (float)(127 - r)); else if (wmode == 2) w *= __builtin_amdgcn_exp2f(lgw * (float)r);
        if (rope) {
            const float* cp = RC + (size_t)(tl0 + r) * 64 + j0; const float* sp = RS + (size_t)(tl0 + r) * 64 + j0;
            const f32x4 c0 = *(const f32x4*)cp, c1 = *(const f32x4*)(cp + 4), s0 = *(const f32x4*)sp, s1 = *(const f32x4*)(sp + 4);
#pragma unroll
            for (int e = 0; e < 8; ++e) { const float c = e < 4 ? c0[e & 3] : c1[e & 3], sn = e < 4 ? s0[e & 3] : s1[e & 3]; o1[e] = (x1[e] * c - x2[e] * sn) * w; o2[e] = (x1[e] * sn + x2[e] * c) * w; }
        } else {
#pragma unroll
            for (int e = 0; e < 8; ++e) { o1[e] = x1[e] * w; o2[e] = x2[e] * w; }
        }
        *(LAS v4u*)(dst + r * TRP + j0 * 2) = pack8(o1); *(LAS v4u*)(dst + r * TRP + (64 + j0) * 2) = pack8(o2);
    }
}
DI void stage_copy_tile(LAS unsigned char* dst, const bf16* src, int ld, int tid) {
#pragma unroll
    for (int i = 0; i < 4; ++i) { const int id = tid + NTHR * i, r = id >> 4, pc = id & 15; *(LAS v4u*)(dst + r * TRP + pc * 16) = *(const v4u*)(src + (size_t)r * ld + pc * 8); }
}
DI void phase_ret_state(const int wu, const Args& a, LAS unsigned char* lds) {
    const int tid = tid_opq(wu), lane = tid & 63, wv = tid >> 6;
    LAS unsigned char* Kt = lds; LAS unsigned char* Vt = lds + 128 * TRP;
    const bf16* lat = (const bf16*)(a.ws + WS_LAT); const float* RC = (const float*)(a.ws + WS_ROPE); const float* RS = RC + SEQ * 64;
    bf16* SP = (bf16*)(a.ws + WS_SPREV);
    const unsigned trK = (unsigned)(size_t)Kt + tr_lane_off(lane) + 2u * (16u * wv), trV = (unsigned)(size_t)Vt + tr_lane_off(lane);
    for (int task = blockIdx.x; task < 64; task += gridDim.x) {
        const int b = task >> 3, h = (task >> 1) & 3, dir = task & 1;
        const float lg = -log1pf(expf(-a.in[I_RDEC][dir * 4 + h])) * 1.4426950408889634f, g128 = exp2f(lg * 128.f);
        f32x4 acc[8];
#pragma unroll
        for (int c = 0; c < 8; ++c) acc[c] = (f32x4){0.f, 0.f, 0.f, 0.f};
        v4u kx1[2], kx2[2], vv[4]; f32x4 kc0[2], kc1[2], ks0[2], ks1[2];
#define R1_LOAD(n_) do { const int _c = dir ? ((n_) < 2 ? 1 - (n_) : 19 - (n_)) : (n_); const bool _ctx = _c < 2; const int _row0 = _ctx ? b * CT + _c * 128 : NCTX + b * SEQ + (_c - 2) * 128, _tl0 = _ctx ? 0 : (_c - 2) * 128; \
            _Pragma("unroll") for (int i = 0; i < 2; ++i) { const int id = tid + NTHR * i, r = id >> 3, j0 = (id & 7) * 8; const bf16* kp = lat + (size_t)(_row0 + r) * EIN + 512 + h * 128 + j0; \
                kx1[i] = *(const v4u*)kp; kx2[i] = *(const v4u*)(kp + 64); const float* cp = RC + (size_t)(_tl0 + r) * 64 + j0; const float* sp_ = RS + (size_t)(_tl0 + r) * 64 + j0; \
                kc0[i] = *(const f32x4*)cp; kc1[i] = *(const f32x4*)(cp + 4); ks0[i] = *(const f32x4*)sp_; ks1[i] = *(const f32x4*)(sp_ + 4); } \
            _Pragma("unroll") for (int i = 0; i < 4; ++i) { const int id = tid + NTHR * i, r = id >> 4, pc = id & 15; vv[i] = *(const v4u*)(lat + (size_t)(_row0 + r) * EIN + 1024 + h * 128 + pc * 8); } } while (0)
        R1_LOAD(0);
        for (int n = 0; n < 18; ++n) {
            const int c = dir ? (n < 2 ? 1 - n : 19 - n) : n;
            const bool isctx = c < 2;
            __syncthreads();
#pragma unroll
            for (int i = 0; i < 2; ++i) { const int id = tid + NTHR * i, r = id >> 3, j0 = (id & 7) * 8;
                float x1[8], x2[8], o1[8], o2[8]; unpack8(kx1[i], x1); unpack8(kx2[i], x2);
                const float w = __builtin_amdgcn_exp2f(lg * (float)(dir ? r : 127 - r));
#pragma unroll
                for (int e = 0; e < 8; ++e) { const float cc = isctx ? 1.f : (e < 4 ? kc0[i][e & 3] : kc1[i][e & 3]), sn = isctx ? 0.f : (e < 4 ? ks0[i][e & 3] : ks1[i][e & 3]); o1[e] = (x1[e] * cc - x2[e] * sn) * w; o2[e] = (x1[e] * sn + x2[e] * cc) * w; }
                *(LAS v4u*)(Kt + r * TRP + j0 * 2) = pack8(o1); *(LAS v4u*)(Kt + r * TRP + (64 + j0) * 2) = pack8(o2); }
#pragma unroll
            for (int i = 0; i < 4; ++i) { const int id = tid + NTHR * i, r = id >> 4, pc = id & 15; *(LAS v4u*)(Vt + r * TRP + pc * 16) = vv[i]; }
            if (n < 17) R1_LOAD(n + 1);
            __syncthreads();
            if (n > 0) {
                bf16* sp = SP + ((size_t)(task * 18 + c) * 128) * 128 + 16 * wv + 4 * (lane >> 4);
#pragma unroll
                for (int cc = 0; cc < 8; ++cc) { v2u w; w.x = pg8::cvt_pk_bf16(acc[cc][0], acc[cc][1]); w.y = pg8::cvt_pk_bf16(acc[cc][2], acc[cc][3]); *(v2u*)(sp + (size_t)(16 * cc + (lane & 15)) * 128) = w; }
            }
#pragma unroll
            for (int cc = 0; cc < 8; ++cc) acc[cc] = acc[cc] * g128;
            bf16x8 af[4]; tr_frag4(trK, af);
#pragma unroll
            for (int cc = 0; cc < 8; ++cc) { bf16x8 bf_[4]; tr_frag4(trV + 32u * cc, bf_);
#pragma unroll
                for (int ks = 0; ks < 4; ++ks) acc[cc] = mfma16(af[ks], bf_[ks], acc[cc]); }
        }
#undef R1_LOAD
    }
}
DI void phase_ret_out(const int wu, const Args& a, LAS unsigned char* lds, const int blk0, const int nblk) {
    const int tid = tid_opq(wu), lane = tid & 63, wv = tid >> 6, fr = lane & 15, fq = lane >> 4;
    LAS unsigned char* Qs = lds; LAS unsigned char* KVs = lds + 128 * TRP; LAS unsigned char* Ps = lds + 2 * 128 * TRP; LAS unsigned char* Ss = lds + 3 * 128 * TRP;
    const bf16* lat = (const bf16*)(a.ws + WS_LAT); const float* RC = (const float*)(a.ws + WS_ROPE); const float* RS = RC + SEQ * 64;
    const bf16* SP = (const bf16*)(a.ws + WS_SPREV); bf16* mix = (bf16*)(a.ws + WS_MIX);
    const unsigned trV = (unsigned)(size_t)KVs + tr_lane_off(lane);
    const int mb = (int)blockIdx.x - blk0;
    if (mb < 0) return;
    for (int task = mb; task < 576; task += nblk) {
        const int c = task % 18, h = (task / 18) & 3, b = task / 72;
        const bool isctx = c < 2; const int row0 = isctx ? b * CT + c * 128 : NCTX + b * SEQ + (c - 2) * 128, tl0 = (c - 2) * 128;
        const float lgf = -log1pf(expf(-a.in[I_RDEC][h])) * 1.4426950408889634f, lgb = -log1pf(expf(-a.in[I_RDEC][4 + h])) * 1.4426950408889634f;
        const bool has_f = c != 0, has_b = c != 1;
        __syncthreads();
        stage_rope_tile(Qs, lat + (size_t)row0 * EIN + h * 128, RC, RS, tl0, !isctx, 0.f, 0, 0.08838834764831845f, tid);
        stage_rope_tile(KVs, lat + (size_t)row0 * EIN + 512 + h * 128, RC, RS, tl0, !isctx, 0.f, 0, 1.f, tid);
        __syncthreads();
        bf16x8 qf[4];
#pragma unroll
        for (int ks = 0; ks < 4; ++ks) qf[ks] = frag_row(Qs, 16 * wv, 32 * ks, lane);
        const int il = 16 * wv + fr;
#pragma unroll
        for (int kb = 0; kb < 8; ++kb) {
            f32x4 pa = (f32x4){0.f, 0.f, 0.f, 0.f};
#pragma unroll
            for (int ks = 0; ks < 4; ++ks) pa = mfma16(frag_row(KVs, 16 * kb, 32 * ks, lane), qf[ks], pa);
#pragma unroll
            for (int r = 0; r < 4; ++r) { const int d = il - (16 * kb + 4 * fq + r); const float w = d == 0 ? 2.f : __builtin_amdgcn_exp2f((d > 0 ? lgf : -lgb) * (float)d); pa[r] *= w; }
            v2u w; w.x = pg8::cvt_pk_bf16(pa[0], pa[1]); w.y = pg8::cvt_pk_bf16(pa[2], pa[3]);
            *(LAS v2u*)(Ps + il * TRP + (16 * kb + 4 * fq) * 2) = w;
        }
        __syncthreads();
        stage_copy_tile(KVs, lat + (size_t)row0 * EIN + 1024 + h * 128, EIN, tid);
        if (has_f) stage_copy_tile(Ss, SP + ((size_t)(((b * 4 + h) * 2 + 0) * 18 + c) * 128) * 128, 128, tid);
        __syncthreads();
        f32x4 ao[8], af_[8], ab[8];
#pragma unroll
        for (int cc = 0; cc < 8; ++cc) { ao[cc] = (f32x4){0.f, 0.f, 0.f, 0.f}; af_[cc] = ao[cc]; ab[cc] = ao[cc]; }
        {
            bf16x8 pf[4];
#pragma unroll
            for (int ks = 0; ks < 4; ++ks) pf[ks] = frag_row(Ps, 16 * wv, 32 * ks, lane);
#pragma unroll
            for (int cc = 0; cc < 8; ++cc) { bf16x8 vf[4]; tr_frag4(trV + 32u * cc, vf);
#pragma unroll
                for (int ks = 0; ks < 4; ++ks) ao[cc] = mfma16(vf[ks], pf[ks], ao[cc]); }
        }
        if (has_f) {
#pragma unroll
            for (int cc = 0; cc < 8; ++cc)
#pragma unroll
                for (int ks = 0; ks < 4; ++ks) af_[cc] = mfma16(frag_row(Ss, 16 * cc, 32 * ks, lane), qf[ks], af_[cc]);
        }
        __syncthreads();
        if (has_b) stage_copy_tile(Ss, SP + ((size_t)(((b * 4 + h) * 2 + 1) * 18 + c) * 128) * 128, 128, tid);
        __syncthreads();
        if (has_b) {
#pragma unroll
            for (int cc = 0; cc < 8; ++cc)
#pragma unroll
                for (int ks = 0; ks < 4; ++ks) ab[cc] = mfma16(frag_row(Ss, 16 * cc, 32 * ks, lane), qf[ks], ab[cc]);
        }
        const float rf = __builtin_amdgcn_exp2f(lgf * (float)(il + 1)), rb = __builtin_amdgcn_exp2f(lgb * (float)(128 - il));
        float sum = 0.f;
#pragma unroll
        for (int cc = 0; cc < 8; ++cc) { ao[cc] = ao[cc] + af_[cc] * rf + ab[cc] * rb; sum += (ao[cc][0] + ao[cc][1]) + (ao[cc][2] + ao[cc][3]); }
        sum += __shfl_xor(sum, 16); sum += __shfl_xor(sum, 32);
        const float mu = sum * (1.f / 128.f); float qq = 0.f;
#pragma unroll
        for (int cc = 0; cc < 8; ++cc) { ao[cc] = ao[cc] - mu; qq += (ao[cc][0] * ao[cc][0] + ao[cc][1] * ao[cc][1]) + (ao[cc][2] * ao[cc][2] + ao[cc][3] * ao[cc][3]); }
        qq += __shfl_xor(qq, 16); qq += __shfl_xor(qq, 32);
        const float rs = rsqrtf(qq * (1.f / 128.f) + EPS);
        const size_t row = (size_t)(row0 + il);
#pragma unroll
        for (int cc = 0; cc < 8; ++cc) { const int col = h * 128 + 16 * cc + 4 * fq;
            const v2u gt = *(const v2u*)(lat + row * EIN + 1536 + col); const f32x4 gw = *(const f32x4*)(a.in[I_RGNW] + col);
            const float g0 = __uint_as_float(gt.x << 16), g1 = __uint_as_float(gt.x & 0xffff0000u), g2 = __uint_as_float(gt.y << 16), g3 = __uint_as_float(gt.y & 0xffff0000u);
            v2u o; o.x = pg8::cvt_pk_bf16(ao[cc][0] * rs * gw[0] * siluf(g0), ao[cc][1] * rs * gw[1] * siluf(g1)); o.y = pg8::cvt_pk_bf16(ao[cc][2] * rs * gw[2] * siluf(g2), ao[cc][3] * rs * gw[3] * siluf(g3));
            *(v2u*)(mix + row * DM + col) = o; }
    }
}


DI void tr_frag2(unsigned addr, bf16x8 (&f)[2]) {
    v2u l0, h0, l1, h1;
    asm volatile("ds_read_b64_tr_b16 %0, %4\n\tds_read_b64_tr_b16 %1, %4 offset:1088\n\tds_read_b64_tr_b16 %2, %4 offset:8704\n\tds_read_b64_tr_b16 %3, %4 offset:9792\n\ts_waitcnt lgkmcnt(0)"
                 : "=&v"(l0), "=&v"(h0), "=&v"(l1), "=&v"(h1) : "v"(addr) : "memory");
    f[0] = __builtin_bit_cast(bf16x8, (v4u){l0.x, l0.y, h0.x, h0.y}); f[1] = __builtin_bit_cast(bf16x8, (v4u){l1.x, l1.y, h1.x, h1.y});
}
constexpr int P256 = 528;
DI void phase_fft_a(const int wu, const Args& a, LAS unsigned char* lds, const int blk0, const int nblk) {
    const int tid = tid_opq(wu), lane = tid & 63, wv = tid >> 6, fr = lane & 15, fq = lane >> 4;
    const int mb_ = (int)blockIdx.x - blk0;
    if (mb_ < 0) return;
    LAS unsigned char* Wl = lds; LAS unsigned char* Ft = lds + 128 * P64;
    const bf16* lat = (const bf16*)(a.ws + WS_LAT); bf16* YB = (bf16*)(a.ws + WS_FOUR + FOUR_GT); const float* TW = (const float*)(a.ws + WS_TW);
    __syncthreads();
#pragma unroll
    for (int k = 0; k < 2; ++k) { const int id = tid + NTHR * k, r = id >> 3, pc = id & 7; *(LAS v4u*)(Wl + r * P64 + pc * 16) = *(const v4u*)((const bf16*)(a.ws + WS_W64) + r * 64 + pc * 8); }
    const unsigned trF = (unsigned)(size_t)Ft + tr_lane_off(lane);
    const int mb = wv & 3, ch0 = (wv >> 2) * 4;
    for (int task = mb_; task < NB * 32 * 4; task += nblk) {
        const int g = task & 3, t1 = (task >> 2) & 31, b = task >> 7;
        __syncthreads();
#pragma unroll
        for (int k = 0; k < 2; ++k) { const int id = tid + NTHR * k, r = id >> 4, pc = id & 15;
            *(LAS v4u*)(Ft + r * TRP + pc * 16) = *(const v4u*)(lat + (size_t)(NCTX + b * SEQ + t1 + 32 * r) * EIN + 2048 + g * 128 + pc * 8); }
        __syncthreads();
        bf16x8 wf[2][2];
#pragma unroll
        for (int cs = 0; cs < 2; ++cs)
#pragma unroll
            for (int ks = 0; ks < 2; ++ks) wf[cs][ks] = frag_row64(Wl, cs * 64 + 16 * mb, 32 * ks, lane);
        const int t2p = 16 * mb + fr; const f32x2 tw = *(const f32x2*)(TW + (size_t)(t1 * 64 + t2p) * 2);
        bf16* yb = YB + (((size_t)(b * 64 + t2p) * 32 + t1) * 2) * 512 + g * 128 + 4 * fq;
#pragma unroll
        for (int q = 0; q < 4; ++q) { const int cb = ch0 + q;
            bf16x8 ff[2]; tr_frag2(trF + 32u * cb, ff);
            f32x4 ac = (f32x4){0.f, 0.f, 0.f, 0.f}, as_ = ac;
            ac = mfma16(ff[0], wf[0][0], ac); ac = mfma16(ff[1], wf[0][1], ac);
            as_ = mfma16(ff[0], wf[1][0], as_); as_ = mfma16(ff[1], wf[1][1], as_);
            const f32x4 yc = ac * tw[0] - as_ * tw[1], ys = as_ * tw[0] + ac * tw[1];
            v2u w0, w1; w0.x = pk2(yc[0], yc[1]); w0.y = pk2(yc[2], yc[3]); w1.x = pk2(ys[0], ys[1]); w1.y = pk2(ys[2], ys[3]);
            *(v2u*)(yb + 16 * cb) = w0; *(v2u*)(yb + 512 + 16 * cb) = w1; }
    }
}
DI void phase_fft_b(const int wu, const Args& a, LAS unsigned char* lds) {
    const int tid = tid_opq(wu), lane = tid & 63, wv = tid >> 6, fr = lane & 15, fq = lane >> 4;
    LAS unsigned char* CHl = lds; LAS unsigned char* W32l = lds + 128 * P256; LAS unsigned char* Yt = W32l + 64 * P64; LAS unsigned char* PQl = Yt + 64 * TRP;
    const bf16* YB = (const bf16*)(a.ws + WS_FOUR + FOUR_GT); bf16* mix = (bf16*)(a.ws + WS_MIX);
    __syncthreads();
#pragma unroll
    for (int k = 0; k < 8; ++k) { const int id = tid + NTHR * k, r = id >> 5, pc = id & 31; *(LAS v4u*)(CHl + r * P256 + pc * 16) = *(const v4u*)((const bf16*)(a.ws + WS_CHT) + r * 256 + pc * 8); }
    { const int r = tid >> 3, pc = tid & 7; *(LAS v4u*)(W32l + r * P64 + pc * 16) = *(const v4u*)((const bf16*)(a.ws + WS_W32) + r * 64 + pc * 8); }
    const unsigned trY = (unsigned)(size_t)Yt + tr_lane_off(lane);
    v4u ya[2];
#define FB_LOAD(task_) do { const int _g = (task_) & 3, _t2p = ((task_) >> 2) & 63, _b = (task_) >> 8; \
        _Pragma("unroll") for (int k = 0; k < 2; ++k) { const int id = tid + NTHR * k, m = id >> 4, pc = id & 15; ya[k] = *(const v4u*)(YB + ((size_t)(_b * 64 + _t2p) * 64 + m) * 512 + _g * 128 + pc * 8); } } while (0)
    if ((int)blockIdx.x < NB * 64 * 4) FB_LOAD(blockIdx.x);
    for (int task = blockIdx.x; task < NB * 64 * 4; task += gridDim.x) {
        const int g = task & 3, t2p = (task >> 2) & 63, b = task >> 8;
        __syncthreads();
#pragma unroll
        for (int k = 0; k < 2; ++k) { const int id = tid + NTHR * k, m = id >> 4, pc = id & 15; *(LAS v4u*)(Yt + ((m & 1) * 32 + (m >> 1)) * TRP + pc * 16) = ya[k]; }
        { const int nt_ = task + gridDim.x; if (nt_ < NB * 64 * 4) FB_LOAD(nt_); }
        __syncthreads();
        {
            const int rb = wv & 3, ch0 = (wv >> 2) * 4;
            bf16x8 wf[2];
#pragma unroll
            for (int ks = 0; ks < 2; ++ks) wf[ks] = frag_row64(W32l, 16 * rb, 32 * ks, lane);
            const int ri = 16 * rb + fr, pq = ri >> 5, t1p = ri & 31;
#pragma unroll
            for (int q = 0; q < 4; ++q) { const int cb = ch0 + q;
                bf16x8 yf[2]; tr_frag2(trY + 32u * cb, yf);
                f32x4 acc = (f32x4){0.f, 0.f, 0.f, 0.f};
                acc = mfma16(yf[0], wf[0], acc); acc = mfma16(yf[1], wf[1], acc);
                v2u w; w.x = pk2(acc[0], acc[1]); w.y = pk2(acc[2], acc[3]);
                *(LAS v2u*)(PQl + t1p * P256 + (pq * 128 + 16 * cb + 4 * fq) * 2) = w; }
        }
        __syncthreads();
        {
            f32x4 z0 = (f32x4){0.f, 0.f, 0.f, 0.f}, z1 = z0;
#pragma unroll
            for (int ks = 0; ks < 8; ++ks) {
                const bf16x8 cf = *(const LAS bf16x8*)(CHl + (16 * wv + fr) * P256 + (32 * ks + 8 * fq) * 2);
                const bf16x8 p0 = *(const LAS bf16x8*)(PQl + fr * P256 + (32 * ks + 8 * fq) * 2), p1 = *(const LAS bf16x8*)(PQl + (16 + fr) * P256 + (32 * ks + 8 * fq) * 2);
                z0 = mfma16(cf, p0, z0); z1 = mfma16(cf, p1, z1); }
            const size_t rowb = (size_t)(NCTX + b * SEQ + t2p); const int col = 512 + g * 128 + 16 * wv + 4 * fq;
            v2u w0, w1; w0.x = pk2(z0[0], z0[1]); w0.y = pk2(z0[2], z0[3]); w1.x = pk2(z1[0], z1[1]); w1.y = pk2(z1[2], z1[3]);
            *(v2u*)(mix + (rowb + 64 * fr) * DM + col) = w0; *(v2u*)(mix + (rowb + 64 * (16 + fr)) * DM + col) = w1;
        }
    }
#undef FB_LOAD
}

struct SchedChan {
    const char* A; const char* lat; int isctx; int G, c;
    DI bool next(int i, pg8::UnitG& u) const { const long L = (long)i * G + c; if (L >= (isctx ? 32 : 256)) return false; const int g = (int)(L & 3), j = (int)(L >> 2);
        const int row0 = isctx ? j * 256 : NCTX + j * 256;
        u.A = A; u.B = lat + ((size_t)row0 * EIN + 2048 + g * 128) * 2; u.gl = nullptr; u.gvalid = 256; u.r0 = 0; u.c0 = 0; u.e0 = g; u.e1 = j; u.hm = 3; return true; }
};
struct SchedTok {
    const char* A; const char* GT; int isctx; int G, c;
    DI bool next(int i, pg8::UnitG& u) const { const long L = (long)i * G + c; u.gl = nullptr; u.gvalid = 256; u.e0 = 256; u.e1 = 0; u.hm = 3;
        if (!isctx) { if (L >= 128) return false; const int pn = (int)(L & 1), pm = (int)(L >> 1) & 7, b = (int)(L >> 4);
            u.A = A + (size_t)pm * 256 * 4096 * 2; u.B = GT + ((size_t)b * 512 + pn * 256) * 4096 * 2; u.r0 = NCTX + b * SEQ + pm * 256; u.c0 = 512 + pn * 256; return true; }
        if (L >= 16) return false; const int pn = (int)(L & 1), b = (int)(L >> 1);
        u.A = A; u.B = GT + ((size_t)b * 512 + pn * 256) * 512 * 2; u.r0 = b * CT; u.c0 = 512 + pn * 256; return true; }
};

DI bf16x8 read2(const LAS unsigned char* p) {
    const v2u lo = *(const LAS v2u*)p, hi = *(const LAS v2u*)(p + 32); return __builtin_bit_cast(bf16x8, (v4u){lo.x, lo.y, hi.x, hi.y}); }
DI bf16x8 pack_tiles(const f32x4& t0, const f32x4& t1) {
    v4u w; w.x = pk2(t0[0], t0[1]); w.y = pk2(t0[2], t0[3]); w.z = pk2(t1[0], t1[1]); w.w = pk2(t1[2], t1[3]); return __builtin_bit_cast(bf16x8, w); }
DI bf16x8 frag_rm(const LAS unsigned char* base, int r0, int k0, int lane, int d) { const int r = r0 + (lane & 15); return *(const LAS bf16x8*)(base + (d ? 63 - r : r) * TRP + (k0 + 8 * (lane >> 4)) * 2); }
constexpr int NDP = NB * 4 * 36;
DI void phase_dn_prep(const int wu, const Args& a, LAS unsigned char* lds) {
    const int tid = tid_opq(wu);
    LAS unsigned char* Qs = lds; LAS unsigned char* Ks = lds + 64 * TRP; LAS unsigned char* Vs = lds + 2 * 64 * TRP;
    LAS unsigned char* XT = lds + 3 * 64 * TRP;
    LAS float* SSQ = (LAS float*)XT;
    constexpr int PD0 = 3 * 64 * TRP + 256 * P64, PDSZ = 20736;
#define DP_LD(d)  ((LAS float*)(lds + PD0 + (d) * PDSZ))
#define DP_LB(d)  (lds + PD0 + (d) * PDSZ + 4352)
#define DP_TM(d)  (lds + PD0 + (d) * PDSZ + 13568)
#define DP_AR(d, k) ((LAS float*)(lds + PD0 + (d) * PDSZ + 18688) + (k) * 64)
    const bf16* lat = (const bf16*)(a.ws + WS_LAT); const float* cw = a.in[I_CONVW]; const float* AB = (const float*)(a.ws + WS_AB);
    bf16* DW = (bf16*)(a.ws + WS_DW); bf16* DKt = (bf16*)(a.ws + WS_DK); bf16* DQ = (bf16*)(a.ws + WS_DQ); bf16* DU = (bf16*)(a.ws + WS_DU); bf16* DA = (bf16*)(a.ws + WS_DA); float* DG = (float*)(a.ws + WS_DG);
    v4u pa0[3], pam[3], paq[3], pb0[3], pbm[3], pbq[3];
#define DP_LOAD(task_, lo_, P0, PM, PQ) do { const int _c = (task_) % 36, _bh = (task_) / 36, _b = _bh >> 2, _h = _bh & 3; const bool _ctx = _c < 4; \
        const int _T = _ctx ? CT : SEQ, _tb = _ctx ? _c * 64 : (_c - 4) * 64, _rowb = _ctx ? _b * CT : NCTX + _b * SEQ; int _tid = tid; asm volatile("" : "+v"(_tid)); \
        _Pragma("unroll") for (int it = 0; it < 3; ++it) { const int id = _tid + NTHR * (it + (lo_)), i = id / 48, gch = id % 48, part = gch >> 4, d0 = (gch & 15) * 8; \
            const int t = _tb + i, col = part * 512 + _h * 128 + d0; const bf16* xp = lat + (size_t)(_rowb + t) * L1N + col; \
            P0[it] = *(const v4u*)xp; PM[it] = *(const v4u*)(xp - (t > 0 ? L1N : 0)); PQ[it] = *(const v4u*)(xp + (t < _T - 1 ? L1N : 0)); } } while (0)
#define DP_CONV(lo_, P0, PM, PQ) do { int _tid = tid; asm volatile("" : "+v"(_tid)); \
        _Pragma("unroll") for (int it = 0; it < 3; ++it) { const int id = _tid + NTHR * (it + (lo_)), i = id / 48, gch = id % 48, part = gch >> 4, d0 = (gch & 15) * 8; \
            const int t = tb + i, col = part * 512 + h * 128 + d0; \
            float x0[8], xm[8], xq[8], y[8]; unpack8(P0[it], x0); unpack8(PM[it], xm); unpack8(PQ[it], xq); \
            if (t == 0) { _Pragma("unroll") for (int e = 0; e < 8; ++e) xm[e] = 0.f; } \
            if (t == T - 1) { _Pragma("unroll") for (int e = 0; e < 8; ++e) xq[e] = 0.f; } \
            const f32x4 w0a = *(const f32x4*)(cw + col), w0b = *(const f32x4*)(cw + col + 4), w1a = *(const f32x4*)(cw + 1536 + col), w1b = *(const f32x4*)(cw + 1536 + col + 4), w2a = *(const f32x4*)(cw + 3072 + col), w2b = *(const f32x4*)(cw + 3072 + col + 4); \
            float ssq = 0.f; \
            _Pragma("unroll") for (int e = 0; e < 8; ++e) { const float w0 = e < 4 ? w0a[e & 3] : w0b[e & 3], w1 = e < 4 ? w1a[e & 3] : w1b[e & 3], w2 = e < 4 ? w2a[e & 3] : w2b[e & 3]; y[e] = siluf(w0 * xm[e] + w1 * x0[e] + w2 * xq[e]); ssq += y[e] * y[e]; } \
            *(LAS v4u*)(lds + part * (64 * TRP) + i * TRP + d0 * 2) = pack8(y); \
            if (part < 2) SSQ[(part * 64 + i) * 16 + (gch & 15)] = ssq; } } while (0)
    if ((int)blockIdx.x < NDP) DP_LOAD(blockIdx.x, 0, pa0, pam, paq);
    const int tid0 = tid;
    for (int task = blockIdx.x; task < NDP; task += gridDim.x) {
        int tid = tid0; asm volatile("" : "+v"(tid));
        const int lane = tid & 63, wv = __builtin_amdgcn_readfirstlane(tid >> 6), fr = lane & 15, fq = lane >> 4;
        const int c = task % 36, bh = task / 36, b = bh >> 2, h = bh & 3;
        const bool isctx = c < 4; const int T = isctx ? CT : SEQ, tb = isctx ? c * 64 : (c - 4) * 64, rowb = isctx ? b * CT : NCTX + b * SEQ;
        DP_LOAD(task, 3, pb0, pbm, pbq);
        __syncthreads();
        DP_CONV(0, pa0, pam, paq);
        asm volatile("" ::: "memory");
        DP_CONV(3, pb0, pbm, pbq);
        { const int nt_ = task + gridDim.x; if (nt_ < NDP) DP_LOAD(nt_, 0, pa0, pam, paq); }
        if (wv < 2) {
            const int d = wv, t = tb + (d ? 63 - lane : lane); const size_t row = (size_t)(rowb + t);
            const float av = AB[row * 16 + d * 4 + h], bt = AB[row * 16 + 8 + d * 4 + h];
            const float z = av + a.in[I_DTB][d * 4 + h]; const float sp = z > 20.f ? z : log1pf(expf(z));
            float g = -expf(a.in[I_ALOG][d * 4 + h]) * sp;
#pragma unroll
            for (int o = 1; o < 64; o <<= 1) { const float v = __shfl_up(g, o); if (lane >= o) g += v; }
            const float gl = __shfl(g, 63);
            DP_AR(d, 0)[lane] = g; DP_AR(d, 1)[lane] = 1.f / (1.f + expf(-bt)); DP_AR(d, 2)[lane] = expf(gl - g);
            if (lane == 63) DG[(bh * 2 + d) * 36 + c] = expf(g);
        }
        __syncthreads();
        if (tid < 128) { const int d = tid >> 6, i = tid & 63, r = d ? 63 - i : i; const LAS float* pq_ = SSQ + r * 16; const LAS float* pk_ = SSQ + (64 + r) * 16; float tq = 0.f, tk = 0.f;
#pragma unroll
            for (int e = 0; e < 16; ++e) { tq += pq_[e]; tk += pk_[e]; }
            const float rq = rsqrtf(tq + EPS) * 0.08838834764831845f, rk = rsqrtf(tk + EPS), eg = __expf(DP_AR(d, 0)[i]);
            DP_AR(d, 3)[i] = DP_AR(d, 1)[i] * eg * rk; DP_AR(d, 4)[i] = eg * rq; DP_AR(d, 5)[i] = DP_AR(d, 2)[i] * rk; DP_AR(d, 6)[i] = rk; DP_AR(d, 7)[i] = rq; }
        __syncthreads();
        for (int i = tid; i < 256 * P64 / 16; i += NTHR) *(LAS v4u*)(XT + i * 16) = (v4u){0u, 0u, 0u, 0u};
#pragma unroll 2
        for (int q8 = 0; q8 < 8; ++q8) {
            const int id = wv * 8 + q8, d = id >> 5, doL = ((id >> 4) & 1) == 0, tI = id & 15, ib = tI >> 2, jb = tI & 3;
            if (doL || !isctx) {
                f32x4 acc = (f32x4){0.f, 0.f, 0.f, 0.f};
                if (jb <= ib) {
#pragma unroll
                    for (int ks = 0; ks < 4; ++ks) acc = mfma16(frag_rm(Ks, 16 * jb, 32 * ks, lane, d), frag_rm(doL ? Ks : Qs, 16 * ib, 32 * ks, lane, d), acc);
                }
                const LAS float* Gs = DP_AR(d, 0); const LAS float* RKP = DP_AR(d, 6);
                const int i = 16 * ib + fr; const float gi = Gs[i], bi = DP_AR(d, 1)[i] * RKP[i], qi = DP_AR(d, 7)[i];
                f32x4 o;
#pragma unroll
                for (int r = 0; r < 4; ++r) { const int j = 16 * jb + 4 * fq + r; const float dd = __expf(gi - Gs[j]) * acc[r] * RKP[j]; o[r] = doL ? (i > j ? bi * dd : 0.f) : (i >= j ? qi * dd : 0.f); }
                if (doL) { if (jb == ib) { LAS float* ld = DP_LD(d) + (ib * 16 + fr) * 17 + 4 * fq; ld[0] = o[0]; ld[1] = o[1]; ld[2] = o[2]; ld[3] = o[3]; }
                    const float z = jb == ib ? 0.f : -1.f; v2u w; w.x = pk2(o[0] * z, o[1] * z); w.y = pk2(o[2] * z, o[3] * z); *(LAS v2u*)(DP_LB(d) + i * P64 + (16 * jb + 4 * fq) * 2) = w; }
                else { v2u w; w.x = pk2(o[0], o[1]); w.y = pk2(o[2], o[3]); *(v2u*)(DA + (size_t)((bh * 2 + d) * 36 + c) * 4096 + i * 64 + 16 * jb + 4 * fq) = w; }
            }
        }
        __syncthreads();
        if (wv < 2) {
            const int d = wv, blk = lane >> 4, cc = lane & 15; const LAS float* Ld = DP_LD(d) + blk * 16 * 17;
            float x[16];
#pragma unroll
            for (int r = 0; r < 16; ++r) { float acc = r == cc ? 1.f : 0.f;
#pragma unroll
                for (int j = 0; j < r; ++j) acc -= Ld[r * 17 + j] * x[j];
                x[r] = acc; }
#pragma unroll
            for (int r = 0; r < 16; ++r) { LAS unsigned short* tp = (LAS unsigned short*)(DP_TM(d) + (16 * blk + r) * 80); tp[16 * (blk & 1) + cc] = (unsigned short)f2bf(x[r]); tp[16 * (1 - (blk & 1)) + cc] = 0; }
        } else if (wv < 4) {
            if (!isctx) { const int d = wv - 2; const LAS float* EGQ = DP_AR(d, 4); bf16* dq = DQ + (size_t)((bh * 2 + d) * 36 + c) * 8192;
#pragma unroll 2
                for (int k = 0; k < 16; ++k) { const int id = lane + 64 * k, i = id >> 4, pc = id & 15; float o[8];
                    unpack8(*(const LAS v4u*)(Qs + (d ? 63 - i : i) * TRP + pc * 16), o); const float eg = EGQ[i];
#pragma unroll
                    for (int e = 0; e < 8; ++e) o[e] *= eg;
                    *(v4u*)(dq + i * 128 + pc * 8) = pack8(o); } }
        } else {
            const int d = (wv - 4) >> 1, dk = ((wv - 4) & 1) * 64 + lane; const LAS float* EGK = DP_AR(d, 5); bf16* kp = DKt + (size_t)((bh * 2 + d) * 36 + c) * 8192 + (size_t)dk * 64;
#pragma unroll 2
            for (int i8 = 0; i8 < 8; ++i8) { float o[8];
#pragma unroll
                for (int e = 0; e < 8; ++e) { const int i = i8 * 8 + e; o[e] = bf2f(*(const LAS unsigned short*)(Ks + (d ? 63 - i : i) * TRP + dk * 2)) * EGK[i]; }
                *(v4u*)(kp + i8 * 8) = pack8(o); }
        }
        __syncthreads();
#pragma unroll 1
        for (int d = 0; d < 2; ++d) {
            const int tix = (bh * 2 + d) * 36 + c;
            {
                const bool isv = wv < 4; const LAS unsigned char* src = isv ? Vs : Ks; const LAS float* CF = isv ? DP_AR(d, 1) : DP_AR(d, 3);
                const LAS unsigned char* Lb = DP_LB(d); const LAS unsigned char* Tm = DP_TM(d);
#pragma unroll 1
                for (int cb2 = 0; cb2 < 2; ++cb2) {
                    const int cb = 2 * wv + cb2, cl = (16 * cb + fr) & 127;
                    LAS unsigned char* xrow = XT + (16 * cb + fr) * P64;
#pragma unroll
                    for (int k = 0; k < 4; ++k) {
                        f32x4 acc;
#pragma unroll
                        for (int r = 0; r < 4; ++r) { const int i = 16 * k + 4 * fq + r; acc[r] = bf2f(*(const LAS unsigned short*)(src + (d ? 63 - i : i) * TRP + cl * 2)) * CF[i]; }
                        if (k >= 1) acc = mfma16(frag_row64(Lb, 16 * k, 0, lane), frag_row64(XT, 16 * cb, 0, lane), acc);
                        if (k == 3) acc = mfma16(frag_row64(Lb, 16 * k, 32, lane), frag_row64(XT, 16 * cb, 32, lane), acc);
                        { v2u w; w.x = pk2(acc[0], acc[1]); w.y = pk2(acc[2], acc[3]); *(LAS v2u*)(xrow + (16 * k + 4 * fq) * 2) = w; }
                        const bf16x8 tf = *(const LAS bf16x8*)(Tm + (16 * k + fr) * 80 + 16 * fq);
                        const f32x4 xk = mfma16(tf, frag_row64(XT, 16 * cb, 32 * (k >> 1), lane), (f32x4){0.f, 0.f, 0.f, 0.f});
                        { v2u w; w.x = pk2(xk[0], xk[1]); w.y = pk2(xk[2], xk[3]); *(LAS v2u*)(xrow + (16 * k + 4 * fq) * 2) = w; }
                    }
                }
            }
            __syncthreads();
#pragma unroll
            for (int k = 0; k < 2; ++k) { const int id = tid + NTHR * k, cidx = id >> 3, pc = id & 7; *(v4u*)(DU + (size_t)tix * 8192 + cidx * 64 + pc * 8) = *(const LAS v4u*)(XT + cidx * P64 + pc * 16); }
#pragma unroll
            for (int k = 0; k < 2; ++k) { const int id = tid + NTHR * k, i = id & 63, d8 = id >> 6; float o[8];
#pragma unroll
                for (int e = 0; e < 8; ++e) o[e] = -bf2f(*(const LAS unsigned short*)(XT + (128 + d8 * 8 + e) * P64 + i * 2));
                *(v4u*)(DW + (size_t)tix * 8192 + i * 128 + d8 * 8) = pack8(o); }
            __syncthreads();
        }
    }
#undef DP_LOAD
#undef DP_CONV
#undef DP_LD
#undef DP_LB
#undef DP_TM
#undef DP_AR
}
DI void phase_dn_scan(const int wu, const Args& a, LAS unsigned char* lds) {
    const int tid = tid_opq(wu), lane = tid & 63, wv = tid >> 6, fr = lane & 15, fq = lane >> 4;
    constexpr int OW = 0, OK_ = 64 * TRP, OQ = OK_ + 128 * P64, OA = OQ + 64 * TRP, BUF = OA + 64 * P64;
    const bf16* DW = (const bf16*)(a.ws + WS_DW); const bf16* DKt = (const bf16*)(a.ws + WS_DK); const bf16* DQ = (const bf16*)(a.ws + WS_DQ); const bf16* DU = (const bf16*)(a.ws + WS_DU);
    const bf16* DA = (const bf16*)(a.ws + WS_DA); const float* DG = (const float*)(a.ws + WS_DG);
    bf16* Oo = (bf16*)(a.ws + WS_FOUR);
    for (int chain = blockIdx.x; chain < 64; chain += gridDim.x) {
        const int b = chain >> 3, h = (chain >> 1) & 3, dir = chain & 1;
        bf16* Od = Oo + (size_t)dir * NLAT * 512 + (size_t)b * SEQ * 512 + h * 128 + 16 * wv + 4 * fq;
        f32x4 S[8];
#pragma unroll
        for (int k = 0; k < 8; ++k) S[k] = (f32x4){0.f, 0.f, 0.f, 0.f};
        v4u pw[2], pk[2], pq[2], pa; v2u un[4], uc[4]; float gln, glc;
        const int w_r0 = tid >> 4, w_pc = tid & 15, k_r0 = tid >> 3, k_pc = tid & 7;
#define DN_LOAD(tixv) do { const size_t _t = (size_t)(tixv); \
            pw[0] = *(const v4u*)(DW + _t * 8192 + (size_t)w_r0 * 128 + w_pc * 8); pw[1] = *(const v4u*)(DW + _t * 8192 + (size_t)(w_r0 + 32) * 128 + w_pc * 8); \
            pk[0] = *(const v4u*)(DKt + _t * 8192 + (size_t)k_r0 * 64 + k_pc * 8); pk[1] = *(const v4u*)(DKt + _t * 8192 + (size_t)(k_r0 + 64) * 64 + k_pc * 8); \
            pq[0] = *(const v4u*)(DQ + _t * 8192 + (size_t)w_r0 * 128 + w_pc * 8); pq[1] = *(const v4u*)(DQ + _t * 8192 + (size_t)(w_r0 + 32) * 128 + w_pc * 8); \
            pa = *(const v4u*)(DA + _t * 4096 + (size_t)k_r0 * 64 + k_pc * 8); \
            _Pragma("unroll") for (int ib = 0; ib < 4; ++ib) un[ib] = *(const v2u*)(DU + _t * 8192 + (size_t)(16 * wv + fr) * 64 + 16 * ib + 4 * fq); \
            gln = DG[_t]; } while (0)
#define DN_WRITE(bufb) do { LAS unsigned char* _b = lds + (bufb); \
            *(LAS v4u*)(_b + OW + w_r0 * TRP + w_pc * 16) = pw[0]; *(LAS v4u*)(_b + OW + (w_r0 + 32) * TRP + w_pc * 16) = pw[1]; \
            *(LAS v4u*)(_b + OK_ + k_r0 * P64 + k_pc * 16) = pk[0]; *(LAS v4u*)(_b + OK_ + (k_r0 + 64) * P64 + k_pc * 16) = pk[1]; \
            *(LAS v4u*)(_b + OQ + w_r0 * TRP + w_pc * 16) = pq[0]; *(LAS v4u*)(_b + OQ + (w_r0 + 32) * TRP + w_pc * 16) = pq[1]; \
            *(LAS v4u*)(_b + OA + k_r0 * P64 + k_pc * 16) = pa; } while (0)
        __syncthreads();
        { const int c0 = dir ? 3 : 0; DN_LOAD(chain * 36 + c0); DN_WRITE(0);
#pragma unroll
          for (int ib = 0; ib < 4; ++ib) uc[ib] = un[ib];
          glc = gln; }
        __syncthreads();
        for (int n = 0; n < 36; ++n) {
            const int c = dir ? (n < 4 ? 3 - n : 39 - n) : n; const bool isctx = c < 4;
            if (n < 35) { const int n1 = n + 1, c1 = dir ? (n1 < 4 ? 3 - n1 : 39 - n1) : n1; DN_LOAD(chain * 36 + c1); }
            const LAS unsigned char* B = lds + (n & 1) * BUF;
            f32x4 vn[4];
#pragma unroll
            for (int ib = 0; ib < 4; ++ib) { vn[ib][0] = __uint_as_float(uc[ib].x << 16); vn[ib][1] = __uint_as_float(uc[ib].x & 0xffff0000u); vn[ib][2] = __uint_as_float(uc[ib].y << 16); vn[ib][3] = __uint_as_float(uc[ib].y & 0xffff0000u); }
            bf16x8 fa[16];
#pragma unroll
            for (int ib = 0; ib < 4; ++ib)
#pragma unroll
                for (int s2 = 0; s2 < 4; ++s2) fa[ib * 4 + s2] = read2(B + OW + (16 * ib + fr) * TRP + (32 * s2 + 4 * fq) * 2);
            bf16x8 sf[4];
#pragma unroll
            for (int s2 = 0; s2 < 4; ++s2) sf[s2] = pack_tiles(S[2 * s2], S[2 * s2 + 1]);
#pragma unroll
            for (int s2 = 0; s2 < 4; ++s2)
#pragma unroll
                for (int ib = 0; ib < 4; ++ib) vn[ib] = mfma16(fa[ib * 4 + s2], sf[s2], vn[ib]);
            bf16x8 fk[16];
#pragma unroll
            for (int kb = 0; kb < 8; ++kb)
#pragma unroll
                for (int s2 = 0; s2 < 2; ++s2) fk[kb * 2 + s2] = read2(B + OK_ + (16 * kb + fr) * P64 + (32 * s2 + 4 * fq) * 2);
            bf16x8 vf[2];
            vf[0] = pack_tiles(vn[0], vn[1]); vf[1] = pack_tiles(vn[2], vn[3]);
            f32x4 Sn[8];
#pragma unroll
            for (int kb = 0; kb < 8; ++kb) Sn[kb] = S[kb] * glc;
#pragma unroll
            for (int s2 = 0; s2 < 2; ++s2)
#pragma unroll
                for (int kb = 0; kb < 8; ++kb) Sn[kb] = mfma16(fk[kb * 2 + s2], vf[s2], Sn[kb]);
            if (!isctx) {
#pragma unroll
                for (int hb = 0; hb < 2; ++hb) {
                    bf16x8 fq_[8], fat[4];
#pragma unroll
                    for (int ib2 = 0; ib2 < 2; ++ib2) { const int ib = hb * 2 + ib2;
#pragma unroll
                        for (int s2 = 0; s2 < 4; ++s2) fq_[ib2 * 4 + s2] = read2(B + OQ + (16 * ib + fr) * TRP + (32 * s2 + 4 * fq) * 2);
#pragma unroll
                        for (int s2 = 0; s2 < 2; ++s2) fat[ib2 * 2 + s2] = read2(B + OA + (16 * ib + fr) * P64 + (32 * s2 + 4 * fq) * 2); }
                    f32x4 o[2];
                    o[0] = (f32x4){0.f, 0.f, 0.f, 0.f}; o[1] = o[0];
#pragma unroll
                    for (int s2 = 0; s2 < 4; ++s2)
#pragma unroll
                        for (int ib2 = 0; ib2 < 2; ++ib2) o[ib2] = mfma16(sf[s2], fq_[ib2 * 4 + s2], o[ib2]);
#pragma unroll
                    for (int s2 = 0; s2 < 2; ++s2)
#pragma unroll
                        for (int ib2 = 0; ib2 < 2; ++ib2) o[ib2] = mfma16(vf[s2], fat[ib2 * 2 + s2], o[ib2]);
#pragma unroll
                    for (int ib2 = 0; ib2 < 2; ++ib2) { const int i = 16 * (hb * 2 + ib2) + fr, t = dir ? (c - 4) * 64 + 63 - i : (c - 4) * 64 + i;
                        v2u w; w.x = pk2(o[ib2][0], o[ib2][1]); w.y = pk2(o[ib2][2], o[ib2][3]); *(v2u*)(Od + (size_t)t * 512) = w; }
                }
            }
#pragma unroll
            for (int kb = 0; kb < 8; ++kb) S[kb] = Sn[kb];
            if (n < 35) { DN_WRITE(((n + 1) & 1) * BUF);
#pragma unroll
                for (int ib = 0; ib < 4; ++ib) uc[ib] = un[ib];
                glc = gln; }
            __syncthreads();
        }
#undef DN_LOAD
#undef DN_WRITE
    }
}
DI void phase_sgu(const int wu, const Args& a, LAS unsigned char* lds) {
    const int tid = tid_opq(wu), wv = tid >> 6, lane = tid & 63, fr = lane & 15, fq = lane >> 4;
    LAS unsigned char* Wb = lds; LAS unsigned char* Vn = lds + 128 * TRP;
    const bf16* lat = (const bf16*)(a.ws + WS_LAT); bf16* mix = (bf16*)(a.ws + WS_MIX);
    const unsigned trV = (unsigned)(size_t)Vn + tr_lane_off(lane);
    const int sg_n = gridDim.x == 256 ? (blockIdx.x < 128 ? 1 : 3) : -1, sg_0 = blockIdx.x < 128 ? (int)blockIdx.x : 128 + ((int)blockIdx.x - 128) * 3;
    for (int ti_ = 0; sg_n < 0 ? ((int)blockIdx.x + ti_ * (int)gridDim.x < NB * 16 * 4) : (ti_ < sg_n); ++ti_) {
        const int task = sg_n < 0 ? (int)blockIdx.x + ti_ * (int)gridDim.x : sg_0 + ti_;
        const int g = task & 3, n = (task >> 2) & 15, b = task >> 6; const int row0 = NCTX + b * SEQ + n * 128;
        __syncthreads();
#pragma unroll 2
        for (int k = 0; k < 8; ++k) { const int id = tid + NTHR * k, p = id >> 5, q4 = id & 31; const f32x4 w = *(const f32x4*)(a.in[I_SGUW] + (size_t)g * 16384 + p * 128 + q4 * 4);
            v2u o; o.x = pk2(w[0], w[1]); o.y = pk2(w[2], w[3]); *(LAS v2u*)(Wb + p * TRP + q4 * 8) = o; }
        for (int q = wv; q < 128; q += NWAVES) { const unsigned u = *(const unsigned*)(lat + (size_t)(row0 + q) * L1N + 2560 + g * 128 + lane * 2);
            float x0 = geluf(__uint_as_float(u << 16)), x1 = geluf(__uint_as_float(u & 0xffff0000u));
            const float mu = wave_sum(x0 + x1) * (1.f / 128.f); x0 -= mu; x1 -= mu;
            const float rs = rsqrtf(wave_sum(x0 * x0 + x1 * x1) * (1.f / 128.f) + EPS);
            *(LAS unsigned*)(Vn + q * TRP + lane * 4) = pk2(x0 * rs, x1 * rs); }
        __syncthreads();
        bf16x8 wf[4];
#pragma unroll
        for (int ks = 0; ks < 4; ++ks) wf[ks] = frag_row(Wb, 16 * wv, 32 * ks, lane);
        const int p = 16 * wv + fr; const size_t row = (size_t)(row0 + p); const float bs = a.in[I_SGUB][g * 128 + p];
        v2u uu8[8];
#pragma unroll
        for (int cb = 0; cb < 8; ++cb) uu8[cb] = *(const v2u*)(lat + row * L1N + 2048 + g * 128 + 16 * cb + 4 * fq);
#pragma unroll
        for (int cb = 0; cb < 8; ++cb) {
            bf16x8 vf[4]; tr_frag4(trV + 32u * cb, vf);
            f32x4 acc = (f32x4){0.f, 0.f, 0.f, 0.f};
#pragma unroll
            for (int ks = 0; ks < 4; ++ks) acc = mfma16(vf[ks], wf[ks], acc);
            const int col = g * 128 + 16 * cb + 4 * fq;
            const v2u uu = uu8[cb];
            const float u0 = geluf(__uint_as_float(uu.x << 16)), u1 = geluf(__uint_as_float(uu.x & 0xffff0000u)), u2 = geluf(__uint_as_float(uu.y << 16)), u3 = geluf(__uint_as_float(uu.y & 0xffff0000u));
            v2u o; o.x = pk2(u0 * (acc[0] + bs), u1 * (acc[1] + bs)); o.y = pk2(u2 * (acc[2] + bs), u3 * (acc[3] + bs));
            *(v2u*)(mix + row * DM + 512 + col) = o;
        }
    }
}
DI void phase_ghn(const int wu, const Args& a) {
    const int tid = tid_opq(wu), wv = tid >> 6, lane = tid & 63;
    const bf16* O0 = (const bf16*)(a.ws + WS_FOUR); const bf16* O1 = O0 + (size_t)NLAT * 512;
    const bf16* lat = (const bf16*)(a.ws + WS_LAT); bf16* mix = (bf16*)(a.ws + WS_MIX); const float* nw = a.in[I_DNNW];
    for (int w = blockIdx.x * NWAVES + wv; w < NLAT * 4; w += gridDim.x * NWAVES) {
        const int rl = w >> 2, h = w & 3, r = NCTX + rl; const size_t oi = (size_t)rl * 512 + h * 128 + lane * 2;
        const unsigned u0 = *(const unsigned*)(O0 + oi), u1 = *(const unsigned*)(O1 + oi);
        const float p = __uint_as_float(u0 << 16) + __uint_as_float(u1 << 16), q = __uint_as_float(u0 & 0xffff0000u) + __uint_as_float(u1 & 0xffff0000u);
        const float rs = rsqrtf(wave_sum(p * p + q * q) * (1.f / 128.f) + EPS);
        const unsigned zz = *(const unsigned*)(lat + (size_t)r * L1N + 1536 + h * 128 + lane * 2);
        const float z0 = __uint_as_float(zz << 16), z1 = __uint_as_float(zz & 0xffff0000u);
        *(unsigned*)(mix + (size_t)r * DM + h * 128 + lane * 2) = pg8::cvt_pk_bf16(p * rs * nw[lane * 2] * siluf(z0), q * rs * nw[lane * 2 + 1] * siluf(z1));
    }
}

constexpr int NPHASE = 20;
__global__ void __launch_bounds__(NTHR, 2) mk_fwd(Args args) {
    extern __shared__ __attribute__((aligned(16))) unsigned char lds_raw[];
    LAS unsigned char* lds = (LAS unsigned char*)lds_raw;
    const int wu = __builtin_amdgcn_readfirstlane(threadIdx.x >> 6);
    const int tid = tid_opq(wu);
    for (int u = tid; u < (LDS_BYTES - LDSCTL_OFF) / 4; u += NTHR) ((LAS unsigned*)(lds + LDSCTL_OFF))[u] = 0u;
    __syncthreads();
    unsigned* ctl = (unsigned*)(args.ws + WS_CTL);
    XcdBarrier bar; bar.bar = ctl + CW_BAR + args.bar_region * XCD_BAR_WORDS; bar.x = 0; bar.st = nullptr;
    const bool one = (args.ph_hi - args.ph_lo) > 1;
    if (one) bar = xcd_barrier_post(ctl + CW_BAR + args.bar_region * XCD_BAR_WORDS, (volatile LAS unsigned*)(lds + LDSCTL_OFF) + 8, tid);
    const int lo = args.ph_lo, hi = args.ph_hi;
#define IN(k) (lo <= (k) && (k) < hi)
#ifdef MK_TIME_PHASE
    unsigned long long t_beg = 0, t_end = 0;
#define SEAM(k) do { if (IN(k) && IN((k) + 1)) xcd_barrier(bar, tid_opq(wu)); if ((k) + 1 == MK_TIME_PHASE) t_beg = __builtin_amdgcn_s_memrealtime(); if ((k) == MK_TIME_PHASE) t_end = __builtin_amdgcn_s_memrealtime(); } while (0)
#else
#define SEAM(k) do { if (IN(k) && IN((k) + 1)) xcd_barrier(bar, tid_opq(wu)); } while (0)
#endif
    const int G = gridDim.x, c = blockIdx.x;
    unsigned char* ws = args.ws;
    if (IN(0)) { phase_prep(wu, args, lds); } SEAM(0);
    if (IN(1)) { phase_rowB<0>(wu, args, lds); } SEAM(1);
    if (IN(2)) {
        pg8::SchedDense S{(const char*)(ws + WS_H), (const char*)(ws + WS_WIN0), DM, DM, 0, NTOK / 256, 0, EIN / 256, 0, 0, 0, 0, G, c};
        pg8::EpiBf16G E{(bf16*)(ws + WS_LAT), EIN, 0};
        pg8::gemm_phase<pg8::EpiBf16G, pg8::SchedDense, false>(wu, lds, DM, DM, DM, S, E);
    } SEAM(2);
    if (IN(3)) {
        phase_ret_state(wu, args, lds);
        phase_fft_a(wu, args, lds, 64, G - 64);
        { SchedChan S{(const char*)(ws + WS_TCH), (const char*)(ws + WS_LAT), 1, G, (c + G - 64) % G}; pg8::EpiChan<1> E{(bf16*)(ws + WS_FOUR + FOUR_GTC)};
          pg8::gemm_phase<pg8::EpiChan<1>, SchedChan, false>(wu, lds, 128, 128, EIN, S, E); }
        if (c >= 64) moe_convert_stream(args, 0, c - 64, G - 64, lds, tid_opq(wu));
    } SEAM(3);
    if (IN(4)) {
        phase_ret_out(wu, args, lds, 0, G);
        phase_fft_b(wu, args, lds);
        __syncthreads();
        pg8::EpiBf16G E{(bf16*)(ws + WS_MIX), DM, 0};
        { SchedTok S{(const char*)(ws + WS_T256), (const char*)(ws + WS_FOUR + FOUR_GTC), 1, G, (c + G - 240) % G};
          pg8::gemm_phase<pg8::EpiBf16G, SchedTok, false>(wu, lds, 512, 512, 512, S, E); }
    } SEAM(4);
    if (IN(5)) {
        pg8::SchedDense S{(const char*)(ws + WS_MIX), (const char*)(ws + WS_WOUT0), DM, DM, NCTX / 256, NLAT / 256, 0, DM / 256, 0, 0, 0, 0, G, c};
        pg8::EpiResid E{args.out, (float*)(ws + WS_XC), (const float*)(ws + WS_MODS), args.in[I_X], args.in[I_CTX]};
        pg8::gemm_phase<pg8::EpiResid, pg8::SchedDense, false>(wu, lds, DM, DM, DM, S, E);
    } SEAM(5);
    if (IN(6)) {
        if (c < 32) {
            pg8::SchedDense S{(const char*)(ws + WS_MIX), (const char*)(ws + WS_WOUT0), DM, DM, 0, NCTX / 256, 0, DM / 256, 0, 0, 0, 0, 32, c};
            pg8::EpiResid E{args.out, (float*)(ws + WS_XC), (const float*)(ws + WS_MODS), args.in[I_X], args.in[I_CTX]};
            pg8::gemm_phase<pg8::EpiResid, pg8::SchedDense, false>(wu, lds, DM, DM, DM, S, E);
            if (tid_opq(wu) == 0) { __builtin_amdgcn_fence(__ATOMIC_RELEASE, "agent"); asm volatile("s_waitcnt vmcnt(0)" ::: "memory");
                __hip_atomic_fetch_add((unsigned*)(ws + WS_CTL) + CW_CTXDONE, 1u, __ATOMIC_RELAXED, __HIP_MEMORY_SCOPE_AGENT); }
        }
        phase_rowA<0>(wu, args, lds);
    } SEAM(6);
    if (IN(7)) { phase_moe_gemm<1>(wu, args, 0, lds); } SEAM(7);
    if (IN(8)) { phase_moe_gemm<2>(wu, args, 0, lds); } SEAM(8);
    if (IN(9)) {
        phase_rowB<1>(wu, args, lds);
    } SEAM(9);
    if (IN(10)) {
        pg8::SchedDense S{(const char*)(ws + WS_H), (const char*)(ws + WS_WIN1), DM, DM, NCTX / 256, NLAT / 256, 0, L1N / 256, 0, NCTX / 256, 2, 4, G, c};
        pg8::EpiBf16G E{(bf16*)(ws + WS_LAT), L1N, 0};
        pg8::gemm_phase<pg8::EpiBf16G, pg8::SchedDense, false>(wu, lds, DM, DM, DM, S, E);
    } SEAM(10);
    if (IN(11)) { phase_dn_prep(wu, args, lds); phase_sgu(wu, args, lds); } SEAM(11);
    if (IN(12)) { phase_dn_scan(wu, args, lds);
        if (c >= 64 && !(c & 1)) moe_convert_stream(args, 1, (c - 64) >> 1, (G - 64) >> 1, lds, tid_opq(wu));
    } SEAM(12);
    if (IN(13)) { phase_ghn(wu, args); } SEAM(13);
    if (IN(14)) {
        pg8::SchedDense S{(const char*)(ws + WS_MIX), (const char*)(ws + WS_WOUT1), DM, DM, NCTX / 256, NLAT / 256, 0, DM / 256, 0, 0, 0, 0, G, c};
        pg8::EpiResid E{args.out, (float*)(ws + WS_XC), (const float*)(ws + WS_MODS) + 9 * 6144, args.out, (const float*)(ws + WS_XC)};
        pg8::gemm_phase<pg8::EpiResid, pg8::SchedDense, false>(wu, lds, DM, DM, DM, S, E);
    } SEAM(14);
    if (IN(15)) { phase_rowA<1>(wu, args, lds); } SEAM(15);
    if (IN(16)) { phase_moe_gemm<1>(wu, args, 1, lds); } SEAM(16);
    if (IN(17)) { phase_moe_gemm<2>(wu, args, 1, lds); } SEAM(17);
#ifdef MK_TIME_PHASE
    if (IN(18)) { int nz = (int)((t_end - t_beg) >> 3); nz = nz < 0 ? 0 : (nz > NLAT ? NLAT : nz); phase_rowB<2>(wu, args, lds, nz); }
#else
    if (IN(18)) { phase_rowB<2>(wu, args, lds); }
#endif
#undef IN
#undef SEAM
}
}

extern "C" void kernel_launch(void* const* d_in, const int* in_sizes, int n_in, void* d_out, int out_size, void* d_ws, size_t ws_size, hipStream_t stream) {
    static int grid = 0;
    if (grid == 0) {
        if (ws_size < WS_END) { fprintf(stderr, "kernel_launch: workspace too small: need %zu, have %zu\n", (size_t)WS_END, ws_size); grid = -1; return; }
        int dev = 0, cus = 0;
        if (hipGetDevice(&dev) != hipSuccess || hipDeviceGetAttribute(&cus, hipDeviceAttributeMultiprocessorCount, dev) != hipSuccess) { grid = -1; return; }
        if (hipFuncSetAttribute((const void*)mk_fwd, hipFuncAttributeMaxDynamicSharedMemorySize, LDS_BYTES) != hipSuccess) { fprintf(stderr, "kernel_launch: hipFuncSetAttribute failed\n"); grid = -1; return; }
        grid = cus >= 256 ? 256 : cus;
    }
    if (grid < 0) return;
    (void)hipMemsetAsync((char*)d_ws + WS_CTL, 0, CTL_ZERO_BYTES, stream);
    Args a{};
    for (int i = 0; i < 28; ++i) a.in[i] = (const float*)d_in[i];
    a.out = (float*)d_out; a.ws = (unsigned char*)d_ws;
#if defined(MK_SPLIT_AT)
    a.ph_lo = 0; a.ph_hi = MK_SPLIT_AT + 1; a.bar_region = 0; hipLaunchKernelGGL(mk_fwd, dim3(grid), dim3(NTHR), LDS_BYTES, stream, a);
#if !defined(MK_SPLIT_NOREP)
    a.ph_lo = MK_SPLIT_AT; a.ph_hi = MK_SPLIT_AT + 1; a.bar_region = 0; hipLaunchKernelGGL(mk_fwd, dim3(grid), dim3(NTHR), LDS_BYTES, stream, a);
#endif
    if (MK_SPLIT_AT + 1 < 19) { a.ph_lo = MK_SPLIT_AT + 1; a.ph_hi = NPHASE; a.bar_region = 1; hipLaunchKernelGGL(mk_fwd, dim3(grid), dim3(NTHR), LDS_BYTES, stream, a); }
#elif MK_ONE_LAUNCH
    a.ph_lo = 0; a.ph_hi = NPHASE;
    hipLaunchKernelGGL(mk_fwd, dim3(grid), dim3(NTHR), LDS_BYTES, stream, a);
#else
    for (int p = 0; p < 19; ++p) { a.ph_lo = p; a.ph_hi = p + 1; hipLaunchKernelGGL(mk_fwd, dim3(grid), dim3(NTHR), LDS_BYTES, stream, a); }
#endif
}
```

```cpp
#include <hip/hip_runtime.h>
#include <cstdio>
#include <cstdint>
#include <cmath>

#define GAS __attribute__((address_space(1)))
#define LAS __attribute__((address_space(3)))
typedef unsigned short bf16;
typedef unsigned v4u __attribute__((ext_vector_type(4)));
typedef unsigned v2u __attribute__((ext_vector_type(2)));
typedef float f32x4 __attribute__((ext_vector_type(4)));
typedef float f32x2 __attribute__((ext_vector_type(2)));
typedef short bf16x8 __attribute__((ext_vector_type(8)));
#define DI __device__ __forceinline__

#ifndef MK_ONE_LAUNCH
#define MK_ONE_LAUNCH 1
#endif

namespace {
constexpr int DM = 1024, NB = 8, SEQ = 2048, CT = 256;
constexpr int NCTX = NB * CT, NLAT = NB * SEQ, NTOK = NCTX + NLAT;
constexpr int EIN = 2560, OIN = 3088, L1N = 3072;
constexpr int NEXP = 32, HID = 512;
constexpr float EPS = 1e-6f;
constexpr float PI2 = 6.283185307179586f;
constexpr int NTHR = 512, NWAVES = 8;
constexpr int NSLOT = NTOK * 2 + 256;

constexpr size_t al(size_t x) { return (x + 255) & ~(size_t)255; }
constexpr size_t WS_CTL = 0, CTL_BYTES = 1u << 20, CTL_ZERO_BYTES = 98304;
constexpr size_t WS_MODS = WS_CTL + CTL_BYTES;
constexpr size_t WS_TOKE = WS_MODS + al((size_t)2 * 9 * 6144 * 4);
constexpr size_t WS_TOKR = WS_TOKE + al((size_t)NTOK * 2 * 4);
constexpr size_t WS_TOKG = WS_TOKR + al((size_t)NTOK * 2 * 4);
constexpr size_t WS_LIST = WS_TOKG + al((size_t)NTOK * 2 * 4);
constexpr size_t WS_AB = WS_LIST + al((size_t)NEXP * NTOK * 4);
constexpr size_t WS_ROPE = WS_AB + al((size_t)NTOK * 16 * 4);
constexpr size_t WS_TCH = WS_ROPE + al((size_t)2 * SEQ * 64 * 4);
constexpr size_t WS_T256 = WS_TCH + al((size_t)256 * 128 * 2);
constexpr size_t WS_W64 = WS_T256 + al((size_t)256 * 512 * 2);
constexpr size_t WS_W32 = WS_W64 + al((size_t)128 * 64 * 2);
constexpr size_t WS_CHT = WS_W32 + al((size_t)64 * 64 * 2);
constexpr size_t WS_TW = WS_CHT + al((size_t)128 * 256 * 2);
constexpr size_t WS_WIN0 = WS_TW + al((size_t)32 * 64 * 2 * 4);
constexpr size_t WS_WOUT0 = WS_WIN0 + al((size_t)EIN * DM * 2);
constexpr size_t WS_WIN1 = WS_WOUT0 + al((size_t)DM * DM * 2);
constexpr size_t WS_WOUT1 = WS_WIN1 + al((size_t)L1N * DM * 2);
constexpr size_t WS_WM1 = WS_WOUT1 + al((size_t)DM * DM * 2);
constexpr size_t WS_WM2 = WS_WM1 + al((size_t)NEXP * 1024 * DM * 2);
constexpr size_t WS_XC = WS_WM2 + al((size_t)NEXP * DM * HID * 2);
constexpr size_t WS_LAT = WS_XC + al((size_t)NTOK * DM * 2);
constexpr size_t WS_MIX = WS_LAT + al((size_t)NTOK * L1N * 2);
constexpr size_t WS_FOUR = WS_MIX + al((size_t)NSLOT * HID * 2);
constexpr size_t FOUR_TRIG = 0, FOUR_GT = (size_t)SEQ * 4096 * 2, FOUR_GTC = FOUR_GT + (size_t)NB * 512 * 4096 * 2;
constexpr size_t FOUR_BYTES = (size_t)SEQ * 4096 * 2 + (size_t)NB * 512 * 4096 * 2 + (size_t)NB * 512 * 512 * 2;
constexpr size_t WS_DELTA = WS_FOUR + al(FOUR_BYTES);
constexpr int NDT = NB * 4 * 2 * 36;
constexpr size_t WS_DW = WS_DELTA;
constexpr size_t WS_DK = WS_DW + (size_t)NDT * 8192 * 2;
constexpr size_t WS_DQ = WS_DK + (size_t)NDT * 8192 * 2;
constexpr size_t WS_DU = WS_DQ + (size_t)NDT * 8192 * 2;
constexpr size_t WS_DA = WS_DU + (size_t)NDT * 8192 * 2;
constexpr size_t WS_DG = WS_DA + (size_t)NDT * 4096 * 2;
constexpr size_t WS_END = WS_DG + al((size_t)NDT * 4);
constexpr size_t WS_SPREV = WS_DELTA;
static_assert(WS_END <= 560000000ull, "d_ws budget (ws_size >= sum of inputs = 560,692,096 bytes)");
static_assert(FOUR_GTC + (size_t)NB * 512 * 512 * 2 <= FOUR_BYTES && (size_t)2 * NLAT * 512 * 2 <= FOUR_BYTES, "four region");
static_assert((size_t)NSLOT * DM * 2 <= (size_t)NTOK * L1N * 2, "Y overlay");
constexpr int CW_BAR = 4096, CW_CNT = 16384, CW_CTXDONE = 20480, CW_CTXH = 20544, CW_DPF = 21504;
static_assert(CW_CTXH > CW_CTXDONE && CW_CTXH < CW_DPF && (CW_DPF + 32 * 36) * 4 <= 98304 && (CW_CTXDONE + 64) * 4 <= 98304 && (CW_BAR + 3456) * 4 <= 98304 && (CW_CNT + 64) * 4 <= 98304, "control words inside the per-call memset");

constexpr int RING_BYTES = 151552, LDSCTL_OFF = RING_BYTES, LDS_BYTES = 155648;

DI float bf2f(unsigned short u) { return __uint_as_float((unsigned)u << 16); }
DI unsigned f2bf(float f) { unsigned u = __float_as_uint(f); return (u + 0x7fffu + ((u >> 16) & 1u)) >> 16; }
typedef __bf16 bf16x2_t __attribute__((ext_vector_type(2)));
DI unsigned pk2(float lo, float hi) { const f32x2 v = {lo, hi}; return __builtin_bit_cast(unsigned, __builtin_convertvector(v, bf16x2_t)); }
DI float siluf(float v) { return v * __builtin_amdgcn_rcpf(1.f + __expf(-v)); }
DI float geluf(float v) {
    const float av = fabsf(v), t = __builtin_amdgcn_rcpf(av * 0.2316418882f + 1.0f);
    float q = t * 0.5307027145f + (-0.7265760135f); q = q * t + 0.7107068705f; q = q * t + (-0.142248368f); q = q * t + 0.127414796f; q = q * t;
    const float m = v * (q * __builtin_amdgcn_exp2f(v * v * (-0.72134752044f)));
    return v < 0.f ? m : v - m;
}
DI int tid_opq(int wu) {
    int t; asm volatile("v_mbcnt_lo_u32_b32 %0, -1, 0\n\tv_mbcnt_hi_u32_b32 %0, -1, %0\n\tv_lshl_add_u32 %0, %1, 6, %0" : "=&v"(t) : "s"(wu)); return t; }
DI int row_mod(int r) { return r < NCTX ? 8 : (r - NCTX) / SEQ; }
DI float wave_sum(float v) {
#define WS_DPP(ctrl, rmask) v += __builtin_bit_cast(float, __builtin_amdgcn_update_dpp(__builtin_bit_cast(int, v), __builtin_bit_cast(int, v), ctrl, rmask, 0xf, false))
    WS_DPP(0x111, 0xf); WS_DPP(0x112, 0xf); WS_DPP(0x114, 0xf); WS_DPP(0x118, 0xf); WS_DPP(0x142, 0xa); WS_DPP(0x143, 0xc);
#undef WS_DPP
    return __builtin_bit_cast(float, __builtin_amdgcn_readlane(__builtin_bit_cast(int, v), 63));
}
#define VM_WAIT() asm volatile("s_waitcnt vmcnt(0)" ::: "memory")
#define LDS_WAIT() asm volatile("s_waitcnt lgkmcnt(0)" ::: "memory")
#define RLX_AGENT __ATOMIC_RELAXED, __HIP_MEMORY_SCOPE_AGENT

#define XB_TMO      128
#define XB_XCNT(j)  (256  + 64 * (j))
#define XB_XSUB(j)  (1280 + 64 * (j))
#define XB_XGEN(j)  (2304 + 64 * (j))
#define XB_TOP      3328
#define XB_TOPGEN   3392
#define XCD_BAR_WORDS 3456
#define XB_SPIN_CAP (1u << 18)
DI unsigned xb_ld(unsigned* p)              { return __hip_atomic_load(p, __ATOMIC_RELAXED, __HIP_MEMORY_SCOPE_AGENT); }
DI unsigned xb_add(unsigned* p, unsigned v) { return __hip_atomic_fetch_add(p, v, __ATOMIC_RELAXED, __HIP_MEMORY_SCOPE_AGENT); }
DI unsigned xb_xcc_id() { return (unsigned)__builtin_amdgcn_s_getreg((3 << 11) | 20) & 0xFu; }
#define XB_SPIN(cond, bar) do { unsigned _sp = 0; while (cond) { __builtin_amdgcn_s_sleep(1); \
    if ((++_sp & 255u) == 0u) { if (xb_ld(&(bar)[XB_TMO])) break; if (_sp > XB_SPIN_CAP) { atomicAdd(&(bar)[XB_TMO], 1u); break; } } } } while (0)
struct XcdBarrier { unsigned* bar; unsigned x; volatile LAS unsigned* st; };
DI XcdBarrier xcd_barrier_post(unsigned* bar, volatile LAS unsigned* st, int tid0) {
    XcdBarrier b; b.bar = bar; b.x = xb_xcc_id(); b.st = st;
    if (tid0 == 0) (void)xb_add(&bar[XB_XCNT(b.x)], 1u);
    return b;
}
DI void xcd_barrier_complete(unsigned* bar, unsigned x, unsigned& nloc, unsigned& nx) {
    const unsigned G = gridDim.x * gridDim.y * gridDim.z;
    unsigned sum, cnt, mine, sp = 0u;
    for (;;) {
        sum = 0u; cnt = 0u; mine = 0u;
#pragma unroll
        for (unsigned j = 0; j < 16; ++j) { const unsigned c = xb_ld(&bar[XB_XCNT(j)]); sum += c; cnt += (c > 0u) ? 1u : 0u; mine = (j == x) ? c : mine; }
        if (sum == G) break;
        __builtin_amdgcn_s_sleep(1);
        if ((++sp & 255u) == 0u) { if (xb_ld(&bar[XB_TMO])) break; if (sp > XB_SPIN_CAP) { atomicAdd(&bar[XB_TMO], 1u); break; } }
    }
    nloc = mine > 0u ? mine : 1u; nx = cnt > 0u ? cnt : 1u;
}
DI void xcd_barrier(const XcdBarrier& b, int tid0) {
    asm volatile("s_waitcnt vmcnt(0)" ::: "memory");
    __syncthreads();
    if (tid0 == 0) {
        unsigned* bar = b.bar;
        __builtin_amdgcn_s_waitcnt(0);
        unsigned nloc = b.st[0], nx = b.st[1];
        if (nloc == 0u) { xcd_barrier_complete(bar, b.x, nloc, nx); b.st[0] = nloc; b.st[1] = nx; }
        const unsigned old = xb_add(&bar[XB_XSUB(b.x)], 1u);
        const unsigned gen = old / nloc;
        if (old + 1u == (gen + 1u) * nloc) {
            __builtin_amdgcn_fence(__ATOMIC_RELEASE, "agent");
            asm volatile("s_waitcnt vmcnt(0)" ::: "memory");
            const unsigned og = xb_add(&bar[XB_TOP], 1u);
            const unsigned tg = og / nx;
            asm volatile("buffer_inv sc1" ::: "memory");
            if (og + 1u == (tg + 1u) * nx) xb_add(&bar[XB_TOPGEN], 1u);
            else XB_SPIN(xb_ld(&bar[XB_TOPGEN]) == tg, bar);
            xb_add(&bar[XB_XGEN(b.x)], 1u);
            asm volatile("s_waitcnt vmcnt(0)" ::: "memory");
        } else {
            asm volatile("buffer_inv sc1" ::: "memory");
            XB_SPIN(xb_ld(&bar[XB_XGEN(b.x)]) == gen, bar);
            asm volatile("s_waitcnt vmcnt(0)" ::: "memory");
        }
    }
    __syncthreads();
}

namespace pg8 {
constexpr int BM = 256, BK = 64, HALF = 128, HTB = HALF * BK * 2, NXCD = 8, WGM = 8;
DI int lds_byte(int r, int c) { const int st = (r >> 4) * 2 + (c >> 5), rr = r & 15, cc = c & 31, ob = rr * 64 + cc * 2; return st * 1024 + (ob ^ (((ob >> 9) & 1) << 5)); }
DI void stage_rc(int b, int& R, int& C) { const int st = b / 1024, sb = b % 1024, swz = sb ^ (((sb >> 9) & 1) << 5); R = (st >> 1) * 16 + swz / 64; C = (st & 1) * 32 + (swz % 64) / 2; }
DI int perm32(int rho) { const int n = rho >> 4, i = rho & 15; return 8 * (i >> 2) + 4 * n + (i & 3); }

struct UnitG { const char* A; const char* B; const int* gl; int gvalid; int r0, c0, e0, e1; int hm; };
DI unsigned cvt_pk_bf16(float lo, float hi) { return pk2(lo, hi); }

template <class Epi, class Sched, bool GATHER>
DI void gemm_phase(const int wu, LAS unsigned char* lds, const int K_, const int lda, const int ldb, const Sched& S, const Epi& E) {
    int K = K_; asm volatile("" : "+s"(K));
    int tid_ = tid_opq(wu);
    const int tid = tid_, wid = __builtin_amdgcn_readfirstlane(tid >> 6), lane = tid & 63, wr = wid >> 2, wc = wid & 3, fr = lane & 15, fq = lane >> 4;
    const int nt = K / BK;
    unsigned voffA[2][2], voffAn[2][2], voffB[2];
#pragma unroll
    for (int i = 0; i < 2; ++i) { int R, C; stage_rc(tid * 16 + i * 8192, R, C); const int Rb = Epi::PERM ? ((R & ~31) + perm32(R & 31)) : R;
        voffB[i] = (unsigned)(Rb * ldb + C) * 2u;
        voffA[0][i] = (unsigned)(R * lda + C) * 2u; voffA[1][i] = (unsigned)((R + HALF) * lda + C) * 2u; voffAn[0][i] = voffA[0][i]; voffAn[1][i] = voffA[1][i]; }
    const size_t kstep = (size_t)(BK * 2);
    const size_t hstepB = (size_t)HALF * ldb * 2;
    const unsigned ldsw = (unsigned)wid * 1024u;
    const int aoff = lds_byte(wr * 64 + fr, fq * 8), boff = lds_byte(wc * 32 + fr, fq * 8);
#define PG8_SA(b, h) (((b) * 2 + (h)) * HTB)
#define PG8_SB(b, h) ((4 + (b) * 2 + (h)) * HTB)
#define PG8_STAGEB(bufoff, gbase) do { _Pragma("unroll") for (int _i = 0; _i < 2; ++_i) \
        __builtin_amdgcn_global_load_lds((const unsigned*)((const char*)(gbase) + voffB[_i]), (LAS unsigned*)(lds + (bufoff) + ldsw + _i * 8192), 16, 0, 0); } while (0)
#define PG8_STAGEA(bufoff, gbase, v0, v1) do { \
        __builtin_amdgcn_global_load_lds((const unsigned*)((const char*)(gbase) + (v0)), (LAS unsigned*)(lds + (bufoff) + ldsw), 16, 0, 0); \
        __builtin_amdgcn_global_load_lds((const unsigned*)((const char*)(gbase) + (v1)), (LAS unsigned*)(lds + (bufoff) + ldsw + 8192), 16, 0, 0); } while (0)
#define PG8_LDA(dst, b, h) do { _Pragma("unroll") for (int m = 0; m < 4; ++m) _Pragma("unroll") for (int k = 0; k < 2; ++k) dst[m][k] = *(const LAS bf16x8*)(lds + PG8_SA(b, h) + aoff + m * 2048 + k * 1024); } while (0)
#define PG8_LDB(dst, b, h) do { _Pragma("unroll") for (int n = 0; n < 2; ++n) _Pragma("unroll") for (int k = 0; k < 2; ++k) dst[n][k] = *(const LAS bf16x8*)(lds + PG8_SB(b, h) + boff + n * 2048 + k * 1024); } while (0)
#define PG8_MMA(ai, bj, At, Bt) do { __builtin_amdgcn_s_setprio(1); _Pragma("unroll") for (int m = 0; m < 4; ++m) _Pragma("unroll") for (int n = 0; n < 2; ++n) _Pragma("unroll") for (int k = 0; k < 2; ++k) \
        acc[ai][bj][m][n] = __builtin_amdgcn_mfma_f32_16x16x32_bf16(Bt[n][k], At[m][k], acc[ai][bj][m][n], 0, 0, 0); __builtin_amdgcn_s_setprio(0); } while (0)
#define PG8_WAIT_V(n) asm volatile("s_waitcnt vmcnt(" #n ")" ::: "memory")
#define PG8_WAIT_L(n) asm volatile("s_waitcnt lgkmcnt(" #n ")" ::: "memory")
#define PG8_BAR __builtin_amdgcn_s_barrier()
#define PG8_SCHED __builtin_amdgcn_sched_barrier(0)
    UnitG cur, nxt; int ui = 0;
    __syncthreads();
    if (!S.next(0, cur)) return;
    if constexpr (GATHER) {
#pragma unroll
        for (int h = 0; h < 2; ++h)
#pragma unroll
            for (int i = 0; i < 2; ++i) { int R, C; stage_rc(tid * 16 + i * 8192, R, C); int rr = h * HALF + R; rr = rr < cur.gvalid ? rr : cur.gvalid - 1; voffA[h][i] = (unsigned)(cur.gl[rr] * lda + C) * 2u; }
    }
    f32x4 acc[2][2][4][2];
#pragma unroll
    for (int a = 0; a < 2; ++a)
#pragma unroll
        for (int b = 0; b < 2; ++b)
#pragma unroll
            for (int m = 0; m < 4; ++m)
#pragma unroll
                for (int n = 0; n < 2; ++n) acc[a][b][m][n] = (f32x4){0.f, 0.f, 0.f, 0.f};
    bf16x8 At[4][2], B0[2][2], B1[2][2];
    const char* cA = cur.A; const char* cB = cur.B;
    PG8_STAGEB(PG8_SB(0, 0), cB); PG8_STAGEB(PG8_SB(0, 1), cB + hstepB); PG8_STAGEA(PG8_SA(0, 0), cA, voffA[0][0], voffA[0][1]); PG8_STAGEA(PG8_SA(0, 1), cA, voffA[1][0], voffA[1][1]);
    if (wr == 1) PG8_BAR;
    PG8_WAIT_V(2); PG8_BAR;
    PG8_STAGEB(PG8_SB(1, 0), cB + kstep); PG8_STAGEA(PG8_SA(1, 0), cA + kstep, voffA[0][0], voffA[0][1]); PG8_STAGEB(PG8_SB(1, 1), cB + hstepB + kstep);
    PG8_WAIT_V(6); PG8_BAR;
    for (;;) {
        const bool has_next = S.next(ui + 1, nxt);
        const char* nA = has_next ? nxt.A : cA; const char* nB = has_next ? nxt.B : cB;
        if constexpr (GATHER) {
            if (has_next) {
#pragma unroll
                for (int h = 0; h < 2; ++h)
#pragma unroll
                    for (int i = 0; i < 2; ++i) { int R, C; stage_rc(tid * 16 + i * 8192, R, C); int rr = h * HALF + R; rr = rr < nxt.gvalid ? rr : nxt.gvalid - 1; voffAn[h][i] = (unsigned)(nxt.gl[rr] * lda + C) * 2u; }
            } else {
#pragma unroll
                for (int h = 0; h < 2; ++h)
#pragma unroll
                    for (int i = 0; i < 2; ++i) voffAn[h][i] = voffA[h][i];
            }
        }
        const int hmu = __builtin_amdgcn_readfirstlane(cur.hm); const bool hm0 = (hmu & 1) != 0, hm1 = (hmu & 2) != 0;
        for (int t = 0; t < nt; t += 2) {
            const bool last = (t == nt - 2);
            const char* a1 = cA + (size_t)(t + 1) * kstep;
            const char* a2 = last ? nA : cA + (size_t)(t + 2) * kstep; const char* b2 = last ? nB : cB + (size_t)(t + 2) * kstep;
            const char* a3 = a2 + kstep; const char* b3 = b2 + kstep;
            PG8_LDB(B0, 0, 0); PG8_LDB(B1, 0, 1); PG8_SCHED; PG8_LDA(At, 0, 0); PG8_STAGEA(PG8_SA(1, 1), a1, voffA[1][0], voffA[1][1]);
            PG8_WAIT_V(8); PG8_WAIT_L(0); PG8_BAR; if (hm0) { PG8_MMA(0, 0, At, B0); PG8_MMA(0, 1, At, B1); } PG8_BAR; PG8_SCHED;
            if constexpr (GATHER) { if (last) { voffA[0][0] = voffAn[0][0]; voffA[0][1] = voffAn[0][1]; voffA[1][0] = voffAn[1][0]; voffA[1][1] = voffAn[1][1]; } }
            PG8_LDA(At, 0, 1); PG8_STAGEB(PG8_SB(0, 0), b2); PG8_STAGEB(PG8_SB(0, 1), b2 + hstepB); PG8_STAGEA(PG8_SA(0, 0), a2, voffA[0][0], voffA[0][1]);
            PG8_WAIT_V(8); PG8_WAIT_L(0); PG8_BAR; if (hm1) { PG8_MMA(1, 0, At, B0); PG8_MMA(1, 1, At, B1); } PG8_BAR; PG8_SCHED;
            PG8_LDB(B0, 1, 0); PG8_LDB(B1, 1, 1); PG8_SCHED; PG8_LDA(At, 1, 0); PG8_STAGEA(PG8_SA(0, 1), a2, voffA[1][0], voffA[1][1]);
            PG8_WAIT_V(8); PG8_WAIT_L(0); PG8_BAR; if (hm0) { PG8_MMA(0, 0, At, B0); PG8_MMA(0, 1, At, B1); } PG8_BAR; PG8_SCHED;
            PG8_LDA(At, 1, 1); PG8_STAGEB(PG8_SB(1, 0), b3); PG8_STAGEB(PG8_SB(1, 1), b3 + hstepB); PG8_STAGEA(PG8_SA(1, 0), a3, voffA[0][0], voffA[0][1]);
            PG8_WAIT_V(8); PG8_WAIT_L(0); PG8_BAR; if (hm1) { PG8_MMA(1, 0, At, B0); PG8_MMA(1, 1, At, B1); } PG8_BAR; PG8_SCHED;
        }
        if (wr == 0) PG8_BAR;
        E(acc, cur, wr, wc, fr, fq);
        if (!has_next) break;
#pragma unroll
        for (int a = 0; a < 2; ++a)
#pragma unroll
            for (int b = 0; b < 2; ++b)
#pragma unroll
                for (int m = 0; m < 4; ++m)
#pragma unroll
                    for (int n = 0; n < 2; ++n) acc[a][b][m][n] = (f32x4){0.f, 0.f, 0.f, 0.f};
        cur = nxt; cA = nA; cB = nB; ++ui;
        if (wr == 1) PG8_BAR;
    }
    PG8_WAIT_V(0);
    PG8_BAR;
#undef PG8_SA
#undef PG8_SB
#undef PG8_STAGEA
#undef PG8_STAGEB
#undef PG8_LDA
#undef PG8_LDB
#undef PG8_MMA
#undef PG8_WAIT_V
#undef PG8_WAIT_L
#undef PG8_BAR
#undef PG8_SCHED
}

DI void static_order_L(int nM, int nN, int Lidx, int& pm, int& pn) {
    const int nwg = nM * nN;
    int wgid = Lidx; { const int q = nwg / NXCD, r = nwg % NXCD, xcd = wgid % NXCD, off = wgid / NXCD; wgid = (xcd < r ? xcd * (q + 1) : r * (q + 1) + (xcd - r) * q) + off; }
    const int nig = WGM * nN, gid = wgid / nig, fm = gid * WGM, gsz = (nM - fm) < WGM ? (nM - fm) : WGM;
    pm = fm + ((wgid % nig) % gsz); pn = (wgid % nig) / gsz;
}
DI bool split_round(long L, int U, int G, int& unit, int& hm) {
    const int NF = (U / G) * G, Lo = U - NF;
    hm = 3;
    if (L < NF) { unit = (int)L; return true; }
    if (2 * Lo <= G) { const long hu = L - NF; if (hu >= 2 * Lo) return false; unit = NF + (int)(hu >> 1); hm = 1 << (int)(hu & 1); return true; }
    if (L >= U) return false;
    unit = (int)L; return true;
}
struct SchedDense {
    const char* A; const char* Bt; int lda, ldb; int pm0, nM, pn0, nN; int pm0b, nMb, pn0b, nNb; int G, c;
    DI bool next(int i, UnitG& u) const {
        int pm, pn, unit, hm; const int n1 = nM * nN, n2 = nMb * nNb;
        if (!split_round((long)i * G + c, n1 + n2, G, unit, hm)) return false;
        if (unit < n1) { static_order_L(nM, nN, unit, pm, pn); pm += pm0; pn += pn0; }
        else { const int L2 = unit - n1; pm = pm0b + L2 % nMb; pn = pn0b + L2 / nMb; }
        u.A = A + (size_t)pm * BM * lda * 2; u.B = Bt + (size_t)pn * BM * ldb * 2; u.gl = nullptr; u.gvalid = BM; u.r0 = pm * BM; u.c0 = pn * BM; u.e0 = BM; u.e1 = 0; u.hm = hm; return true;
    }
};
struct EpiBf16G {
    static constexpr bool PERM = true;
    bf16* O; int ldc; int coff;
    DI void operator()(const f32x4 (&acc)[2][2][4][2], const UnitG& u, int wr, int wc, int fr, int fq) const {
        const int col0 = u.c0 + coff + wc * 32 + 8 * fq;
        const __amdgpu_buffer_rsrc_t ors = __builtin_amdgcn_make_buffer_rsrc((void*)O, 0, 0x7ffffff0, 0x00020000);
#pragma unroll
        for (int ai = 0; ai < 2; ++ai)
#pragma unroll
            for (int m = 0; m < 4; ++m) { const int lr = ai * HALF + wr * 64 + m * 16 + fr;
                if (lr < u.e0 && ((u.hm >> ai) & 1)) { const unsigned ro = (unsigned)(((size_t)(u.r0 + lr) * ldc + col0) * 2);
#pragma unroll
                    for (int bj = 0; bj < 2; ++bj) { const f32x4 v0 = acc[ai][bj][m][0], v1 = acc[ai][bj][m][1];
                        v4u w; w.x = cvt_pk_bf16(v0[0], v0[1]); w.y = cvt_pk_bf16(v0[2], v0[3]); w.z = cvt_pk_bf16(v1[0], v1[1]); w.w = cvt_pk_bf16(v1[2], v1[3]);
                        __builtin_amdgcn_raw_buffer_store_b128(w, ors, ro + (unsigned)(bj * HALF * 2), 0, 16); } } }
    }
};
struct EpiSwi {
    static constexpr bool PERM = true;
    bf16* O; int ldc;
    DI void operator()(const f32x4 (&acc)[2][2][4][2], const UnitG& u, int wr, int wc, int fr, int fq) const {
        const int col0 = u.c0 + wc * 32 + 8 * fq;
#pragma unroll
        for (int ai = 0; ai < 2; ++ai)
#pragma unroll
            for (int m = 0; m < 4; ++m) { const int lr = ai * HALF + wr * 64 + m * 16 + fr;
                if (lr < u.e0 && ((u.hm >> ai) & 1)) { bf16* rowp = O + (size_t)(u.r0 + lr) * ldc + col0;
                    float o[8];
#pragma unroll
                    for (int n = 0; n < 2; ++n)
#pragma unroll
                        for (int j = 0; j < 4; ++j) { const float g = acc[ai][0][m][n][j], up = acc[ai][1][m][n][j]; o[n * 4 + j] = siluf(g) * up; }
                    v4u w; w.x = cvt_pk_bf16(o[0], o[1]); w.y = cvt_pk_bf16(o[2], o[3]); w.z = cvt_pk_bf16(o[4], o[5]); w.w = cvt_pk_bf16(o[6], o[7]);
                    *(v4u*)rowp = w; } }
    }
};
struct EpiResid {
    static constexpr bool PERM = true;
    bf16* xb; const float* mods; const float* sl; const float* sc_; bool wt;
    DI void operator()(const f32x4 (&acc)[2][2][4][2], const UnitG& u, int wr, int wc, int fr, int fq) const {
        const int col0 = u.c0 + wc * 32 + 8 * fq;
        const __amdgpu_buffer_rsrc_t xrs = __builtin_amdgcn_make_buffer_rsrc((void*)xb, 0, NTOK * DM * 2, 0x00020000);
#pragma unroll
        for (int ai = 0; ai < 2; ++ai) { if (!((u.hm >> ai) & 1)) continue;
#pragma unroll
            for (int m = 0; m < 4; ++m) { const int row = u.r0 + ai * HALF + wr * 64 + m * 16 + fr;
                bf16* xr = xb + (size_t)row * DM + col0;
                const float* g1 = mods + (size_t)row_mod(row) * 6144 + 2 * DM + col0;
#pragma unroll
                for (int bj = 0; bj < 2; ++bj) { const int o = bj * HALF; const f32x4 g0 = *(const f32x4*)(g1 + o), g4 = *(const f32x4*)(g1 + o + 4);
                    f32x4 x0, x1;
                    if (sl) { const float* xs = (row < NCTX ? sc_ + (size_t)row * DM : sl + (size_t)(row - NCTX) * DM) + col0 + o; x0 = __builtin_nontemporal_load((const f32x4*)xs); x1 = __builtin_nontemporal_load((const f32x4*)(xs + 4)); }
                    else { const v4u w = *(const v4u*)(xr + o); x0 = (f32x4){__uint_as_float(w.x << 16), __uint_as_float(w.x & 0xffff0000u), __uint_as_float(w.y << 16), __uint_as_float(w.y & 0xffff0000u)};
                        x1 = (f32x4){__uint_as_float(w.z << 16), __uint_as_float(w.z & 0xffff0000u), __uint_as_float(w.w << 16), __uint_as_float(w.w & 0xffff0000u)}; }
                    x0 = x0 + g0 * acc[ai][bj][m][0]; x1 = x1 + g4 * acc[ai][bj][m][1];
                    v4u w; w.x = cvt_pk_bf16(x0[0], x0[1]); w.y = cvt_pk_bf16(x0[2], x0[3]); w.z = cvt_pk_bf16(x1[0], x1[1]); w.w = cvt_pk_bf16(x1[2], x1[3]);
                    if (wt) __builtin_amdgcn_raw_buffer_store_b128(w, xrs, (unsigned)(((size_t)row * DM + col0 + o) * 2), 0, 16); else *(v4u*)(xr + o) = w; } } }
    }
};
template <int ISCTX> struct EpiChan {
    static constexpr bool PERM = false;
    bf16* GT;
    DI void operator()(const f32x4 (&acc)[2][2][4][2], const UnitG& u, int wr, int wc, int fr, int fq) const {
        constexpr int T = ISCTX ? CT : SEQ, ld = 2 * T;
        const int g = u.e0, j = u.e1;
        bf16* base = ISCTX ? GT + (size_t)j * 512 * ld : GT + (size_t)(j >> 3) * 512 * ld + (j & 7) * 256;
        base += (size_t)(g * 128 + wr * 64 + fr) * ld + wc * 32 + 4 * fq;
#pragma unroll
        for (int ai = 0; ai < 2; ++ai)
#pragma unroll
            for (int m = 0; m < 4; ++m) {
                bf16* rowp = base + (size_t)(m * 16) * ld + ai * T;
#pragma unroll
                for (int bj = 0; bj < 2; ++bj)
#pragma unroll
                    for (int n = 0; n < 2; ++n) { const f32x4 v = acc[ai][bj][m][n]; v2u w; w.x = cvt_pk_bf16(v[0], v[1]); w.y = cvt_pk_bf16(v[2], v[3]); *(v2u*)(rowp + bj * HALF + n * 16) = w; } }
    }
};
}

struct Args { const float* in[28]; float* out; unsigned char* ws; int ph_lo, ph_hi, bar_region, pad; };
enum { I_X = 0, I_C, I_CTX, I_CCTX, I_N1W, I_N2W, I_ADAW, I_ADAB, I_EWIN, I_RDEC, I_RGNW, I_EWOUT, I_OWIN, I_CONVW, I_ALOG, I_DTB, I_DNNW, I_SGUW, I_SGUB, I_OWOUT,
       I_RGW, I_RGB, I_REW, I_REB, I_MWG, I_MWU, I_MWD, I_FNW };

DI void transpose_super(const float* __restrict__ W, int ldw, int k0, int n0, bf16* __restrict__ WT, int ldt, int mode, int dbase, LAS float* scr, int tid) {
    float4 v[8];
#pragma unroll
    for (int i = 0; i < 8; ++i) { const int idx = tid + 512 * i, kk = idx >> 6, n4 = idx & 63; const f32x4 t_ = __builtin_nontemporal_load((const f32x4*)(W + (size_t)(k0 + kk) * ldw + n0 + n4 * 4)); v[i] = make_float4(t_[0], t_[1], t_[2], t_[3]); }
#pragma unroll
    for (int i = 0; i < 8; ++i) { const int idx = tid + 512 * i, kk = idx >> 6, n4 = idx & 63; LAS float* d = scr + (n4 >> 4) * (64 * 65 + 1) + kk * 65 + (n4 & 15) * 4; d[0] = v[i].x; d[1] = v[i].y; d[2] = v[i].z; d[3] = v[i].w; }
    __syncthreads();
#pragma unroll
    for (int s = 0; s < 4; ++s) {
        const int n = tid >> 3, kc = tid & 7; const LAS float* src = scr + s * (64 * 65 + 1) + (kc * 8) * 65 + n;
        v4u o; o.x = pk2(src[0], src[65]); o.y = pk2(src[2 * 65], src[3 * 65]); o.z = pk2(src[4 * 65], src[5 * 65]); o.w = pk2(src[6 * 65], src[7 * 65]);
        const int j = n0 + s * 64 + n;
        const int drow = mode == 0 ? dbase + j : (((j >> 7) << 8) + dbase + (j & 127));
        *(v4u*)(WT + (size_t)drow * ldt + k0 + kc * 8) = o;
    }
    __syncthreads();
}
struct CvtItem { const float* W; bf16* WT; int ldw, k0, n0, ldt, mode, dbase; };
DI CvtItem moe_item(const Args& a, int layer, int item) {
    const int e = item / 96, r = item % 96; CvtItem c;
    bf16* WM1 = (bf16*)(a.ws + WS_WM1) + (size_t)e * 1024 * DM; bf16* WM2 = (bf16*)(a.ws + WS_WM2) + (size_t)e * DM * HID;
    if (r < 32) { c.W = a.in[I_MWG] + ((size_t)layer * NEXP + e) * DM * HID; c.ldw = HID; c.k0 = (r >> 1) * 64; c.n0 = (r & 1) * 256; c.WT = WM1; c.ldt = DM; c.mode = 1; c.dbase = 0; }
    else if (r < 64) { const int q = r - 32; c.W = a.in[I_MWU] + ((size_t)layer * NEXP + e) * DM * HID; c.ldw = HID; c.k0 = (q >> 1) * 64; c.n0 = (q & 1) * 256; c.WT = WM1; c.ldt = DM; c.mode = 1; c.dbase = 128; }
    else { const int q = r - 64; c.W = a.in[I_MWD] + ((size_t)layer * NEXP + e) * HID * DM; c.ldw = DM; c.k0 = (q >> 2) * 64; c.n0 = (q & 3) * 256; c.WT = WM2; c.ldt = HID; c.mode = 0; c.dbase = 0; }
    return c;
}
DI void cvt_load(const CvtItem& c, float4 (&v)[8], int tid) {
#pragma unroll
    for (int i = 0; i < 8; ++i) { const int idx = tid + 512 * i, kk = idx >> 6, n4 = idx & 63; const f32x4 t_ = __builtin_nontemporal_load((const f32x4*)(c.W + (size_t)(c.k0 + kk) * c.ldw + c.n0 + n4 * 4)); v[i] = make_float4(t_[0], t_[1], t_[2], t_[3]); }
}
DI void cvt_store(const CvtItem& c, const float4 (&v)[8], LAS float* scr, int tid) {
#pragma unroll
    for (int i = 0; i < 8; ++i) { const int idx = tid + 512 * i, kk = idx >> 6, n4 = idx & 63; LAS float* d = scr + (n4 >> 4) * (64 * 65 + 1) + kk * 65 + (n4 & 15) * 4; d[0] = v[i].x; d[1] = v[i].y; d[2] = v[i].z; d[3] = v[i].w; }
    __syncthreads();
#pragma unroll
    for (int s4 = 0; s4 < 4; ++s4) {
        const int n = tid >> 3, kc = tid & 7; const LAS float* src = scr + s4 * (64 * 65 + 1) + (kc * 8) * 65 + n;
        v4u o; o.x = pk2(src[0], src[65]); o.y = pk2(src[2 * 65], src[3 * 65]); o.z = pk2(src[4 * 65], src[5 * 65]); o.w = pk2(src[6 * 65], src[7 * 65]);
        const int j = c.n0 + s4 * 64 + n;
        const int drow = c.mode == 0 ? c.dbase + j : (((j >> 7) << 8) + c.dbase + (j & 127));
        __builtin_nontemporal_store(o, (v4u*)(c.WT + (size_t)drow * c.ldt + c.k0 + kc * 8));
    }
}
DI void moe_convert_stream(const Args& a, int layer, int first, int stride, LAS unsigned char* lds, int tid) {
    constexpr int NI = NEXP * 96;
    if (first >= NI) return;
    __syncthreads();
    CvtItem c0 = moe_item(a, layer, first), c1 = c0, c2 = c0; float4 v0[8], v1[8], v2[8];
    cvt_load(c0, v0, tid);
    if (first + stride < NI) { c1 = moe_item(a, layer, first + stride); cvt_load(c1, v1, tid); }
    int par = 0;
    for (int it = first; it < NI; it += stride) {
        const int n2 = it + 2 * stride;
        if (n2 < NI) { c2 = moe_item(a, layer, n2); cvt_load(c2, v2, tid); }
        cvt_store(c0, v0, (LAS float*)(lds + par * 66576), tid); par ^= 1;
        c0 = c1; c1 = c2;
#pragma unroll
        for (int i = 0; i < 8; ++i) { v0[i] = v1[i]; v1[i] = v2[i]; }
    }
    __syncthreads();
}
DI void phase_prep(const int wu, const Args& a, LAS unsigned char* lds) {
    const int tid = tid_opq(wu), bid = blockIdx.x, G = gridDim.x;
    {
        LAS float* s = (LAS float*)lds;
        LAS float* red = s + 9 * 1024;
        bool have = false;
        for (int task = bid; task < 192; task += G) {
            if (!have) { for (int i = tid; i < 9 * 1024; i += NTHR) { const int r = i >> 10, k = i & 1023; const float v = r < 8 ? a.in[I_C][r * 1024 + k] : a.in[I_CCTX][k]; s[i] = v / (1.f + expf(-v)); } have = true; __syncthreads(); }
            const int layer = task / 96, j0 = (task % 96) * 64;
            const int cg = tid & 15, kg = tid >> 4;
            float acc[9][4];
#pragma unroll
            for (int r = 0; r < 9; ++r)
#pragma unroll
                for (int q = 0; q < 4; ++q) acc[r][q] = 0.f;
            const float* W = a.in[I_ADAW] + (size_t)layer * 1024 * 6144 + j0 + cg * 4;
            for (int i0 = 0; i0 < 32; i0 += 8) {
                f32x4 w8[8];
#pragma unroll
                for (int u = 0; u < 8; ++u) w8[u] = __builtin_nontemporal_load((const f32x4*)(W + (size_t)(kg + 32 * (i0 + u)) * 6144));
#pragma unroll
                for (int u = 0; u < 8; ++u) { const int k = kg + 32 * (i0 + u); const f32x4 w = w8[u];
#pragma unroll
                    for (int r = 0; r < 9; ++r) { const float sv = s[r * 1024 + k]; acc[r][0] += sv * w[0]; acc[r][1] += sv * w[1]; acc[r][2] += sv * w[2]; acc[r][3] += sv * w[3]; } } }
#pragma unroll
            for (int r = 0; r < 9; ++r)
#pragma unroll
                for (int q = 0; q < 4; ++q) red[(kg * 9 + r) * 64 + cg * 4 + q] = acc[r][q];
            __syncthreads();
            for (int o = tid; o < 9 * 64; o += NTHR) { const int r = o >> 6, c = o & 63; float t = 0.f; for (int g = 0; g < 32; ++g) t += red[(g * 9 + r) * 64 + c];
                ((float*)(a.ws + WS_MODS))[((size_t)layer * 9 + r) * 6144 + j0 + c] = t + a.in[I_ADAB][layer * 6144 + j0 + c]; }
            __syncthreads();
        }
        __syncthreads();
    }
    {
        LAS float* scr = (LAS float*)lds;
        constexpr int I0 = 16 * 10, I1 = 16 * 4, I2 = 16 * 12, I3 = 16 * 4;
        const bool bal = G == 256; const int it0 = !bal ? bid : (bid < 192 ? bid : 192 + (bid - 192)), its = !bal ? G : (bid < 192 ? 1 << 20 : 64);
        for (int it = it0; it < I0 + I1 + I2 + I3; it += its) {
            int r = it;
            if (r < I0) { transpose_super(a.in[I_EWIN], EIN, (r / 10) * 64, (r % 10) * 256, (bf16*)(a.ws + WS_WIN0), DM, 0, 0, scr, tid); continue; } r -= I0;
            if (r < I1) { transpose_super(a.in[I_EWOUT], DM, (r / 4) * 64, (r % 4) * 256, (bf16*)(a.ws + WS_WOUT0), DM, 0, 0, scr, tid); continue; } r -= I1;
            if (r < I2) { const int ns = r % 12; const int n0 = ns < 8 ? ns * 256 : 2064 + (ns - 8) * 256;
                transpose_super(a.in[I_OWIN], OIN, (r / 12) * 64, n0, (bf16*)(a.ws + WS_WIN1), DM, 0, ns * 256 - n0, scr, tid); continue; } r -= I2;
            transpose_super(a.in[I_OWOUT], DM, (r / 4) * 64, (r % 4) * 256, (bf16*)(a.ws + WS_WOUT1), DM, 0, 0, scr, tid);
        }
    }
    {
        const int gt = bid * NTHR + tid, NT = G * NTHR;
        bf16* W64 = (bf16*)(a.ws + WS_W64);
        for (int it = gt; it < 128 * 64; it += NT) { const int rr = it >> 6, t2 = it & 63, t2p = rr & 63; const float ang = (float)((t2 * t2p) & 63) * (PI2 / 64.f);
            W64[it] = (bf16)f2bf((rr < 64 ? __cosf(ang) : __sinf(ang)) * 0.125f); }
        bf16* W32 = (bf16*)(a.ws + WS_W32);
        for (int it = gt; it < 64 * 64; it += NT) { const int rr = it >> 6, kk = it & 63, pq = rr >> 5, t1p = rr & 31, cs = kk >> 5, t1 = kk & 31; const float ang = (float)((t1 * t1p) & 31) * (PI2 / 32.f);
            const float cv = __cosf(ang), sv = __sinf(ang); W32[it] = (bf16)f2bf((pq == cs ? cv : (pq ? sv : -sv)) * 0.17677669529663687f); }
        bf16* CHT = (bf16*)(a.ws + WS_CHT);
        for (int it = gt; it < 128 * 256; it += NT) { const int cp = it >> 8, kk = it & 255, cc = kk & 127; const float ang = (float)((cp * cc) & 127) * (PI2 / 128.f);
            CHT[it] = (bf16)f2bf((kk < 128 ? __cosf(ang) : -__sinf(ang)) * 0.08838834764831845f); }
        float* TW = (float*)(a.ws + WS_TW);
        for (int it = gt; it < 32 * 64; it += NT) { const int t1 = it >> 6, t2p = it & 63; const float ang = (float)(t1 * t2p) * (PI2 / 2048.f); TW[it * 2] = __cosf(ang); TW[it * 2 + 1] = __sinf(ang); }
        bf16* T256 = (bf16*)(a.ws + WS_T256);
        for (int it = gt; it < 256 * 512; it += NT) { const int tp = it / 512, col = it % 512; const int t = col & 255; const int m = (tp * t) & 255; const float ang = (float)m * (PI2 / 256.f);
            T256[it] = (bf16)f2bf((col < 256 ? __cosf(ang) : -__sinf(ang)) * 0.0625f); }
        bf16* TCH = (bf16*)(a.ws + WS_TCH);
        for (int it = gt; it < 256 * 128; it += NT) { const int rr = it / 128, c = it % 128; const int cp = rr & 127; const int m = (cp * c) & 127; const float ang = (float)m * (PI2 / 128.f);
            TCH[it] = (bf16)f2bf((rr < 128 ? __cosf(ang) : __sinf(ang)) * 0.08838834764831845f); }
        float* RC = (float*)(a.ws + WS_ROPE); float* RS = RC + SEQ * 64;
        for (int it = gt; it < SEQ * 64; it += NT) { const int t = it >> 6, j = it & 63; const int f = j & 31; const float pos = j < 32 ? (float)(t >> 6) : (float)(t & 63);
            const float inv = powf(10000.f, -(float)f / 32.f); float sn, cs; sincosf(pos * inv, &sn, &cs); RC[it] = cs; RS[it] = sn; }
    }
}

DI void moe_offsets_to_lds(const Args& a, int layer, LAS int* moff, int tid) {
    if (tid == 0) { const int* cnt = (const int*)(a.ws + WS_CTL) + CW_CNT + layer * NEXP; int s = 0; for (int e = 0; e < NEXP; ++e) { moff[e] = s; s += cnt[e]; } moff[NEXP] = s; }
    __syncthreads();
}
template <int MODE>
DI void phase_rowB(const int wu, const Args& a, LAS unsigned char* lds, const int nzero = 0) {
    const int tid = tid_opq(wu), lane = tid & 63, wv = tid >> 6, fr = lane & 15, fq = lane >> 4;
    LAS int* moff = (LAS int*)(lds + LDSCTL_OFF + 256);
    LAS float* hs = (LAS float*)lds;
    LAS float* part = hs + 32 * 1026;
    if (MODE != 0) moe_offsets_to_lds(a, MODE - 1, moff, tid);
    bf16* xb = (bf16*)(a.ws + WS_XC);
    const float* modsP = (const float*)(a.ws + WS_MODS) + (MODE == 2 ? 9 * 6144 : 0);
    const float* modsN = (const float*)(a.ws + WS_MODS) + (MODE == 1 ? 9 * 6144 : 0);
    const float* normw = MODE == 2 ? a.in[I_FNW] : a.in[I_N1W] + (MODE == 1 ? DM : 0);
    const int* tok_e = (const int*)(a.ws + WS_TOKE); const int* tok_r = (const int*)(a.ws + WS_TOKR); const float* tok_g = (const float*)(a.ws + WS_TOKG);
    const bf16* Y = (const bf16*)(a.ws + WS_LAT);
    bf16* H = (bf16*)a.out;
    const int row0 = MODE == 2 ? NCTX : 0, ngrp = (NTOK - row0) / 32;
    float Bf[32];
    if (MODE == 1) {
#pragma unroll
        for (int s2 = 0; s2 < 32; ++s2) Bf[s2] = a.in[I_OWIN][(size_t)(128 * wv + 4 * s2 + fq) * OIN + 2048 + fr];
    }
    f32x4 nw4[4];
#pragma unroll
    for (int j = 0; j < 4; ++j) nw4[j] = *(const f32x4*)(normw + j * 256 + lane * 4);
    const int lane0 = lane;
    const bool p9map = MODE == 1 && gridDim.x == 256; const int bx = (int)blockIdx.x;
    const int ng_ = !p9map ? 0 : (bx < 128 ? 3 : (bx < 224 ? 2 : 0));
    for (int gi = 0, grp = bx; p9map ? gi < ng_ : grp < ngrp; ++gi, grp = p9map ? (gi == 1 ? bx + 256 : (bx < 64 ? bx + 512 : (bx < 96 ? 480 + bx - 64 : 224 + bx - 96))) : grp + (int)gridDim.x) {
        int lane = lane0; asm volatile("" : "+v"(lane));
        if (MODE == 1) __syncthreads();
        const int rb0 = row0 + grp * 32 + 4 * wv, mr = row_mod(rb0);
        constexpr int NR = MODE == 2 ? 2 : 4;
#pragma unroll 1
        for (int rh = 0; rh < 4; rh += NR) { const int rb = rb0 + rh;
        f32x4 x[4][4];
        if (MODE == 0) {
#pragma unroll
            for (int rr = 0; rr < NR; ++rr) { const int r = rb + rr; const float* src = r < NCTX ? a.in[I_CTX] + (size_t)r * DM : a.in[I_X] + (size_t)(r - NCTX) * DM;
#pragma unroll
                for (int j = 0; j < 4; ++j) x[rr][j] = __builtin_nontemporal_load((const f32x4*)(src + j * 256 + lane * 4)); }
        } else {
            int s0[4], s1[4]; float g0[4], g1[4];
#pragma unroll
            for (int rr = 0; rr < NR; ++rr) { const int r = rb + rr; s0[rr] = moff[tok_e[r * 2]] + tok_r[r * 2]; s1[rr] = moff[tok_e[r * 2 + 1]] + tok_r[r * 2 + 1]; g0[rr] = tok_g[r * 2]; g1[rr] = tok_g[r * 2 + 1]; }
            constexpr int JW = 4;
#pragma unroll
            for (int jh = 0; jh < 4; jh += JW) {
            if (jh) asm volatile("" ::: "memory");
            v2u y0[4][4], y1[4][4], xw[4][4];
#pragma unroll
            for (int rr = 0; rr < NR; ++rr) { const int r = rb + rr; const bf16* xs = xb + (size_t)r * DM;
#pragma unroll
                for (int j = jh; j < jh + JW; ++j) { xw[rr][j] = MODE == 2 ? __builtin_nontemporal_load((const v2u*)(xs + j * 256 + lane * 4)) : *(const v2u*)(xs + j * 256 + lane * 4); y0[rr][j] = __builtin_nontemporal_load((const v2u*)(Y + (size_t)s0[rr] * DM + j * 256 + lane * 4)); y1[rr][j] = __builtin_nontemporal_load((const v2u*)(Y + (size_t)s1[rr] * DM + j * 256 + lane * 4)); } }
#pragma unroll
            for (int j = jh; j < jh + JW; ++j) { const f32x4 g2 = *(const f32x4*)(modsP + (size_t)mr * 6144 + 5 * DM + j * 256 + lane * 4);
#pragma unroll
                for (int rr = 0; rr < NR; ++rr) { const v2u a0 = y0[rr][j], a1 = y1[rr][j]; f32x4 mo;
                    mo[0] = g0[rr] * __uint_as_float(a0.x << 16) + g1[rr] * __uint_as_float(a1.x << 16); mo[1] = g0[rr] * __uint_as_float(a0.x & 0xffff0000u) + g1[rr] * __uint_as_float(a1.x & 0xffff0000u);
                    mo[2] = g0[rr] * __uint_as_float(a0.y << 16) + g1[rr] * __uint_as_float(a1.y << 16); mo[3] = g0[rr] * __uint_as_float(a0.y & 0xffff0000u) + g1[rr] * __uint_as_float(a1.y & 0xffff0000u);
                    const v2u xv = xw[rr][j]; x[rr][j] = (f32x4){__uint_as_float(xv.x << 16), __uint_as_float(xv.x & 0xffff0000u), __uint_as_float(xv.y << 16), __uint_as_float(xv.y & 0xffff0000u)} + g2 * mo; } }
            }
        }
        f32x4 sh[4], sc[4];
        if (MODE != 2) {
#pragma unroll
            for (int j = 0; j < 4; ++j) { sh[j] = *(const f32x4*)(modsN + (size_t)mr * 6144 + j * 256 + lane * 4); sc[j] = *(const f32x4*)(modsN + (size_t)mr * 6144 + DM + j * 256 + lane * 4); }
        }
#pragma unroll
        for (int rr = 0; rr < NR; ++rr) {
            const int r = rb + rr;
            bf16* xs = xb + (size_t)r * DM;
            float ss = 0.f;
#pragma unroll
            for (int j = 0; j < 4; ++j) ss += (x[rr][j][0] * x[rr][j][0] + x[rr][j][1] * x[rr][j][1]) + (x[rr][j][2] * x[rr][j][2] + x[rr][j][3] * x[rr][j][3]);
            const float rs = rsqrtf(wave_sum(ss) * (1.f / DM) + EPS);
            if (MODE == 2) {
#pragma unroll
                for (int j = 0; j < 4; ++j) { f32x4 ov = x[rr][j] * rs * nw4[j]; if (r - NCTX < nzero) ov = (f32x4){0.f, 0.f, 0.f, 0.f}; __builtin_nontemporal_store(ov, (f32x4*)(a.out + (size_t)(r - NCTX) * DM + j * 256 + lane * 4)); }
            } else {
#pragma unroll
                for (int j = 0; j < 4; ++j) { if (MODE != 0) { v2u xo; xo.x = pk2(x[rr][j][0], x[rr][j][1]); xo.y = pk2(x[rr][j][2], x[rr][j][3]); __builtin_nontemporal_store(xo, (v2u*)(xs + j * 256 + lane * 4)); }
                    const f32x4 hv = x[rr][j] * rs * nw4[j] * (sc[j] + 1.f) + sh[j];
                    v2u o; o.x = pk2(hv[0], hv[1]); o.y = pk2(hv[2], hv[3]);
                    if (MODE == 1 && p9map && grp < NCTX / 32) __hip_atomic_store((unsigned long long*)(H + (size_t)r * DM + j * 256 + lane * 4), (unsigned long long)o.x | ((unsigned long long)o.y << 32), __ATOMIC_RELAXED, __HIP_MEMORY_SCOPE_AGENT);
                    else *(v2u*)(H + (size_t)r * DM + j * 256 + lane * 4) = o;
                    if (MODE == 1) { LAS float* hp = hs + (4 * wv + rr) * 1026 + j * 256 + lane * 4; *(LAS f32x2*)hp = (f32x2){hv[0], hv[1]}; *(LAS f32x2*)(hp + 2) = (f32x2){hv[2], hv[3]}; } }
            }
        }
        }
        if (MODE == 1) {
            __syncthreads();
            f32x4 acc0 = (f32x4){0.f, 0.f, 0.f, 0.f}, acc1 = acc0;
            const LAS float* ap = hs + fr * 1026 + 128 * wv + fq;
#pragma unroll
            for (int s2 = 0; s2 < 32; ++s2) { acc0 = __builtin_amdgcn_mfma_f32_16x16x4f32(ap[4 * s2], Bf[s2], acc0, 0, 0, 0); acc1 = __builtin_amdgcn_mfma_f32_16x16x4f32(ap[16 * 1026 + 4 * s2], Bf[s2], acc1, 0, 0, 0); }
#pragma unroll
            for (int r = 0; r < 4; ++r) { part[(wv * 32 + 4 * fq + r) * 16 + fr] = acc0[r]; part[(wv * 32 + 16 + 4 * fq + r) * 16 + fr] = acc1[r]; }
            __syncthreads();
            { float t = 0.f;
#pragma unroll
                for (int w = 0; w < 8; ++w) t += part[w * 512 + tid];
                ((float*)(a.ws + WS_AB))[(size_t)(row0 + grp * 32) * 16 + tid] = t; }
            if (p9map && grp < NCTX / 32) {
                asm volatile("s_waitcnt vmcnt(0)" ::: "memory"); __syncthreads();
                if (tid == 0) __hip_atomic_fetch_add((unsigned*)(a.ws + WS_CTL) + CW_CTXH, 1u, __ATOMIC_RELAXED, __HIP_MEMORY_SCOPE_AGENT);
            }
        }
    }
}
DI f32x4 mfma_f32(float a, float b, f32x4 c) { return __builtin_amdgcn_mfma_f32_16x16x4f32(a, b, c, 0, 0, 0); }
constexpr int HSP = 1028;
template <int LAYER>
DI void phase_rowA(const int wu, const Args& a, LAS unsigned char* lds) {
    const int tid = tid_opq(wu), lane = tid & 63, wv = tid >> 6, fr = lane & 15, fq = lane >> 4;
    LAS float* hs = (LAS float*)lds;
    LAS float* part = hs + 16 * HSP;
    LAS float* lgs = part + 8 * 16 * 48;
    LAS int* lcnt = (LAS int*)(lds + LDSCTL_OFF + 1024); LAS int* lbase = lcnt + 32;
    const bf16* xb = (const bf16*)(a.ws + WS_XC);
    const float* mods = (const float*)(a.ws + WS_MODS) + LAYER * 9 * 6144;
    const float* normw = a.in[I_N2W] + LAYER * DM;
    const float* wg = a.in[I_RGW] + LAYER * DM * 4; const float* bg = a.in[I_RGB] + LAYER * 4; const float* we = a.in[I_REW] + LAYER * DM * 32; const float* be = a.in[I_REB] + LAYER * 32;
    int* cnt = (int*)(a.ws + WS_CTL) + CW_CNT + LAYER * NEXP;
    int* tok_e = (int*)(a.ws + WS_TOKE); int* tok_r = (int*)(a.ws + WS_TOKR); float* tok_g = (float*)(a.ws + WS_TOKG); int* list = (int*)(a.ws + WS_LIST);
    bf16* H = (bf16*)a.out;
    const int row0 = LAYER == 1 ? NCTX : 0, ngrp = (NTOK - row0) / 16;
    __syncthreads();
    if (tid < 32) lcnt[tid] = 0;
    bf16x8 Bh[4][3], Bl[4][3];
#pragma unroll
    for (int kb = 0; kb < 4; ++kb)
#pragma unroll
        for (int cb = 0; cb < 3; ++cb) { float w8[8];
#pragma unroll
            for (int e = 0; e < 8; ++e) { const int k = 128 * wv + 32 * kb + 8 * fq + e;
                w8[e] = cb == 0 ? (fr < 4 ? wg[(size_t)k * 4 + fr] : we[(size_t)k * 32 + fr - 4]) : (cb == 1 ? we[(size_t)k * 32 + 12 + fr] : (fr < 4 ? we[(size_t)k * 32 + 28 + fr] : 0.f)); }
            v4u ph, pl;
#pragma unroll
            for (int e2 = 0; e2 < 4; ++e2) { const unsigned p = pk2(w8[2 * e2], w8[2 * e2 + 1]); ph[e2] = p; pl[e2] = pk2(w8[2 * e2] - __uint_as_float(p << 16), w8[2 * e2 + 1] - __uint_as_float(p & 0xffff0000u)); }
            Bh[kb][cb] = __builtin_bit_cast(bf16x8, ph); Bl[kb][cb] = __builtin_bit_cast(bf16x8, pl); }
#define RCOL(j) (((j) >> 1) * 512 + lane * 8 + ((j) & 1) * 4)
    f32x4 nw4[4];
#pragma unroll
    for (int j = 0; j < 4; ++j) nw4[j] = *(const f32x4*)(normw + RCOL(j));
    v2u xn[2][4]; f32x4 shn[4], scn[4];
#define ROWA_LOAD(g_) do { const int _r0 = row0 + (g_) * 16 + 2 * wv; const int _mr = row_mod(_r0); \
        _Pragma("unroll") for (int rr = 0; rr < 2; ++rr) { const int _r = _r0 + rr; const bf16* _xs = xb + (size_t)_r * DM; \
            _Pragma("unroll") for (int j2 = 0; j2 < 2; ++j2) { const v4u _t = *(const v4u*)(_xs + j2 * 512 + lane * 8); xn[rr][2 * j2] = (v2u){_t.x, _t.y}; xn[rr][2 * j2 + 1] = (v2u){_t.z, _t.w}; } } \
        _Pragma("unroll") for (int j = 0; j < 4; ++j) { shn[j] = *(const f32x4*)(mods + (size_t)_mr * 6144 + 3 * DM + RCOL(j)); scn[j] = *(const f32x4*)(mods + (size_t)_mr * 6144 + 4 * DM + RCOL(j)); } } while (0)
    const int bid = blockIdx.x, G_ = gridDim.x;
    constexpr int NPASS = LAYER == 0 ? 2 : 1;
#define ROWA_RANGE(pass_) int gfirst, gend, gstride; \
        if (LAYER == 1) { if (G_ == 256) { gfirst = (bid & 7) * 128 + (bid >> 3); gend = (bid & 7) * 128 + 128; gstride = 32; }     \
                          else { gfirst = bid; gend = ngrp; gstride = G_; } } \
        else if ((pass_) == 0) { gfirst = bid >= 32 ? 128 + bid - 32 : ngrp; gend = ngrp; gstride = G_ - 32; } \
        else { gfirst = bid >= 160 ? bid - 160 : (bid < 32 ? 96 + bid : 128); gend = 128; gstride = 128; }
    for (int pass = 0; pass < NPASS; ++pass) {
    ROWA_RANGE(pass)
    if (LAYER == 0 && pass == 1) {
        if (tid == 0) { unsigned* dn = (unsigned*)(a.ws + WS_CTL) + CW_CTXDONE; unsigned sp = 0;
            while (__hip_atomic_load(dn, __ATOMIC_RELAXED, __HIP_MEMORY_SCOPE_AGENT) < 32u && ++sp < (1u << 22)) __builtin_amdgcn_s_sleep(2);
            __builtin_amdgcn_fence(__ATOMIC_ACQUIRE, "agent"); asm volatile("s_waitcnt vmcnt(0)" ::: "memory"); }
        __syncthreads();
    }
    if (gfirst < gend) ROWA_LOAD(gfirst);
    for (int grp = gfirst; grp < gend; grp += gstride) {
        const int r0 = row0 + grp * 16;
        __syncthreads();
#pragma unroll
        for (int rr = 0; rr < 2; ++rr) {
            const int r = r0 + 2 * wv + rr;
            float ss = 0.f; f32x4 xf[4];
#pragma unroll
            for (int j = 0; j < 4; ++j) { const v2u xw = xn[rr][j]; xf[j] = (f32x4){__uint_as_float(xw.x << 16), __uint_as_float(xw.x & 0xffff0000u), __uint_as_float(xw.y << 16), __uint_as_float(xw.y & 0xffff0000u)};
                ss += (xf[j][0] * xf[j][0] + xf[j][1] * xf[j][1]) + (xf[j][2] * xf[j][2] + xf[j][3] * xf[j][3]); }
            const float rs = rsqrtf(wave_sum(ss) * (1.f / DM) + EPS);
#pragma unroll
            for (int j2 = 0; j2 < 2; ++j2) {
                const f32x4 h0 = xf[2 * j2] * rs * nw4[2 * j2] * (scn[2 * j2] + 1.f) + shn[2 * j2], h1 = xf[2 * j2 + 1] * rs * nw4[2 * j2 + 1] * (scn[2 * j2 + 1] + 1.f) + shn[2 * j2 + 1];
                v4u o; o.x = pk2(h0[0], h0[1]); o.y = pk2(h0[2], h0[3]); o.z = pk2(h1[0], h1[1]); o.w = pk2(h1[2], h1[3]); *(v4u*)(H + (size_t)r * DM + j2 * 512 + lane * 8) = o;
                LAS float* hp = hs + (2 * wv + rr) * HSP + j2 * 512 + lane * 8;
                *(LAS f32x4*)hp = h0; *(LAS f32x4*)(hp + 4) = h1; }
        }
        if (grp + gstride < gend) ROWA_LOAD(grp + gstride);
        __syncthreads();
        {
            f32x4 acc[3];
#pragma unroll
            for (int cb = 0; cb < 3; ++cb) acc[cb] = (f32x4){0.f, 0.f, 0.f, 0.f};
            const LAS float* ap = hs + fr * HSP + 128 * wv + 8 * fq;
#pragma unroll
            for (int kb = 0; kb < 4; ++kb) { const f32x4 x0 = *(const LAS f32x4*)(ap + 32 * kb), x1 = *(const LAS f32x4*)(ap + 32 * kb + 4);
                v4u ph, pl;
                ph[0] = pk2(x0[0], x0[1]); ph[1] = pk2(x0[2], x0[3]); ph[2] = pk2(x1[0], x1[1]); ph[3] = pk2(x1[2], x1[3]);
                pl[0] = pk2(x0[0] - __uint_as_float(ph[0] << 16), x0[1] - __uint_as_float(ph[0] & 0xffff0000u)); pl[1] = pk2(x0[2] - __uint_as_float(ph[1] << 16), x0[3] - __uint_as_float(ph[1] & 0xffff0000u));
                pl[2] = pk2(x1[0] - __uint_as_float(ph[2] << 16), x1[1] - __uint_as_float(ph[2] & 0xffff0000u)); pl[3] = pk2(x1[2] - __uint_as_float(ph[3] << 16), x1[3] - __uint_as_float(ph[3] & 0xffff0000u));
                const bf16x8 ah = __builtin_bit_cast(bf16x8, ph), al = __builtin_bit_cast(bf16x8, pl);
#pragma unroll
                for (int cb = 0; cb < 3; ++cb) { acc[cb] = __builtin_amdgcn_mfma_f32_16x16x32_bf16(ah, Bh[kb][cb], acc[cb], 0, 0, 0); acc[cb] = __builtin_amdgcn_mfma_f32_16x16x32_bf16(ah, Bl[kb][cb], acc[cb], 0, 0, 0);
                    acc[cb] = __builtin_amdgcn_mfma_f32_16x16x32_bf16(al, Bh[kb][cb], acc[cb], 0, 0, 0); } }
#pragma unroll
            for (int cb = 0; cb < 3; ++cb)
#pragma unroll
                for (int r = 0; r < 4; ++r) part[(wv * 16 + 4 * fq + r) * 48 + 16 * cb + fr] = acc[cb][r];
        }
        __syncthreads();
        for (int o = tid; o < 16 * 36; o += NTHR) { const int i = o / 36, j = o % 36; float t = j < 4 ? bg[j] : be[j - 4];
#pragma unroll
            for (int w = 0; w < 8; ++w) t += part[(w * 16 + i) * 48 + j];
            lgs[o] = t; }
        __syncthreads();
        if (tid < 16) {
            const int r = r0 + tid; const LAS float* lg = lgs + tid * 36;
            int grpi = 0; float mx = lg[0];
            for (int g = 1; g < 4; ++g) if (lg[g] > mx) { mx = lg[g]; grpi = g; }
            float den = 0.f;
            for (int g = 0; g < 4; ++g) den += __expf(lg[g] - mx);
            const float pg = 1.f / den;
            const LAS float* le = lg + 4 + grpi * 8;
            int i0 = 0; float l0 = le[0];
            for (int i = 1; i < 8; ++i) if (le[i] > l0) { l0 = le[i]; i0 = i; }
            int i1 = 0; float l1 = -INFINITY;
            for (int i = 0; i < 8; ++i) if (i != i0 && le[i] > l1) { l1 = le[i]; i1 = i; }
            const float e1 = __expf(l1 - l0), inv = 1.f / (1.f + e1);
            const int ex0 = grpi * 8 + i0, ex1 = grpi * 8 + i1;
            tok_e[r * 2] = ex0; tok_e[r * 2 + 1] = ex1; tok_g[r * 2] = pg * inv; tok_g[r * 2 + 1] = pg * e1 * inv;
            tok_r[r * 2] = __hip_atomic_fetch_add(lcnt + ex0, 1, __ATOMIC_RELAXED, __HIP_MEMORY_SCOPE_WORKGROUP); tok_r[r * 2 + 1] = __hip_atomic_fetch_add(lcnt + ex1, 1, __ATOMIC_RELAXED, __HIP_MEMORY_SCOPE_WORKGROUP);
        }
    }
    }
    __syncthreads();
    if (tid < 32) { const int n = lcnt[tid]; lbase[tid] = n ? atomicAdd(cnt + tid, n) : 0; }
    __syncthreads();
#undef ROWA_LOAD
    for (int pass = 0; pass < NPASS; ++pass) {
        ROWA_RANGE(pass)
        for (int grp = gfirst; grp < gend; grp += gstride) {
            if (tid < 32) { const int r = row0 + grp * 16 + (tid >> 1), q = tid & 1; const int e = tok_e[r * 2 + q]; const int k = lbase[e] + tok_r[r * 2 + q]; tok_r[r * 2 + q] = k; list[(size_t)e * NTOK + k] = r; }
        }
    }
#undef ROWA_RANGE
#undef RCOL
}

struct SchedMoe {
    const LAS int* tpre; const LAS int* moff; const int* cnt; const char* A; const char* Bt; const int* list; int which; int G, c;
    DI bool next(int i, pg8::UnitG& u) const {
        int unit, hm;
        const int cx = (G & 7) == 0 ? (c & 7) * (G >> 3) + (c >> 3) : c;
        if (!pg8::split_round((long)i * G + cx, tpre[NEXP] * 4, G, unit, hm)) return false;
        const int tile = unit >> 2, pn = unit & 3; u.hm = hm;
        int e = 0;
        for (int q = 1; q < NEXP; ++q) e = tile >= tpre[q] ? q : e;
        const int pm = tile - tpre[e]; const int valid = min(256, cnt[e] - pm * 256);
        u.gvalid = valid; u.e0 = valid; u.e1 = 0; u.r0 = moff[e] + pm * 256;
        if (which == 1) { u.A = A; u.gl = list + (size_t)e * NTOK + pm * 256; u.B = Bt + ((size_t)e * 1024 + pn * 256) * DM * 2; u.c0 = pn * 128; }
        else { u.A = A + (size_t)u.r0 * HID * 2; u.gl = nullptr; u.B = Bt + ((size_t)e * 1024 + pn * 256) * HID * 2; u.c0 = pn * 256; }
        return true;
    }
};
template <int WHICH>
DI void phase_moe_gemm(const int wu, const Args& a, int layer, LAS unsigned char* lds) {
    const int tid = tid_opq(wu);
    LAS int* moff = (LAS int*)(lds + LDSCTL_OFF + 256); LAS int* tpre = moff + 40;
    const int* cnt = (const int*)(a.ws + WS_CTL) + CW_CNT + layer * NEXP;
    if (tid == 0) { int s = 0, t = 0; for (int e = 0; e < NEXP; ++e) { moff[e] = s; tpre[e] = t; s += cnt[e]; t += (cnt[e] + 255) >> 8; } moff[NEXP] = s; tpre[NEXP] = t; }
    __syncthreads();
    SchedMoe S; S.tpre = tpre; S.moff = moff; S.cnt = cnt; S.list = (const int*)(a.ws + WS_LIST); S.which = WHICH; S.G = gridDim.x; S.c = blockIdx.x;
    if (WHICH == 1) { S.A = (const char*)a.out; S.Bt = (const char*)(a.ws + WS_WM1); pg8::EpiSwi E{(bf16*)(a.ws + WS_MIX), HID};
        pg8::gemm_phase<pg8::EpiSwi, SchedMoe, true>(wu, lds, DM, DM, DM, S, E); }
    else { S.A = (const char*)(a.ws + WS_MIX); S.Bt = (const char*)(a.ws + WS_WM2); pg8::EpiBf16G E{(bf16*)(a.ws + WS_LAT), DM, 0};
        pg8::gemm_phase<pg8::EpiBf16G, SchedMoe, false>(wu, lds, HID, HID, HID, S, E); }
}

DI void phase_ret_naive(const int wu, const Args& a, LAS unsigned char* lds) {
    LAS float* Qs = (LAS float*)lds; LAS float* Ks = Qs + 64 * 128; LAS float* Vs = Ks + 64 * 128; LAS float* Ss = Vs + 64 * 128;
    const int tid = tid_opq(wu);
    const bf16* lat = (const bf16*)(a.ws + WS_LAT); bf16* mix = (bf16*)(a.ws + WS_MIX);
    const float* RC = (const float*)(a.ws + WS_ROPE); const float* RS = RC + SEQ * 64;
    for (int task = blockIdx.x; task < 36 * 4 * NB; task += gridDim.x) {
        const int it = task % 36, h = (task / 36) & 3, b = task / 144;
        float lg[2];
#pragma unroll
        for (int d = 0; d < 2; ++d) { const float x = a.in[I_RDEC][d * 4 + h]; lg[d] = -log1pf(expf(-x)) * 1.4426950408889634f; }
        auto srow = [&](int s) { return s < CT ? b * CT + s : NCTX + b * SEQ + (s - CT); };
        auto ldqk = [&](int s, int d, int base) {
            const int row = srow(s); const bf16* p = lat + (size_t)row * EIN + base + h * 128; const int j = d & 63;
            const float x1 = bf2f(p[j]), x2 = bf2f(p[j + 64]);
            if (s < CT) return d < 64 ? x1 : x2;
            const int t = s - CT; const float c = RC[t * 64 + j], sn = RS[t * 64 + j];
            return d < 64 ? x1 * c - x2 * sn : x1 * sn + x2 * c; };
        __syncthreads();
        for (int i = tid; i < 64 * 128; i += NTHR) { const int q = i >> 7, d = i & 127; Qs[i] = ldqk(it * 64 + q, d, 0) * 0.08838834764831845f; }
        float o[16];
#pragma unroll
        for (int i = 0; i < 16; ++i) o[i] = 0.f;
        const int qi = tid >> 3, sub = tid & 7;
        const int si = it * 64 + qi; const int p1i = si < CT ? CT - 1 - si : 2559 - si;
        const int njt = it < 4 ? 4 : 36;
        for (int jt = 0; jt < njt; ++jt) {
            __syncthreads();
            for (int i = tid; i < 64 * 128; i += NTHR) { const int q = i >> 7, d = i & 127; Ks[i] = ldqk(jt * 64 + q, d, 512); Vs[i] = bf2f(lat[(size_t)srow(jt * 64 + q) * EIN + 1024 + h * 128 + d]); }
            __syncthreads();
            for (int kk = 0; kk < 8; ++kk) {
                const int j = sub * 8 + kk; const int sj = jt * 64 + j;
                float dot = 0.f;
                for (int d = 0; d < 128; ++d) dot += Qs[qi * 128 + d] * Ks[j * 128 + d];
                const int p1j = sj < CT ? CT - 1 - sj : 2559 - sj;
                float w = 0.f;
                if (sj <= si) w += exp2f(lg[0] * (float)(si - sj));
                if (p1j <= p1i) w += exp2f(lg[1] * (float)(p1i - p1j));
                Ss[qi * 65 + j] = dot * w;
            }
            __syncthreads();
            for (int j = 0; j < 64; ++j) { const float s = Ss[qi * 65 + j];
#pragma unroll
                for (int dd = 0; dd < 16; ++dd) o[dd] += s * Vs[j * 128 + sub * 16 + dd]; }
        }
        float s = 0.f;
#pragma unroll
        for (int i = 0; i < 16; ++i) s += o[i];
        s += __shfl_xor(s, 1); s += __shfl_xor(s, 2); s += __shfl_xor(s, 4);
        const float mu = s * (1.f / 128.f); float q = 0.f;
#pragma unroll
        for (int i = 0; i < 16; ++i) { o[i] -= mu; q += o[i] * o[i]; }
        q += __shfl_xor(q, 1); q += __shfl_xor(q, 2); q += __shfl_xor(q, 4);
        const float rs = rsqrtf(q * (1.f / 128.f) + EPS);
        const int row = srow(si);
        const bf16* gp = lat + (size_t)row * EIN + 1536 + h * 128 + sub * 16; const float* gw = a.in[I_RGNW] + h * 128 + sub * 16;
        bf16* mp = mix + (size_t)row * DM + h * 128 + sub * 16;
#pragma unroll
        for (int i = 0; i < 16; ++i) mp[i] = (bf16)f2bf(o[i] * rs * gw[i] * siluf(bf2f(gp[i])));
    }
}

constexpr int TRP = 272;
constexpr int P64 = 144;
DI bf16x8 frag_row64(const LAS unsigned char* base, int r0, int k0, int lane) { return *(const LAS bf16x8*)(base + (r0 + (lane & 15)) * P64 + (k0 + 8 * (lane >> 4)) * 2); }
DI f32x4 mfma16(bf16x8 a, bf16x8 b, f32x4 c) { return __builtin_amdgcn_mfma_f32_16x16x32_bf16(a, b, c, 0, 0, 0); }
DI bf16x8 frag_row(const LAS unsigned char* base, int r0, int k0, int lane) { return *(const LAS bf16x8*)(base + (r0 + (lane & 15)) * TRP + (k0 + 8 * (lane >> 4)) * 2); }
DI unsigned tr_lane_off(int lane) { const int g = lane >> 4, q = (lane & 15) >> 2, p = lane & 3; return (unsigned)((8 * g + q) * TRP + 8 * p); }
DI void tr_frag4(unsigned addr, bf16x8 (&f)[4]) {
    v2u l0, h0, l1, h1, l2, h2, l3, h3;
    asm volatile("ds_read_b64_tr_b16 %0, %8\n\tds_read_b64_tr_b16 %1, %8 offset:1088\n\t"
                 "ds_read_b64_tr_b16 %2, %8 offset:8704\n\tds_read_b64_tr_b16 %3, %8 offset:9792\n\t"
                 "ds_read_b64_tr_b16 %4, %8 offset:17408\n\tds_read_b64_tr_b16 %5, %8 offset:18496\n\t"
                 "ds_read_b64_tr_b16 %6, %8 offset:26112\n\tds_read_b64_tr_b16 %7, %8 offset:27200\n\ts_waitcnt lgkmcnt(0)"
                 : "=&v"(l0), "=&v"(h0), "=&v"(l1), "=&v"(h1), "=&v"(l2), "=&v"(h2), "=&v"(l3), "=&v"(h3) : "v"(addr) : "memory");
    f[0] = __builtin_bit_cast(bf16x8, (v4u){l0.x, l0.y, h0.x, h0.y}); f[1] = __builtin_bit_cast(bf16x8, (v4u){l1.x, l1.y, h1.x, h1.y});
    f[2] = __builtin_bit_cast(bf16x8, (v4u){l2.x, l2.y, h2.x, h2.y}); f[3] = __builtin_bit_cast(bf16x8, (v4u){l3.x, l3.y, h3.x, h3.y});
}
DI void unpack8(v4u x, float (&o)[8]) {
#pragma unroll
    for (int e = 0; e < 4; ++e) { o[2 * e] = __uint_as_float(x[e] << 16); o[2 * e + 1] = __uint_as_float(x[e] & 0xffff0000u); }
}
DI v4u pack8(const float (&o)[8]) { v4u w; w.x = pg8::cvt_pk_bf16(o[0], o[1]); w.y = pg8::cvt_pk_bf16(o[2], o[3]); w.z = pg8::cvt_pk_bf16(o[4], o[5]); w.w = pg8::cvt_pk_bf16(o[6], o[7]); return w; }
DI void stage_rope_tile(LAS unsigned char* dst, const bf16* src, const float* RC, const float* RS, int tl0, bool rope, float lgw, int wmode, float scale, int tid) {
#pragma unroll
    for (int i = 0; i < 2; ++i) {
        const int id = tid + NTHR * i, r = id >> 3, j0 = (id & 7) * 8;
        const bf16* kp = src + (size_t)r * EIN + j0;
        float x1[8], x2[8], o1[8], o2[8];
        unpack8(*(const v4u*)kp, x1); unpack8(*(const v4u*)(kp + 64), x2);
        float w = scale;
        if (wmode == 1) w *= __builtin_amdgcn_exp2f(lgw * (float)(127 - r)); else if (wmode == 2) w *= __builtin_amdgcn_exp2f(lgw * (float)r);
        if (rope) {
            const float* cp = RC + (size_t)(tl0 + r) * 64 + j0; const float* sp = RS + (size_t)(tl0 + r) * 64 + j0;
            const f32x4 c0 = *(const f32x4*)cp, c1 = *(const f32x4*)(cp + 4), s0 = *(const f32x4*)sp, s1 = *(const f32x4*)(sp + 4);
#pragma unroll
            for (int e = 0; e < 8; ++e) { const float c = e < 4 ? c0[e & 3] : c1[e & 3], sn = e < 4 ? s0[e & 3] : s1[e & 3]; o1[e] = (x1[e] * c - x2[e] * sn) * w; o2[e] = (x1[e] * sn + x2[e] * c) * w; }
        } else {
#pragma unroll
            for (int e = 0; e < 8; ++e) { o1[e] = x1[e] * w; o2[e] = x2[e] * w; }
        }
        *(LAS v4u*)(dst + r * TRP + j0 * 2) = pack8(o1); *(LAS v4u*)(dst + r * TRP + (64 + j0) * 2) = pack8(o2);
    }
}
DI void stage_copy_tile(LAS unsigned char* dst, const bf16* src, int ld, int tid) {
#pragma unroll
    for (int i = 0; i < 4; ++i) { const int id = tid + NTHR * i, r = id >> 4, pc = id & 15; *(LAS v4u*)(dst + r * TRP + pc * 16) = *(const v4u*)(src + (size_t)r * ld + pc * 8); }
}
DI void tile_load(v4u (&p)[4], const bf16* src, int ld, int tid) {
#pragma unroll
    for (int i = 0; i < 4; ++i) { const int id = tid + NTHR * i, r = id >> 4, pc = id & 15; p[i] = *(const v4u*)(src + (size_t)r * ld + pc * 8); }
}
DI void tile_store(LAS unsigned char* dst, const v4u (&p)[4], int tid) {
#pragma unroll
    for (int i = 0; i < 4; ++i) { const int id = tid + NTHR * i, r = id >> 4, pc = id & 15; *(LAS v4u*)(dst + r * TRP + pc * 16) = p[i]; }
}
DI void phase_ret_state(const int wu, const Args& a, LAS unsigned char* lds) {
    const int tid = tid_opq(wu), lane = tid & 63, wv = tid >> 6;
    LAS unsigned char* Kt = lds; LAS unsigned char* Vt = lds + 128 * TRP;
    const bf16* lat = (const bf16*)(a.ws + WS_LAT); const float* RC = (const float*)(a.ws + WS_ROPE); const float* RS = RC + SEQ * 64;
    bf16* SP = (bf16*)(a.ws + WS_SPREV);
    const unsigned trK = (unsigned)(size_t)Kt + tr_lane_off(lane) + 2u * (16u * wv), trV = (unsigned)(size_t)Vt + tr_lane_off(lane);
    for (int task = blockIdx.x; task < 64; task += gridDim.x) {
        const int b = task >> 3, h = (task >> 1) & 3, dir = task & 1;
        const float lg = -log1pf(expf(-a.in[I_RDEC][dir * 4 + h])) * 1.4426950408889634f, g128 = exp2f(lg * 128.f);
        f32x4 acc[8];
#pragma unroll
        for (int c = 0; c < 8; ++c) acc[c] = (f32x4){0.f, 0.f, 0.f, 0.f};
        v4u kx1[2], kx2[2], vv[4]; f32x4 kc0[2], kc1[2], ks0[2], ks1[2];
#define R1_LOAD(n_) do { const int _c = dir ? ((n_) < 2 ? 1 - (n_) : 19 - (n_)) : (n_); const bool _ctx = _c < 2; const int _row0 = _ctx ? b * CT + _c * 128 : NCTX + b * SEQ + (_c - 2) * 128, _tl0 = _ctx ? 0 : (_c - 2) * 128; \
            _Pragma("unroll") for (int i = 0; i < 2; ++i) { const int id = tid + NTHR * i, r = id >> 3, j0 = (id & 7) * 8; const bf16* kp = lat + (size_t)(_row0 + r) * EIN + 512 + h * 128 + j0; \
                kx1[i] = *(const v4u*)kp; kx2[i] = *(const v4u*)(kp + 64); const float* cp = RC + (size_t)(_tl0 + r) * 64 + j0; const float* sp_ = RS + (size_t)(_tl0 + r) * 64 + j0; \
                kc0[i] = *(const f32x4*)cp; kc1[i] = *(const f32x4*)(cp + 4); ks0[i] = *(const f32x4*)sp_; ks1[i] = *(const f32x4*)(sp_ + 4); } \
            _Pragma("unroll") for (int i = 0; i < 4; ++i) { const int id = tid + NTHR * i, r = id >> 4, pc = id & 15; vv[i] = *(const v4u*)(lat + (size_t)(_row0 + r) * EIN + 1024 + h * 128 + pc * 8); } } while (0)
        R1_LOAD(0);
        for (int n = 0; n < 18; ++n) {
            const int c = dir ? (n < 2 ? 1 - n : 19 - n) : n;
            const bool isctx = c < 2;
            __syncthreads();
#pragma unroll
            for (int i = 0; i < 2; ++i) { const int id = tid + NTHR * i, r = id >> 3, j0 = (id & 7) * 8;
                float x1[8], x2[8], o1[8], o2[8]; unpack8(kx1[i], x1); unpack8(kx2[i], x2);
                const float w = __builtin_amdgcn_exp2f(lg * (float)(dir ? r : 127 - r));
#pragma unroll
                for (int e = 0; e < 8; ++e) { const float cc = isctx ? 1.f : (e < 4 ? kc0[i][e & 3] : kc1[i][e & 3]), sn = isctx ? 0.f : (e < 4 ? ks0[i][e & 3] : ks1[i][e & 3]); o1[e] = (x1[e] * cc - x2[e] * sn) * w; o2[e] = (x1[e] * sn + x2[e] * cc) * w; }
                *(LAS v4u*)(Kt + r * TRP + j0 * 2) = pack8(o1); *(LAS v4u*)(Kt + r * TRP + (64 + j0) * 2) = pack8(o2); }
#pragma unroll
            for (int i = 0; i < 4; ++i) { const int id = tid + NTHR * i, r = id >> 4, pc = id & 15; *(LAS v4u*)(Vt + r * TRP + pc * 16) = vv[i]; }
            if (n < 17) R1_LOAD(n + 1);
            __syncthreads();
            if (n > 0) {
                bf16* sp = SP + ((size_t)(task * 18 + c) * 128) * 128 + 16 * wv + 4 * (lane >> 4);
#pragma unroll
                for (int cc = 0; cc < 8; ++cc) { v2u w; w.x = pg8::cvt_pk_bf16(acc[cc][0], acc[cc][1]); w.y = pg8::cvt_pk_bf16(acc[cc][2], acc[cc][3]); *(v2u*)(sp + (size_t)(16 * cc + (lane & 15)) * 128) = w; }
            }
#pragma unroll
            for (int cc = 0; cc < 8; ++cc) acc[cc] = acc[cc] * g128;
            bf16x8 af[4]; tr_frag4(trK, af);
#pragma unroll
            for (int cc = 0; cc < 8; ++cc) { bf16x8 bf_[4]; tr_frag4(trV + 32u * cc, bf_);
#pragma unroll
                for (int ks = 0; ks < 4; ++ks) acc[cc] = mfma16(af[ks], bf_[ks], acc[cc]); }
        }
#undef R1_LOAD
    }
}
DI void phase_ret_out(const int wu, const Args& a, LAS unsigned char* lds, const int blk0, const int nblk) {
    const int tid = tid_opq(wu), lane = tid & 63, wv = tid >> 6, fr = lane & 15, fq = lane >> 4;
    LAS unsigned char* Qs = lds; LAS unsigned char* KVs = lds + 128 * TRP; LAS unsigned char* Ps = lds + 2 * 128 * TRP; LAS unsigned char* Ss = lds + 3 * 128 * TRP;
    const bf16* lat = (const bf16*)(a.ws + WS_LAT); const float* RC = (const float*)(a.ws + WS_ROPE); const float* RS = RC + SEQ * 64;
    const bf16* SP = (const bf16*)(a.ws + WS_SPREV); bf16* mix = (bf16*)(a.ws + WS_MIX);
    const unsigned trV = (unsigned)(size_t)KVs + tr_lane_off(lane);
    const int mb = (int)blockIdx.x - blk0;
    if (mb < 0) return;
    for (int task = mb; task < 576; task += nblk) {
        const int c = task % 18, h = (task / 18) & 3, b = task / 72;
        const bool isctx = c < 2; const int row0 = isctx ? b * CT + c * 128 : NCTX + b * SEQ + (c - 2) * 128, tl0 = (c - 2) * 128;
        const float lgf = -log1pf(expf(-a.in[I_RDEC][h])) * 1.4426950408889634f, lgb = -log1pf(expf(-a.in[I_RDEC][4 + h])) * 1.4426950408889634f;
        const bool has_f = c != 0, has_b = c != 1;
        __syncthreads();
        v4u pv[4], ps[4];
        tile_load(pv, lat + (size_t)row0 * EIN + 1024 + h * 128, EIN, tid);
        if (has_f) tile_load(ps, SP + ((size_t)(((b * 4 + h) * 2 + 0) * 18 + c) * 128) * 128, 128, tid);
        stage_rope_tile(Qs, lat + (size_t)row0 * EIN + h * 128, RC, RS, tl0, !isctx, 0.f, 0, 0.08838834764831845f, tid);
        stage_rope_tile(KVs, lat + (size_t)row0 * EIN + 512 + h * 128, RC, RS, tl0, !isctx, 0.f, 0, 1.f, tid);
        __syncthreads();
        bf16x8 qf[4];
#pragma unroll
        for (int ks = 0; ks < 4; ++ks) qf[ks] = frag_row(Qs, 16 * wv, 32 * ks, lane);
        const int il = 16 * wv + fr;
#pragma unroll
        for (int kb = 0; kb < 8; ++kb) {
            f32x4 pa = (f32x4){0.f, 0.f, 0.f, 0.f};
#pragma unroll
            for (int ks = 0; ks < 4; ++ks) pa = mfma16(frag_row(KVs, 16 * kb, 32 * ks, lane), qf[ks], pa);
#pragma unroll
            for (int r = 0; r < 4; ++r) { const int d = il - (16 * kb + 4 * fq + r); const float w = d == 0 ? 2.f : __builtin_amdgcn_exp2f((d > 0 ? lgf : -lgb) * (float)d); pa[r] *= w; }
            v2u w; w.x = pg8::cvt_pk_bf16(pa[0], pa[1]); w.y = pg8::cvt_pk_bf16(pa[2], pa[3]);
            *(LAS v2u*)(Ps + il * TRP + (16 * kb + 4 * fq) * 2) = w;
        }
        __syncthreads();
        tile_store(KVs, pv, tid);
        if (has_f) tile_store(Ss, ps, tid);
        if (has_b) tile_load(ps, SP + ((size_t)(((b * 4 + h) * 2 + 1) * 18 + c) * 128) * 128, 128, tid);
        const int il_ = 16 * wv + fr; v2u gt8[8];
#pragma unroll
        for (int cc = 0; cc < 8; ++cc) gt8[cc] = *(const v2u*)(lat + (size_t)(row0 + il_) * EIN + 1536 + h * 128 + 16 * cc + 4 * fq);
        __syncthreads();
        f32x4 ao[8], af_[8], ab[8];
#pragma unroll
        for (int cc = 0; cc < 8; ++cc) { ao[cc] = (f32x4){0.f, 0.f, 0.f, 0.f}; af_[cc] = ao[cc]; ab[cc] = ao[cc]; }
        {
            bf16x8 pf[4];
#pragma unroll
            for (int ks = 0; ks < 4; ++ks) pf[ks] = frag_row(Ps, 16 * wv, 32 * ks, lane);
#pragma unroll
            for (int cc = 0; cc < 8; ++cc) { bf16x8 vf[4]; tr_frag4(trV + 32u * cc, vf);
#pragma unroll
                for (int ks = 0; ks < 4; ++ks) ao[cc] = mfma16(vf[ks], pf[ks], ao[cc]); }
        }
        if (has_f) {
#pragma unroll
            for (int cc = 0; cc < 8; ++cc)
#pragma unroll
                for (int ks = 0; ks < 4; ++ks) af_[cc] = mfma16(frag_row(Ss, 16 * cc, 32 * ks, lane), qf[ks], af_[cc]);
        }
        __syncthreads();
        if (has_b) tile_store(Ss, ps, tid);
        __syncthreads();
        if (has_b) {
#pragma unroll
            for (int cc = 0; cc < 8; ++cc)
#pragma unroll
                for (int ks = 0; ks < 4; ++ks) ab[cc] = mfma16(frag_row(Ss, 16 * cc, 32 * ks, lane), qf[ks], ab[cc]);
        }
        const float rf = __builtin_amdgcn_exp2f(lgf * (float)(il + 1)), rb = __builtin_amdgcn_exp2f(lgb * (float)(128 - il));
        float sum = 0.f;
#pragma unroll
        for (int cc = 0; cc < 8; ++cc) { ao[cc] = ao[cc] + af_[cc] * rf + ab[cc] * rb; sum += (ao[cc][0] + ao[cc][1]) + (ao[cc][2] + ao[cc][3]); }
        sum += __shfl_xor(sum, 16); sum += __shfl_xor(sum, 32);
        const float mu = sum * (1.f / 128.f); float qq = 0.f;
#pragma unroll
        for (int cc = 0; cc < 8; ++cc) { ao[cc] = ao[cc] - mu; qq += (ao[cc][0] * ao[cc][0] + ao[cc][1] * ao[cc][1]) + (ao[cc][2] * ao[cc][2] + ao[cc][3] * ao[cc][3]); }
        qq += __shfl_xor(qq, 16); qq += __shfl_xor(qq, 32);
        const float rs = rsqrtf(qq * (1.f / 128.f) + EPS);
        const size_t row = (size_t)(row0 + il);
#pragma unroll
        for (int cc = 0; cc < 8; ++cc) { const int col = h * 128 + 16 * cc + 4 * fq;
            const v2u gt = gt8[cc]; const f32x4 gw = *(const f32x4*)(a.in[I_RGNW] + col);
            const float g0 = __uint_as_float(gt.x << 16), g1 = __uint_as_float(gt.x & 0xffff0000u), g2 = __uint_as_float(gt.y << 16), g3 = __uint_as_float(gt.y & 0xffff0000u);
            v2u o; o.x = pg8::cvt_pk_bf16(ao[cc][0] * rs * gw[0] * siluf(g0), ao[cc][1] * rs * gw[1] * siluf(g1)); o.y = pg8::cvt_pk_bf16(ao[cc][2] * rs * gw[2] * siluf(g2), ao[cc][3] * rs * gw[3] * siluf(g3));
            *(v2u*)(mix + row * DM + col) = o; }
    }
}


DI void tr_frag2(unsigned addr, bf16x8 (&f)[2]) {
    v2u l0, h0, l1, h1;
    asm volatile("ds_read_b64_tr_b16 %0, %4\n\tds_read_b64_tr_b16 %1, %4 offset:1088\n\tds_read_b64_tr_b16 %2, %4 offset:8704\n\tds_read_b64_tr_b16 %3, %4 offset:9792\n\ts_waitcnt lgkmcnt(0)"
                 : "=&v"(l0), "=&v"(h0), "=&v"(l1), "=&v"(h1) : "v"(addr) : "memory");
    f[0] = __builtin_bit_cast(bf16x8, (v4u){l0.x, l0.y, h0.x, h0.y}); f[1] = __builtin_bit_cast(bf16x8, (v4u){l1.x, l1.y, h1.x, h1.y});
}
constexpr int P256 = 528;
DI void phase_fft_a(const int wu, const Args& a, LAS unsigned char* lds, const int blk0, const int nblk) {
    const int tid = tid_opq(wu), lane = tid & 63, wv = tid >> 6, fr = lane & 15, fq = lane >> 4;
    const int mb_ = (int)blockIdx.x - blk0;
    if (mb_ < 0) return;
    LAS unsigned char* Wl = lds; LAS unsigned char* Ft = lds + 128 * P64;
    const bf16* lat = (const bf16*)(a.ws + WS_LAT); bf16* YB = (bf16*)(a.ws + WS_FOUR + FOUR_GT); const float* TW = (const float*)(a.ws + WS_TW);
    __syncthreads();
#pragma unroll
    for (int k = 0; k < 2; ++k) { const int id = tid + NTHR * k, r = id >> 3, pc = id & 7; *(LAS v4u*)(Wl + r * P64 + pc * 16) = *(const v4u*)((const bf16*)(a.ws + WS_W64) + r * 64 + pc * 8); }
    const unsigned trF = (unsigned)(size_t)Ft + tr_lane_off(lane);
    const int mb = wv & 3, ch0 = (wv >> 2) * 4;
    for (int task = mb_; task < NB * 32 * 4; task += nblk) {
        const int g = task & 3, t1 = (task >> 2) & 31, b = task >> 7;
        __syncthreads();
#pragma unroll
        for (int k = 0; k < 2; ++k) { const int id = tid + NTHR * k, r = id >> 4, pc = id & 15;
            *(LAS v4u*)(Ft + r * TRP + pc * 16) = *(const v4u*)(lat + (size_t)(NCTX + b * SEQ + t1 + 32 * r) * EIN + 2048 + g * 128 + pc * 8); }
        __syncthreads();
        bf16x8 wf[2][2];
#pragma unroll
        for (int cs = 0; cs < 2; ++cs)
#pragma unroll
            for (int ks = 0; ks < 2; ++ks) wf[cs][ks] = frag_row64(Wl, cs * 64 + 16 * mb, 32 * ks, lane);
        const int t2p = 16 * mb + fr; const f32x2 tw = *(const f32x2*)(TW + (size_t)(t1 * 64 + t2p) * 2);
        bf16* yb = YB + (((size_t)(b * 64 + t2p) * 32 + t1) * 2) * 512 + g * 128 + 4 * fq;
#pragma unroll
        for (int q = 0; q < 4; ++q) { const int cb = ch0 + q;
            bf16x8 ff[2]; tr_frag2(trF + 32u * cb, ff);
            f32x4 ac = (f32x4){0.f, 0.f, 0.f, 0.f}, as_ = ac;
            ac = mfma16(ff[0], wf[0][0], ac); ac = mfma16(ff[1], wf[0][1], ac);
            as_ = mfma16(ff[0], wf[1][0], as_); as_ = mfma16(ff[1], wf[1][1], as_);
            const f32x4 yc = ac * tw[0] - as_ * tw[1], ys = as_ * tw[0] + ac * tw[1];
            v2u w0, w1; w0.x = pk2(yc[0], yc[1]); w0.y = pk2(yc[2], yc[3]); w1.x = pk2(ys[0], ys[1]); w1.y = pk2(ys[2], ys[3]);
            *(v2u*)(yb + 16 * cb) = w0; *(v2u*)(yb + 512 + 16 * cb) = w1; }
    }
}
DI void phase_fft_b(const int wu, const Args& a, LAS unsigned char* lds, const int t_first, const int t_stride, const int t_end) {
    const int tid = tid_opq(wu), lane = tid & 63, wv = tid >> 6, fr = lane & 15, fq = lane >> 4;
    LAS unsigned char* CHl = lds; LAS unsigned char* W32l = lds + 128 * P256; LAS unsigned char* Yt = W32l + 64 * P64; LAS unsigned char* PQl = Yt + 64 * TRP;
    const bf16* YB = (const bf16*)(a.ws + WS_FOUR + FOUR_GT); bf16* mix = (bf16*)(a.ws + WS_MIX);
    __syncthreads();
#pragma unroll
    for (int k = 0; k < 8; ++k) { const int id = tid + NTHR * k, r = id >> 5, pc = id & 31; *(LAS v4u*)(CHl + r * P256 + pc * 16) = *(const v4u*)((const bf16*)(a.ws + WS_CHT) + r * 256 + pc * 8); }
    { const int r = tid >> 3, pc = tid & 7; *(LAS v4u*)(W32l + r * P64 + pc * 16) = *(const v4u*)((const bf16*)(a.ws + WS_W32) + r * 64 + pc * 8); }
    const unsigned trY = (unsigned)(size_t)Yt + tr_lane_off(lane);
    v4u ya[2];
#define FB_LOAD(task_) do { const int _g = (task_) & 3, _t2p = ((task_) >> 2) & 63, _b = (task_) >> 8; \
        _Pragma("unroll") for (int k = 0; k < 2; ++k) { const int id = tid + NTHR * k, m = id >> 4, pc = id & 15; ya[k] = *(const v4u*)(YB + ((size_t)(_b * 64 + _t2p) * 64 + m) * 512 + _g * 128 + pc * 8); } } while (0)
    if (t_first < t_end) FB_LOAD(t_first);
    for (int task = t_first; task < t_end; task += t_stride) {
        const int g = task & 3, t2p = (task >> 2) & 63, b = task >> 8;
        __syncthreads();
#pragma unroll
        for (int k = 0; k < 2; ++k) { const int id = tid + NTHR * k, m = id >> 4, pc = id & 15; *(LAS v4u*)(Yt + ((m & 1) * 32 + (m >> 1)) * TRP + pc * 16) = ya[k]; }
        { const int nt_ = task + t_stride; if (nt_ < t_end) FB_LOAD(nt_); }
        __syncthreads();
        {
            const int rb = wv & 3, ch0 = (wv >> 2) * 4;
            bf16x8 wf[2];
#pragma unroll
            for (int ks = 0; ks < 2; ++ks) wf[ks] = frag_row64(W32l, 16 * rb, 32 * ks, lane);
            const int ri = 16 * rb + fr, pq = ri >> 5, t1p = ri & 31;
#pragma unroll
            for (int q = 0; q < 4; ++q) { const int cb = ch0 + q;
                bf16x8 yf[2]; tr_frag2(trY + 32u * cb, yf);
                f32x4 acc = (f32x4){0.f, 0.f, 0.f, 0.f};
                acc = mfma16(yf[0], wf[0], acc); acc = mfma16(yf[1], wf[1], acc);
                v2u w; w.x = pk2(acc[0], acc[1]); w.y = pk2(acc[2], acc[3]);
                *(LAS v2u*)(PQl + t1p * P256 + (pq * 128 + 16 * cb + 4 * fq) * 2) = w; }
        }
        __syncthreads();
        {
            f32x4 z0 = (f32x4){0.f, 0.f, 0.f, 0.f}, z1 = z0;
#pragma unroll
            for (int ks = 0; ks < 8; ++ks) {
                const bf16x8 cf = *(const LAS bf16x8*)(CHl + (16 * wv + fr) * P256 + (32 * ks + 8 * fq) * 2);
                const bf16x8 p0 = *(const LAS bf16x8*)(PQl + fr * P256 + (32 * ks + 8 * fq) * 2), p1 = *(const LAS bf16x8*)(PQl + (16 + fr) * P256 + (32 * ks + 8 * fq) * 2);
                z0 = mfma16(cf, p0, z0); z1 = mfma16(cf, p1, z1); }
            const size_t rowb = (size_t)(NCTX + b * SEQ + t2p); const int col = 512 + g * 128 + 16 * wv + 4 * fq;
            v2u w0, w1; w0.x = pk2(z0[0], z0[1]); w0.y = pk2(z0[2], z0[3]); w1.x = pk2(z1[0], z1[1]); w1.y = pk2(z1[2], z1[3]);
            *(v2u*)(mix + (rowb + 64 * fr) * DM + col) = w0; *(v2u*)(mix + (rowb + 64 * (16 + fr)) * DM + col) = w1;
        }
    }
#undef FB_LOAD
}

struct SchedChan {
    const char* A; const char* lat; int isctx; int G, c;
    DI bool next(int i, pg8::UnitG& u) const { const long L = (long)i * G + c; if (L >= (isctx ? 32 : 256)) return false; const int g = (int)(L & 3), j = (int)(L >> 2);
        const int row0 = isctx ? j * 256 : NCTX + j * 256;
        u.A = A; u.B = lat + ((size_t)row0 * EIN + 2048 + g * 128) * 2; u.gl = nullptr; u.gvalid = 256; u.r0 = 0; u.c0 = 0; u.e0 = g; u.e1 = j; u.hm = 3; return true; }
};
struct SchedTok {
    const char* A; const char* GT; int isctx; int G, c;
    DI bool next(int i, pg8::UnitG& u) const { const long L = (long)i * G + c; u.gl = nullptr; u.gvalid = 256; u.e0 = 256; u.e1 = 0; u.hm = 3;
        if (!isctx) { if (L >= 128) return false; const int pn = (int)(L & 1), pm = (int)(L >> 1) & 7, b = (int)(L >> 4);
            u.A = A + (size_t)pm * 256 * 4096 * 2; u.B = GT + ((size_t)b * 512 + pn * 256) * 4096 * 2; u.r0 = NCTX + b * SEQ + pm * 256; u.c0 = 512 + pn * 256; return true; }
        if (L >= 16) return false; const int pn = (int)(L & 1), b = (int)(L >> 1);
        u.A = A; u.B = GT + ((size_t)b * 512 + pn * 256) * 512 * 2; u.r0 = b * CT; u.c0 = 512 + pn * 256; return true; }
};

DI bf16x8 read2(const LAS unsigned char* p) {
    const v2u lo = *(const LAS v2u*)p, hi = *(const LAS v2u*)(p + 32); return __builtin_bit_cast(bf16x8, (v4u){lo.x, lo.y, hi.x, hi.y}); }
DI bf16x8 pack_tiles(const f32x4& t0, const f32x4& t1) {
    v4u w; w.x = pk2(t0[0], t0[1]); w.y = pk2(t0[2], t0[3]); w.z = pk2(t1[0], t1[1]); w.w = pk2(t1[2], t1[3]); return __builtin_bit_cast(bf16x8, w); }
DI bf16x8 frag_rm(const LAS unsigned char* base, int r0, int k0, int lane, int d) { const int r = r0 + (lane & 15); return *(const LAS bf16x8*)(base + (d ? 63 - r : r) * TRP + (k0 + 8 * (lane >> 4)) * 2); }
constexpr int NDP = NB * 4 * 36;
constexpr int NDP1 = 768;
DI void dp_map(int task, int& bh, int& c) { const int k = task >> 5; bh = task & 31; const int j = (k - 4) >> 1; c = k < 4 ? ((k & 1) ? 3 - (k >> 1) : (k >> 1)) : (((k - 4) & 1) ? 35 - j : 4 + j); }
template <bool WT>
DI void phase_dn_prep(const int wu, const Args& a, LAS unsigned char* lds, const int t_first, const int t_stride, const int t_end) {
    const __amdgpu_buffer_rsrc_t drs = __builtin_amdgcn_make_buffer_rsrc((void*)(a.ws + WS_DELTA), 0, (int)(WS_END - WS_DELTA), 0x00020000);
    const char* dbase = (const char*)(a.ws + WS_DELTA);
#define DP_ST16(p_, v_) do { if (WT) __builtin_amdgcn_raw_buffer_store_b128((v_), drs, (unsigned)((const char*)(p_) - dbase), 0, 16); else *(v4u*)(p_) = (v_); } while (0)
#define DP_ST8(p_, v_)  do { if (WT) __builtin_amdgcn_raw_buffer_store_b64((v_), drs, (unsigned)((const char*)(p_) - dbase), 0, 16); else *(v2u*)(p_) = (v_); } while (0)
#define DP_ST4(p_, v_)  do { if (WT) __builtin_amdgcn_raw_buffer_store_b32(__float_as_uint(v_), drs, (unsigned)((const char*)(p_) - dbase), 0, 16); else *(float*)(p_) = (v_); } while (0)
    const int tid = tid_opq(wu);
    LAS unsigned char* Qs = lds; LAS unsigned char* Ks = lds + 64 * TRP; LAS unsigned char* Vs = lds + 2 * 64 * TRP;
    LAS unsigned char* XT = lds + 3 * 64 * TRP;
    LAS float* SSQ = (LAS float*)XT;
    constexpr int PD0 = 3 * 64 * TRP + 256 * P64, PDSZ = 20736;
#define DP_LD(d)  ((LAS float*)(lds + PD0 + (d) * PDSZ))
#define DP_LB(d)  (lds + PD0 + (d) * PDSZ + 4352)
#define DP_TM(d)  (lds + PD0 + (d) * PDSZ + 13568)
#define DP_AR(d, k) ((LAS float*)(lds + PD0 + (d) * PDSZ + 18688) + (k) * 64)
    const bf16* lat = (const bf16*)(a.ws + WS_LAT); const float* cw = a.in[I_CONVW]; const float* AB = (const float*)(a.ws + WS_AB);
    bf16* DW = (bf16*)(a.ws + WS_DW); bf16* DKt = (bf16*)(a.ws + WS_DK); bf16* DQ = (bf16*)(a.ws + WS_DQ); bf16* DU = (bf16*)(a.ws + WS_DU); bf16* DA = (bf16*)(a.ws + WS_DA); float* DG = (float*)(a.ws + WS_DG);
    v4u pa0[3], pam[3], paq[3], pb0[3], pbm[3], pbq[3];
#define DP_LOAD(task_, lo_, P0, PM, PQ) do { int _c, _bh; dp_map((task_), _bh, _c); const int _b = _bh >> 2, _h = _bh & 3; const bool _ctx = _c < 4; \
        const int _T = _ctx ? CT : SEQ, _tb = _ctx ? _c * 64 : (_c - 4) * 64, _rowb = _ctx ? _b * CT : NCTX + _b * SEQ; int _tid = tid; asm volatile("" : "+v"(_tid)); \
        _Pragma("unroll") for (int it = 0; it < 3; ++it) { const int id = _tid + NTHR * (it + (lo_)), i = id / 48, gch = id % 48, part = gch >> 4, d0 = (gch & 15) * 8; \
            const int t = _tb + i, col = part * 512 + _h * 128 + d0; const bf16* xp = lat + (size_t)(_rowb + t) * L1N + col; \
            P0[it] = *(const v4u*)xp; PM[it] = *(const v4u*)(xp - (t > 0 ? L1N : 0)); PQ[it] = *(const v4u*)(xp + (t < _T - 1 ? L1N : 0)); } } while (0)
#define DP_CONV(lo_, P0, PM, PQ) do { int _tid = tid; asm volatile("" : "+v"(_tid)); \
        _Pragma("unroll") for (int it = 0; it < 3; ++it) { const int id = _tid + NTHR * (it + (lo_)), i = id / 48, gch = id % 48, part = gch >> 4, d0 = (gch & 15) * 8; \
            const int t = tb + i, col = part * 512 + h * 128 + d0; \
            float x0[8], xm[8], xq[8], y[8]; unpack8(P0[it], x0); unpack8(PM[it], xm); unpack8(PQ[it], xq); \
            if (t == 0) { _Pragma("unroll") for (int e = 0; e < 8; ++e) xm[e] = 0.f; } \
            if (t == T - 1) { _Pragma("unroll") for (int e = 0; e < 8; ++e) xq[e] = 0.f; } \
            const f32x4 w0a = *(const f32x4*)(cw + col), w0b = *(const f32x4*)(cw + col + 4), w1a = *(const f32x4*)(cw + 1536 + col), w1b = *(const f32x4*)(cw + 1536 + col + 4), w2a = *(const f32x4*)(cw + 3072 + col), w2b = *(const f32x4*)(cw + 3072 + col + 4); \
            float ssq = 0.f; \
            _Pragma("unroll") for (int e = 0; e < 8; ++e) { const float w0 = e < 4 ? w0a[e & 3] : w0b[e & 3], w1 = e < 4 ? w1a[e & 3] : w1b[e & 3], w2 = e < 4 ? w2a[e & 3] : w2b[e & 3]; y[e] = siluf(w0 * xm[e] + w1 * x0[e] + w2 * xq[e]); ssq += y[e] * y[e]; } \
            *(LAS v4u*)(lds + part * (64 * TRP) + i * TRP + d0 * 2) = pack8(y); \
            if (part < 2) SSQ[(part * 64 + i) * 16 + (gch & 15)] = ssq; } } while (0)
    if (t_first < t_end) DP_LOAD(t_first, 0, pa0, pam, paq);
    const int tid0 = tid;
    for (int task = t_first; task < t_end; task += t_stride) {
        int tid = tid0; asm volatile("" : "+v"(tid));
        const int lane = tid & 63, wv = __builtin_amdgcn_readfirstlane(tid >> 6), fr = lane & 15, fq = lane >> 4;
        int c, bh; dp_map(task, bh, c); const int b = bh >> 2, h = bh & 3;
        const bool isctx = c < 4; const int T = isctx ? CT : SEQ, tb = isctx ? c * 64 : (c - 4) * 64, rowb = isctx ? b * CT : NCTX + b * SEQ;
        DP_LOAD(task, 3, pb0, pbm, pbq);
        float g_av = 0.f, g_bt = 0.f, g_dtb = 0.f, g_al = 0.f;
        if (wv < 2) { const int d = wv, t = tb + (d ? 63 - lane : lane); const size_t row = (size_t)(rowb + t); g_av = AB[row * 16 + d * 4 + h]; g_bt = AB[row * 16 + 8 + d * 4 + h]; g_dtb = a.in[I_DTB][d * 4 + h]; g_al = a.in[I_ALOG][d * 4 + h]; }
        __syncthreads();
        DP_CONV(0, pa0, pam, paq);
        asm volatile("" ::: "memory");
        DP_CONV(3, pb0, pbm, pbq);
        { const int nt_ = task + t_stride; if (nt_ < t_end) DP_LOAD(nt_, 0, pa0, pam, paq); }
        if (wv < 2) {
            const int d = wv; const float av = g_av, bt = g_bt;
            const float z = av + g_dtb; const float sp = z > 20.f ? z : log1pf(expf(z));
            float g = -expf(g_al) * sp;
#pragma unroll
            for (int o = 1; o < 64; o <<= 1) { const float v = __shfl_up(g, o); if (lane >= o) g += v; }
            const float gl = __shfl(g, 63);
            DP_AR(d, 0)[lane] = g; DP_AR(d, 1)[lane] = 1.f / (1.f + expf(-bt)); DP_AR(d, 2)[lane] = expf(gl - g);
            if (lane == 63) DP_ST4(DG + (bh * 2 + d) * 36 + c, expf(g));
        }
        __syncthreads();
        if (tid < 128) { const int d = tid >> 6, i = tid & 63, r = d ? 63 - i : i; const LAS float* pq_ = SSQ + r * 16; const LAS float* pk_ = SSQ + (64 + r) * 16; float tq = 0.f, tk = 0.f;
#pragma unroll
            for (int e = 0; e < 16; ++e) { tq += pq_[e]; tk += pk_[e]; }
            const float rq = rsqrtf(tq + EPS) * 0.08838834764831845f, rk = rsqrtf(tk + EPS), eg = __expf(DP_AR(d, 0)[i]);
            DP_AR(d, 3)[i] = DP_AR(d, 1)[i] * eg * rk; DP_AR(d, 4)[i] = eg * rq; DP_AR(d, 5)[i] = DP_AR(d, 2)[i] * rk; DP_AR(d, 6)[i] = rk; DP_AR(d, 7)[i] = rq; }
        __syncthreads();
        for (int i = tid; i < 256 * P64 / 16; i += NTHR) *(LAS v4u*)(XT + i * 16) = (v4u){0u, 0u, 0u, 0u};
#pragma unroll 2
        for (int q8 = 0; q8 < 8; ++q8) {
            const int id = wv * 8 + q8, d = id >> 5, doL = ((id >> 4) & 1) == 0, tI = id & 15, ib = tI >> 2, jb = tI & 3;
            if (doL || !isctx) {
                f32x4 acc = (f32x4){0.f, 0.f, 0.f, 0.f};
                if (jb <= ib) {
#pragma unroll
                    for (int ks = 0; ks < 4; ++ks) acc = mfma16(frag_rm(Ks, 16 * jb, 32 * ks, lane, d), frag_rm(doL ? Ks : Qs, 16 * ib, 32 * ks, lane, d), acc);
                }
                const LAS float* Gs = DP_AR(d, 0); const LAS float* RKP = DP_AR(d, 6);
                const int i = 16 * ib + fr; const float gi = Gs[i], bi = DP_AR(d, 1)[i] * RKP[i], qi = DP_AR(d, 7)[i];
                f32x4 o;
#pragma unroll
                for (int r = 0; r < 4; ++r) { const int j = 16 * jb + 4 * fq + r; const float dd = __expf(gi - Gs[j]) * acc[r] * RKP[j]; o[r] = doL ? (i > j ? bi * dd : 0.f) : (i >= j ? qi * dd : 0.f); }
                if (doL) { if (jb == ib) { LAS float* ld = DP_LD(d) + (ib * 16 + fr) * 17 + 4 * fq; ld[0] = o[0]; ld[1] = o[1]; ld[2] = o[2]; ld[3] = o[3]; }
                    const float z = jb == ib ? 0.f : -1.f; v2u w; w.x = pk2(o[0] * z, o[1] * z); w.y = pk2(o[2] * z, o[3] * z); *(LAS v2u*)(DP_LB(d) + i * P64 + (16 * jb + 4 * fq) * 2) = w; }
                else { v2u w; w.x = pk2(o[0], o[1]); w.y = pk2(o[2], o[3]); DP_ST8(DA + (size_t)((bh * 2 + d) * 36 + c) * 4096 + i * 64 + 16 * jb + 4 * fq, w); }
            }
        }
        __syncthreads();
        if (wv < 2) {
            const int d = wv, blk = lane >> 4, cc = lane & 15; const LAS float* Ld = DP_LD(d) + blk * 16 * 17;
            float x[16];
#pragma unroll
            for (int r = 0; r < 16; ++r) { float acc = r == cc ? 1.f : 0.f;
#pragma unroll
                for (int j = 0; j < r; ++j) acc -= Ld[r * 17 + j] * x[j];
                x[r] = acc; }
#pragma unroll
            for (int r = 0; r < 16; ++r) { LAS unsigned short* tp = (LAS unsigned short*)(DP_TM(d) + (16 * blk + r) * 80); tp[16 * (blk & 1) + cc] = (unsigned short)f2bf(x[r]); tp[16 * (1 - (blk & 1)) + cc] = 0; }
        } else if (wv < 4) {
            if (!isctx) { const int d = wv - 2; const LAS float* EGQ = DP_AR(d, 4); bf16* dq = DQ + (size_t)((bh * 2 + d) * 36 + c) * 8192;
#pragma unroll 2
                for (int k = 0; k < 16; ++k) { const int id = lane + 64 * k, i = id >> 4, pc = id & 15; float o[8];
                    unpack8(*(const LAS v4u*)(Qs + (d ? 63 - i : i) * TRP + pc * 16), o); const float eg = EGQ[i];
#pragma unroll
                    for (int e = 0; e < 8; ++e) o[e] *= eg;
                    DP_ST16(dq + i * 128 + pc * 8, pack8(o)); } }
        } else {
            const int d = (wv - 4) >> 1, dk = ((wv - 4) & 1) * 64 + lane; const LAS float* EGK = DP_AR(d, 5); bf16* kp = DKt + (size_t)((bh * 2 + d) * 36 + c) * 8192 + (size_t)dk * 64;
#pragma unroll 2
            for (int i8 = 0; i8 < 8; ++i8) { float o[8];
#pragma unroll
                for (int e = 0; e < 8; ++e) { const int i = i8 * 8 + e; o[e] = bf2f(*(const LAS unsigned short*)(Ks + (d ? 63 - i : i) * TRP + dk * 2)) * EGK[i]; }
                DP_ST16(kp + i8 * 8, pack8(o)); }
        }
        __syncthreads();
#pragma unroll 1
        for (int d = 0; d < 2; ++d) {
            const int tix = (bh * 2 + d) * 36 + c;
            {
                const bool isv = wv < 4; const LAS unsigned char* src = isv ? Vs : Ks; const LAS float* CF = isv ? DP_AR(d, 1) : DP_AR(d, 3);
                const LAS unsigned char* Lb = DP_LB(d); const LAS unsigned char* Tm = DP_TM(d);
                {
                    const int cb0 = 2 * wv, cl0 = (16 * cb0 + fr) & 127, cl1 = (16 * cb0 + 16 + fr) & 127;
                    LAS unsigned char* xrow0 = XT + (16 * cb0 + fr) * P64; LAS unsigned char* xrow1 = xrow0 + 16 * P64;
#pragma unroll
                    for (int k = 0; k < 4; ++k) {
                        f32x4 acc0, acc1;
#pragma unroll
                        for (int r = 0; r < 4; ++r) { const int i = 16 * k + 4 * fq + r; const LAS unsigned char* sp = src + (d ? 63 - i : i) * TRP; const float cf = CF[i];
                            acc0[r] = bf2f(*(const LAS unsigned short*)(sp + cl0 * 2)) * cf; acc1[r] = bf2f(*(const LAS unsigned short*)(sp + cl1 * 2)) * cf; }
                        if (k >= 1) { const bf16x8 lf = frag_row64(Lb, 16 * k, 0, lane); acc0 = mfma16(lf, frag_row64(XT, 16 * cb0, 0, lane), acc0); acc1 = mfma16(lf, frag_row64(XT, 16 * cb0 + 16, 0, lane), acc1); }
                        if (k == 3) { const bf16x8 lf = frag_row64(Lb, 16 * k, 32, lane); acc0 = mfma16(lf, frag_row64(XT, 16 * cb0, 32, lane), acc0); acc1 = mfma16(lf, frag_row64(XT, 16 * cb0 + 16, 32, lane), acc1); }
                        { v2u w; w.x = pk2(acc0[0], acc0[1]); w.y = pk2(acc0[2], acc0[3]); *(LAS v2u*)(xrow0 + (16 * k + 4 * fq) * 2) = w; }
                        { v2u w; w.x = pk2(acc1[0], acc1[1]); w.y = pk2(acc1[2], acc1[3]); *(LAS v2u*)(xrow1 + (16 * k + 4 * fq) * 2) = w; }
                        const bf16x8 tf = *(const LAS bf16x8*)(Tm + (16 * k + fr) * 80 + 16 * fq);
                        const f32x4 xk0 = mfma16(tf, frag_row64(XT, 16 * cb0, 32 * (k >> 1), lane), (f32x4){0.f, 0.f, 0.f, 0.f});
                        const f32x4 xk1 = mfma16(tf, frag_row64(XT, 16 * cb0 + 16, 32 * (k >> 1), lane), (f32x4){0.f, 0.f, 0.f, 0.f});
                        { v2u w; w.x = pk2(xk0[0], xk0[1]); w.y = pk2(xk0[2], xk0[3]); *(LAS v2u*)(xrow0 + (16 * k + 4 * fq) * 2) = w; }
                        { v2u w; w.x = pk2(xk1[0], xk1[1]); w.y = pk2(xk1[2], xk1[3]); *(LAS v2u*)(xrow1 + (16 * k + 4 * fq) * 2) = w; }
                    }
                }
            }
            __syncthreads();
#pragma unroll
            for (int k = 0; k < 2; ++k) { const int id = tid + NTHR * k, cidx = id >> 3, pc = id & 7; DP_ST16(DU + (size_t)tix * 8192 + cidx * 64 + pc * 8, *(const LAS v4u*)(XT + cidx * P64 + pc * 16)); }
#pragma unroll
            for (int k = 0; k < 2; ++k) { const int id = tid + NTHR * k, i = id & 63, d8 = id >> 6; float o[8];
#pragma unroll
                for (int e = 0; e < 8; ++e) o[e] = -bf2f(*(const LAS unsigned short*)(XT + (128 + d8 * 8 + e) * P64 + i * 2));
                DP_ST16(DW + (size_t)tix * 8192 + i * 128 + d8 * 8, pack8(o)); }
            if (WT && d == 1) asm volatile("s_waitcnt vmcnt(0)" ::: "memory");
            __syncthreads();
        }
        if (WT && tid == 0) __hip_atomic_store((unsigned*)(a.ws + WS_CTL) + CW_DPF + bh * 36 + c, 1u, __ATOMIC_RELAXED, __HIP_MEMORY_SCOPE_AGENT);
    }
#undef DP_ST16
#undef DP_ST8
#undef DP_ST4
#undef DP_LOAD
#undef DP_CONV
#undef DP_LD
#undef DP_LB
#undef DP_TM
#undef DP_AR
}
struct DnPf { v4u pw[2], pk[2], pq[2], pa; v2u un[4]; float gl; };
DI void phase_dn_scan(const int wu, const Args& a, LAS unsigned char* lds, const bool gated) {
    const int tid = tid_opq(wu), lane = tid & 63, wv = tid >> 6, fr = lane & 15, fq = lane >> 4;
    constexpr int OW = 0, OK_ = 64 * TRP, OQ = OK_ + 128 * P64, OA = OQ + 64 * TRP, BUF = OA + 64 * P64;
    const bf16* DW = (const bf16*)(a.ws + WS_DW); const bf16* DKt = (const bf16*)(a.ws + WS_DK); const bf16* DQ = (const bf16*)(a.ws + WS_DQ); const bf16* DU = (const bf16*)(a.ws + WS_DU);
    const bf16* DA = (const bf16*)(a.ws + WS_DA); const float* DG = (const float*)(a.ws + WS_DG);
    bf16* Oo = (bf16*)(a.ws + WS_FOUR);
    for (int chain = blockIdx.x; chain < 64; chain += gridDim.x) {
        const int b = chain >> 3, h = (chain >> 1) & 3, dir = chain & 1;
        bf16* Od = Oo + (size_t)dir * NLAT * 512 + (size_t)b * SEQ * 512 + h * 128 + 16 * wv + 4 * fq;
        f32x4 S[8];
#pragma unroll
        for (int k = 0; k < 8; ++k) S[k] = (f32x4){0.f, 0.f, 0.f, 0.f};
        DnPf pf0, pf1; v2u uc[4]; float glc;
        const int w_r0 = tid >> 4, w_pc = tid & 15, k_r0 = tid >> 3, k_pc = tid & 7;
        const __amdgpu_buffer_rsrc_t drs = __builtin_amdgcn_make_buffer_rsrc((void*)(a.ws + WS_DELTA), 0, (int)(WS_END - WS_DELTA), 0x00020000);
#define DN_L16(p_) __builtin_amdgcn_raw_buffer_load_b128(drs, (unsigned)((const char*)(p_) - (const char*)(a.ws + WS_DELTA)), 0, 16)
#define DN_L8(p_)  __builtin_amdgcn_raw_buffer_load_b64(drs, (unsigned)((const char*)(p_) - (const char*)(a.ws + WS_DELTA)), 0, 16)
#define DN_LOAD(P, tixv) do { const size_t _t = (size_t)(tixv); \
            P.pw[0] = DN_L16(DW + _t * 8192 + (size_t)w_r0 * 128 + w_pc * 8); P.pw[1] = DN_L16(DW + _t * 8192 + (size_t)(w_r0 + 32) * 128 + w_pc * 8); \
            P.pk[0] = DN_L16(DKt + _t * 8192 + (size_t)k_r0 * 64 + k_pc * 8); P.pk[1] = DN_L16(DKt + _t * 8192 + (size_t)(k_r0 + 64) * 64 + k_pc * 8); \
            P.pq[0] = DN_L16(DQ + _t * 8192 + (size_t)w_r0 * 128 + w_pc * 8); P.pq[1] = DN_L16(DQ + _t * 8192 + (size_t)(w_r0 + 32) * 128 + w_pc * 8); \
            P.pa = DN_L16(DA + _t * 4096 + (size_t)k_r0 * 64 + k_pc * 8); \
            _Pragma("unroll") for (int ib = 0; ib < 4; ++ib) P.un[ib] = DN_L8(DU + _t * 8192 + (size_t)(16 * wv + fr) * 64 + 16 * ib + 4 * fq); \
            P.gl = __uint_as_float(__builtin_amdgcn_raw_buffer_load_b32(drs, (unsigned)((const char*)(DG + _t) - (const char*)(a.ws + WS_DELTA)), 0, 16)); } while (0)
#define DN_WRITE(P, bufb) do { LAS unsigned char* _b = lds + (bufb); \
            *(LAS v4u*)(_b + OW + w_r0 * TRP + w_pc * 16) = P.pw[0]; *(LAS v4u*)(_b + OW + (w_r0 + 32) * TRP + w_pc * 16) = P.pw[1]; \
            *(LAS v4u*)(_b + OK_ + k_r0 * P64 + k_pc * 16) = P.pk[0]; *(LAS v4u*)(_b + OK_ + (k_r0 + 64) * P64 + k_pc * 16) = P.pk[1]; \
            *(LAS v4u*)(_b + OQ + w_r0 * TRP + w_pc * 16) = P.pq[0]; *(LAS v4u*)(_b + OQ + (w_r0 + 32) * TRP + w_pc * 16) = P.pq[1]; \
            *(LAS v4u*)(_b + OA + k_r0 * P64 + k_pc * 16) = P.pa; } while (0)
#define DN_CHUNK(n_) (dir ? ((n_) < 4 ? 3 - (n_) : 39 - (n_)) : (n_))
        const unsigned* DPF = (const unsigned*)(a.ws + WS_CTL) + CW_DPF + (chain >> 1) * 36; unsigned fl;
#define DN_FLAG(cx) __hip_atomic_load(DPF + (cx), __ATOMIC_RELAXED, __HIP_MEMORY_SCOPE_AGENT)
#define DN_LATE(cx) (gated && (cx) >= 4 && ((cx) < 20 ? 4 + 2 * ((cx) - 4) : 5 + 2 * (35 - (cx))) >= NDP1 / 32)
#define DN_WAIT(cx) do { if (DN_LATE(cx)) { unsigned _sp = 0; while (fl == 0u && ++_sp < (1u << 20)) { __builtin_amdgcn_s_sleep(1); fl = DN_FLAG(cx); } asm volatile("" ::: "memory"); } } while (0)
        __syncthreads();
        { fl = 1u; DN_LOAD(pf0, chain * 36 + DN_CHUNK(0)); DN_WRITE(pf0, 0);
#pragma unroll
          for (int ib = 0; ib < 4; ++ib) uc[ib] = pf0.un[ib];
          glc = pf0.gl;
          DN_LOAD(pf1, chain * 36 + DN_CHUNK(1)); }
        __syncthreads();
        auto step = [&](const int n, DnPf& ld, DnPf& wr) __attribute__((always_inline)) {
            const int c = DN_CHUNK(n); const bool isctx = c < 4;
            { const int c2 = DN_CHUNK(n + 2 < 35 ? n + 2 : 35), c3 = DN_CHUNK(n + 3 < 35 ? n + 3 : 35); DN_WAIT(c2); fl = DN_FLAG(c3); DN_LOAD(ld, chain * 36 + c2); }
            const LAS unsigned char* B = lds + (n & 1) * BUF;
            f32x4 vn[4];
#pragma unroll
            for (int ib = 0; ib < 4; ++ib) { vn[ib][0] = __uint_as_float(uc[ib].x << 16); vn[ib][1] = __uint_as_float(uc[ib].x & 0xffff0000u); vn[ib][2] = __uint_as_float(uc[ib].y << 16); vn[ib][3] = __uint_as_float(uc[ib].y & 0xffff0000u); }
            bf16x8 fa[16];
#pragma unroll
            for (int ib = 0; ib < 4; ++ib)
#pragma unroll
                for (int s2 = 0; s2 < 4; ++s2) fa[ib * 4 + s2] = read2(B + OW + (16 * ib + fr) * TRP + (32 * s2 + 4 * fq) * 2);
            bf16x8 sf[4];
#pragma unroll
            for (int s2 = 0; s2 < 4; ++s2) sf[s2] = pack_tiles(S[2 * s2], S[2 * s2 + 1]);
#pragma unroll
            for (int s2 = 0; s2 < 4; ++s2)
#pragma unroll
                for (int ib = 0; ib < 4; ++ib) vn[ib] = mfma16(fa[ib * 4 + s2], sf[s2], vn[ib]);
            bf16x8 fk[16];
#pragma unroll
            for (int kb = 0; kb < 8; ++kb)
#pragma unroll
                for (int s2 = 0; s2 < 2; ++s2) fk[kb * 2 + s2] = read2(B + OK_ + (16 * kb + fr) * P64 + (32 * s2 + 4 * fq) * 2);
            bf16x8 vf[2];
            vf[0] = pack_tiles(vn[0], vn[1]); vf[1] = pack_tiles(vn[2], vn[3]);
            f32x4 Sn[8];
#pragma unroll
            for (int kb = 0; kb < 8; ++kb) Sn[kb] = S[kb] * glc;
#pragma unroll
            for (int s2 = 0; s2 < 2; ++s2)
#pragma unroll
                for (int kb = 0; kb < 8; ++kb) Sn[kb] = mfma16(fk[kb * 2 + s2], vf[s2], Sn[kb]);
            if (!isctx) {
#pragma unroll
                for (int hb = 0; hb < 2; ++hb) {
                    bf16x8 fq_[8], fat[4];
#pragma unroll
                    for (int ib2 = 0; ib2 < 2; ++ib2) { const int ib = hb * 2 + ib2;
#pragma unroll
                        for (int s2 = 0; s2 < 4; ++s2) fq_[ib2 * 4 + s2] = read2(B + OQ + (16 * ib + fr) * TRP + (32 * s2 + 4 * fq) * 2);
#pragma unroll
                        for (int s2 = 0; s2 < 2; ++s2) fat[ib2 * 2 + s2] = read2(B + OA + (16 * ib + fr) * P64 + (32 * s2 + 4 * fq) * 2); }
                    f32x4 o[2];
                    o[0] = (f32x4){0.f, 0.f, 0.f, 0.f}; o[1] = o[0];
#pragma unroll
                    for (int s2 = 0; s2 < 4; ++s2)
#pragma unroll
                        for (int ib2 = 0; ib2 < 2; ++ib2) o[ib2] = mfma16(sf[s2], fq_[ib2 * 4 + s2], o[ib2]);
#pragma unroll
                    for (int s2 = 0; s2 < 2; ++s2)
#pragma unroll
                        for (int ib2 = 0; ib2 < 2; ++ib2) o[ib2] = mfma16(vf[s2], fat[ib2 * 2 + s2], o[ib2]);
#pragma unroll
                    for (int ib2 = 0; ib2 < 2; ++ib2) { const int i = 16 * (hb * 2 + ib2) + fr, t = dir ? (c - 4) * 64 + 63 - i : (c - 4) * 64 + i;
                        v2u w; w.x = pk2(o[ib2][0], o[ib2][1]); w.y = pk2(o[ib2][2], o[ib2][3]); *(v2u*)(Od + (size_t)t * 512) = w; }
                }
            }
#pragma unroll
            for (int kb = 0; kb < 8; ++kb) S[kb] = Sn[kb];
            if (n < 35) { DN_WRITE(wr, ((n + 1) & 1) * BUF);
#pragma unroll
                for (int ib = 0; ib < 4; ++ib) uc[ib] = wr.un[ib];
                glc = wr.gl; }
            __syncthreads();
        };
#pragma unroll 1
        for (int n = 0; n < 36; n += 2) { step(n, pf0, pf1); step(n + 1, pf1, pf0); }
#undef DN_LOAD
#undef DN_L16
#undef DN_L8
#undef DN_WRITE
#undef DN_FLAG
#undef DN_WAIT
#undef DN_LATE
#undef DN_CHUNK
    }
}
DI void phase_sgu(const int wu, const Args& a, LAS unsigned char* lds, const int s_first, const int s_stride) {
    const int tid = tid_opq(wu), wv = tid >> 6, lane = tid & 63, fr = lane & 15, fq = lane >> 4;
    LAS unsigned char* Wb = lds; LAS unsigned char* Vn = lds + 128 * TRP;
    const bf16* lat = (const bf16*)(a.ws + WS_LAT); bf16* mix = (bf16*)(a.ws + WS_MIX);
    const unsigned trV = (unsigned)(size_t)Vn + tr_lane_off(lane);
    for (int task = s_first; task < NB * 16 * 4; task += s_stride) {
        const int g = task & 3, n = (task >> 2) & 15, b = task >> 6; const int row0 = NCTX + b * SEQ + n * 128;
        __syncthreads();
#pragma unroll 4
        for (int k = 0; k < 8; ++k) { const int id = tid + NTHR * k, p = id >> 5, q4 = id & 31; const f32x4 w = *(const f32x4*)(a.in[I_SGUW] + (size_t)g * 16384 + p * 128 + q4 * 4);
            v2u o; o.x = pk2(w[0], w[1]); o.y = pk2(w[2], w[3]); *(LAS v2u*)(Wb + p * TRP + q4 * 8) = o; }
        {
            v4u sv[4]; const int qs = wv * 4 + (lane >> 4), c8 = (lane & 15) * 8;
#pragma unroll
            for (int it = 0; it < 4; ++it) sv[it] = *(const v4u*)(lat + (size_t)(row0 + it * 32 + qs) * L1N + 2560 + g * 128 + c8);
#pragma unroll
            for (int it = 0; it < 4; ++it) { float x[8]; unpack8(sv[it], x); float sm = 0.f;
#pragma unroll
                for (int e = 0; e < 8; ++e) { x[e] = geluf(x[e]); sm += x[e]; }
#pragma unroll
                for (int o = 1; o < 16; o <<= 1) sm += __shfl_xor(sm, o);
                const float mu = sm * (1.f / 128.f); float sq = 0.f;
#pragma unroll
                for (int e = 0; e < 8; ++e) { x[e] -= mu; sq += x[e] * x[e]; }
#pragma unroll
                for (int o = 1; o < 16; o <<= 1) sq += __shfl_xor(sq, o);
                const float rs = rsqrtf(sq * (1.f / 128.f) + EPS);
#pragma unroll
                for (int e = 0; e < 8; ++e) x[e] *= rs;
                *(LAS v4u*)(Vn + (it * 32 + qs) * TRP + c8 * 2) = pack8(x); }
        }
        __syncthreads();
        bf16x8 wf[4];
#pragma unroll
        for (int ks = 0; ks < 4; ++ks) wf[ks] = frag_row(Wb, 16 * wv, 32 * ks, lane);
        const int p = 16 * wv + fr; const size_t row = (size_t)(row0 + p); const float bs = a.in[I_SGUB][g * 128 + p];
        v2u uu8[8];
#pragma unroll
        for (int cb = 0; cb < 8; ++cb) uu8[cb] = *(const v2u*)(lat + row * L1N + 2048 + g * 128 + 16 * cb + 4 * fq);
#pragma unroll
        for (int cb = 0; cb < 8; ++cb) {
            bf16x8 vf[4]; tr_frag4(trV + 32u * cb, vf);
            f32x4 acc = (f32x4){0.f, 0.f, 0.f, 0.f};
#pragma unroll
            for (int ks = 0; ks < 4; ++ks) acc = mfma16(vf[ks], wf[ks], acc);
            const int col = g * 128 + 16 * cb + 4 * fq;
            const v2u uu = uu8[cb];
            const float u0 = geluf(__uint_as_float(uu.x << 16)), u1 = geluf(__uint_as_float(uu.x & 0xffff0000u)), u2 = geluf(__uint_as_float(uu.y << 16)), u3 = geluf(__uint_as_float(uu.y & 0xffff0000u));
            v2u o; o.x = pk2(u0 * (acc[0] + bs), u1 * (acc[1] + bs)); o.y = pk2(u2 * (acc[2] + bs), u3 * (acc[3] + bs));
            *(v2u*)(mix + row * DM + 512 + col) = o;
        }
    }
}
DI void phase_ghn(const int wu, const Args& a) {
    const int tid = tid_opq(wu), wv = tid >> 6, lane = tid & 63;
    const bf16* O0 = (const bf16*)(a.ws + WS_FOUR); const bf16* O1 = O0 + (size_t)NLAT * 512;
    const bf16* lat = (const bf16*)(a.ws + WS_LAT); bf16* mix = (bf16*)(a.ws + WS_MIX); const float* nw = a.in[I_DNNW];
    const f32x4 nwa = *(const f32x4*)(nw + (lane & 15) * 8), nwb = *(const f32x4*)(nw + (lane & 15) * 8 + 4);
    for (int r4 = (blockIdx.x * NWAVES + wv) * 4; r4 < NLAT; r4 += gridDim.x * NWAVES * 4) {
        v4u u0[4], u1[4], zz[4];
#pragma unroll
        for (int rr = 0; rr < 4; ++rr) { const size_t oi = (size_t)(r4 + rr) * 512 + lane * 8;
            u0[rr] = __builtin_nontemporal_load((const v4u*)(O0 + oi)); u1[rr] = __builtin_nontemporal_load((const v4u*)(O1 + oi));
            zz[rr] = *(const v4u*)(lat + (size_t)(NCTX + r4 + rr) * L1N + 1536 + lane * 8); }
#pragma unroll
        for (int rr = 0; rr < 4; ++rr) {
            float p[8], q[8], z[8]; unpack8(u0[rr], p); unpack8(u1[rr], q); unpack8(zz[rr], z);
            float ss = 0.f;
#pragma unroll
            for (int e = 0; e < 8; ++e) { p[e] += q[e]; ss += p[e] * p[e]; }
#pragma unroll
            for (int o = 1; o < 16; o <<= 1) ss += __shfl_xor(ss, o);
            const float rs = rsqrtf(ss * (1.f / 128.f) + EPS);
#pragma unroll
            for (int e = 0; e < 8; ++e) p[e] = p[e] * rs * (e < 4 ? nwa[e & 3] : nwb[e & 3]) * siluf(z[e]);
            *(v4u*)(mix + (size_t)(NCTX + r4 + rr) * DM + lane * 8) = pack8(p);
        }
    }
}

constexpr int NPHASE = 20;
__global__ void __launch_bounds__(NTHR, 2) mk_fwd(Args args) {
    extern __shared__ __attribute__((aligned(16))) unsigned char lds_raw[];
    LAS unsigned char* lds = (LAS unsigned char*)lds_raw;
    const int wu = __builtin_amdgcn_readfirstlane(threadIdx.x >> 6);
    const int tid = tid_opq(wu);
    for (int u = tid; u < (LDS_BYTES - LDSCTL_OFF) / 4; u += NTHR) ((LAS unsigned*)(lds + LDSCTL_OFF))[u] = 0u;
    __syncthreads();
    unsigned* ctl = (unsigned*)(args.ws + WS_CTL);
    XcdBarrier bar; bar.bar = ctl + CW_BAR + args.bar_region * XCD_BAR_WORDS; bar.x = 0; bar.st = nullptr;
    const bool one = (args.ph_hi - args.ph_lo) > 1;
    if (one) bar = xcd_barrier_post(ctl + CW_BAR + args.bar_region * XCD_BAR_WORDS, (volatile LAS unsigned*)(lds + LDSCTL_OFF) + 8, tid);
    const int lo = args.ph_lo, hi = args.ph_hi;
#define IN(k) (lo <= (k) && (k) < hi)
#ifdef MK_TIME_PHASE
    unsigned long long t_beg = 0, t_end = 0;
#define SEAM(k) do { if (IN(k) && IN((k) + 1)) xcd_barrier(bar, tid_opq(wu)); if ((k) + 1 == MK_TIME_PHASE) t_beg = __builtin_amdgcn_s_memrealtime(); if ((k) == MK_TIME_PHASE) t_end = __builtin_amdgcn_s_memrealtime(); } while (0)
#else
#define SEAM(k) do { if (IN(k) && IN((k) + 1)) xcd_barrier(bar, tid_opq(wu)); } while (0)
#endif
    const int G = gridDim.x, c = blockIdx.x;
    unsigned char* ws = args.ws;
    if (IN(0)) { phase_prep(wu, args, lds); } SEAM(0);
    if (IN(1)) { phase_rowB<0>(wu, args, lds); } SEAM(1);
    if (IN(2)) {
        pg8::SchedDense S{(const char*)args.out, (const char*)(ws + WS_WIN0), DM, DM, 0, NTOK / 256, 0, EIN / 256, 0, 0, 0, 0, G, c};
        pg8::EpiBf16G E{(bf16*)(ws + WS_LAT), EIN, 0};
        pg8::gemm_phase<pg8::EpiBf16G, pg8::SchedDense, false>(wu, lds, DM, DM, DM, S, E);
    } SEAM(2);
    if (IN(3)) {
        phase_ret_state(wu, args, lds);
        phase_fft_a(wu, args, lds, 64, G - 64);
        { SchedChan S{(const char*)(ws + WS_TCH), (const char*)(ws + WS_LAT), 1, G, (c + G - 64) % G}; pg8::EpiChan<1> E{(bf16*)(ws + WS_FOUR + FOUR_GTC)};
          pg8::gemm_phase<pg8::EpiChan<1>, SchedChan, false>(wu, lds, 128, 128, EIN, S, E); }
        if (c >= 64) moe_convert_stream(args, 0, c - 64, G - 64, lds, tid_opq(wu));
    } SEAM(3);
    if (IN(4)) {
        phase_ret_out(wu, args, lds, 0, G);
        {
            int f0 = c, fs = G, fe = NB * 64 * 4;
            if (G == 256) { fs = 1; if (c < 64) { f0 = c; fe = f0 + 1; } else if (c < 240) { f0 = 64 + (c - 64) * 11; fe = f0 + 11; } else { f0 = 2000 + (c - 240) * 3; fe = f0 + 3; } }
            phase_fft_b(wu, args, lds, f0, fs, fe);
        }
        __syncthreads();
        pg8::EpiBf16G E{(bf16*)(ws + WS_MIX), DM, 0};
        { SchedTok S{(const char*)(ws + WS_T256), (const char*)(ws + WS_FOUR + FOUR_GTC), 1, G, (c + G - 240) % G};
          pg8::gemm_phase<pg8::EpiBf16G, SchedTok, false>(wu, lds, 512, 512, 512, S, E); }
    } SEAM(4);
    if (IN(5)) {
        pg8::SchedDense S{(const char*)(ws + WS_MIX), (const char*)(ws + WS_WOUT0), DM, DM, NCTX / 256, NLAT / 256, 0, DM / 256, 0, 0, 0, 0, G, c};
        pg8::EpiResid E{(bf16*)(ws + WS_XC), (const float*)(ws + WS_MODS), args.in[I_X], args.in[I_CTX], false};
        pg8::gemm_phase<pg8::EpiResid, pg8::SchedDense, false>(wu, lds, DM, DM, DM, S, E);
    } SEAM(5);
    if (IN(6)) {
        if (c < 32) {
            pg8::SchedDense S{(const char*)(ws + WS_MIX), (const char*)(ws + WS_WOUT0), DM, DM, 0, NCTX / 256, 0, DM / 256, 0, 0, 0, 0, 32, c};
            pg8::EpiResid E{(bf16*)(ws + WS_XC), (const float*)(ws + WS_MODS), args.in[I_X], args.in[I_CTX], true};
            pg8::gemm_phase<pg8::EpiResid, pg8::SchedDense, false>(wu, lds, DM, DM, DM, S, E);
            if (tid_opq(wu) == 0) __hip_atomic_fetch_add((unsigned*)(ws + WS_CTL) + CW_CTXDONE, 1u, __ATOMIC_RELAXED, __HIP_MEMORY_SCOPE_AGENT);
        }
        phase_rowA<0>(wu, args, lds);
    } SEAM(6);
    if (IN(7)) { phase_moe_gemm<1>(wu, args, 0, lds); } SEAM(7);
    if (IN(8)) { phase_moe_gemm<2>(wu, args, 0, lds); } SEAM(8);
    if (IN(9)) {
        phase_rowB<1>(wu, args, lds);
        if (G == 256 && c >= 224) {
            if (tid_opq(wu) == 0) { unsigned* dn = (unsigned*)(ws + WS_CTL) + CW_CTXH; unsigned sp = 0;
                while (__hip_atomic_load(dn, __ATOMIC_RELAXED, __HIP_MEMORY_SCOPE_AGENT) < (unsigned)(NCTX / 32) && ++sp < (1u << 22)) __builtin_amdgcn_s_sleep(2);
                __builtin_amdgcn_fence(__ATOMIC_ACQUIRE, "agent"); asm volatile("s_waitcnt vmcnt(0)" ::: "memory"); }
            __syncthreads();
            pg8::SchedDense S{(const char*)args.out, (const char*)(ws + WS_WIN1), DM, DM, 0, NCTX / 256, 2, 4, 0, 0, 0, 0, 32, c - 224};
            pg8::EpiBf16G E{(bf16*)(ws + WS_LAT), L1N, 0};
            pg8::gemm_phase<pg8::EpiBf16G, pg8::SchedDense, false>(wu, lds, DM, DM, DM, S, E);
        }
    } SEAM(9);
    if (IN(10)) {
        pg8::SchedDense S{(const char*)args.out, (const char*)(ws + WS_WIN1), DM, DM, NCTX / 256, NLAT / 256, 0, L1N / 256, 0, G == 256 ? 0 : NCTX / 256, 2, 4, G, c};
        pg8::EpiBf16G E{(bf16*)(ws + WS_LAT), L1N, 0};
        pg8::gemm_phase<pg8::EpiBf16G, pg8::SchedDense, false>(wu, lds, DM, DM, DM, S, E);
    } SEAM(10);
    if (IN(11)) { phase_dn_prep<false>(wu, args, lds, c, G, G == 256 ? NDP1 : NDP); if (G != 256) phase_sgu(wu, args, lds, c, G); } SEAM(11);
    if (IN(12)) { phase_dn_scan(wu, args, lds, G == 256);
        if (c >= 64 && G == 256) phase_dn_prep<true>(wu, args, lds, NDP1 + c - 64, G - 64, NDP);
        if (c >= 64) moe_convert_stream(args, 1, c - 64, G - 64, lds, tid_opq(wu));
        if (c >= 64 && G == 256) phase_sgu(wu, args, lds, c - 64, G - 64);
    } SEAM(12);
    if (IN(13)) { phase_ghn(wu, args); } SEAM(13);
    if (IN(14)) {
        pg8::SchedDense S{(const char*)(ws + WS_MIX), (const char*)(ws + WS_WOUT1), DM, DM, NCTX / 256, NLAT / 256, 0, DM / 256, 0, 0, 0, 0, G, c};
        pg8::EpiResid E{(bf16*)(ws + WS_XC), (const float*)(ws + WS_MODS) + 9 * 6144, nullptr, nullptr, false};
        pg8::gemm_phase<pg8::EpiResid, pg8::SchedDense, false>(wu, lds, DM, DM, DM, S, E);
    } SEAM(14);
    if (IN(15)) { phase_rowA<1>(wu, args, lds); } SEAM(15);
    if (IN(16)) { phase_moe_gemm<1>(wu, args, 1, lds); } SEAM(16);
    if (IN(17)) { phase_moe_gemm<2>(wu, args, 1, lds); } SEAM(17);
#ifdef MK_TIME_PHASE
    if (IN(18)) { int nz = (int)((t_end - t_beg) >> 3); nz = nz < 0 ? 0 : (nz > NLAT ? NLAT : nz); phase_rowB<2>(wu, args, lds, nz); }
#else
    if (IN(18)) { phase_rowB<2>(wu, args, lds); }
#endif
#undef IN
#undef SEAM
}
}

extern "C" void kernel_launch(void* const* d_in, const int* in_sizes, int n_in, void* d_out, int out_size, void* d_ws, size_t ws_size, hipStream_t stream) {
    static int grid = 0;
    if (grid == 0) {
        if (ws_size < WS_END) { fprintf(stderr, "kernel_launch: workspace too small: need %zu, have %zu\n", (size_t)WS_END, ws_size); grid = -1; return; }
        int dev = 0, cus = 0;
        if (hipGetDevice(&dev) != hipSuccess || hipDeviceGetAttribute(&cus, hipDeviceAttributeMultiprocessorCount, dev) != hipSuccess) { grid = -1; return; }
        if (hipFuncSetAttribute((const void*)mk_fwd, hipFuncAttributeMaxDynamicSharedMemorySize, LDS_BYTES) != hipSuccess) { fprintf(stderr, "kernel_launch: hipFuncSetAttribute failed\n"); grid = -1; return; }
        grid = cus >= 256 ? 256 : cus;
    }
    if (grid < 0) return;
    (void)hipMemsetAsync((char*)d_ws + WS_CTL, 0, CTL_ZERO_BYTES, stream);
    Args a{};
    for (int i = 0; i < 28; ++i) a.in[i] = (const float*)d_in[i];
    a.out = (float*)d_out; a.ws = (unsigned char*)d_ws;
#if defined(MK_SPLIT_AT)
    a.ph_lo = 0; a.ph_hi = MK_SPLIT_AT + 1; a.bar_region = 0; hipLaunchKernelGGL(mk_fwd, dim3(grid), dim3(NTHR), LDS_BYTES, stream, a);
#if !defined(MK_SPLIT_NOREP)
    a.ph_lo = MK_SPLIT_AT; a.ph_hi = MK_SPLIT_AT + 1; a.bar_region = 0; hipLaunchKernelGGL(mk_fwd, dim3(grid), dim3(NTHR), LDS_BYTES, stream, a);
#endif
    if (MK_SPLIT_AT + 1 < 19) { a.ph_lo = MK_SPLIT_AT + 1; a.ph_hi = NPHASE; a.bar_region = 1; hipLaunchKernelGGL(mk_fwd, dim3(grid), dim3(NTHR), LDS_BYTES, stream, a); }
#elif MK_ONE_LAUNCH
    a.ph_lo = 0; a.ph_hi = NPHASE;
    hipLaunchKernelGGL(mk_fwd, dim3(grid), dim3(NTHR), LDS_BYTES, stream, a);
#else
    for (int p = 0; p < 19; ++p) { a.ph_lo = p; a.ph_hi = p + 1; hipLaunchKernelGGL(mk_fwd, dim3(grid), dim3(NTHR), LDS_BYTES, stream, a); }
#endif
}
```
